# Optimizing an MI355X kernel written in HIP

```python
import math
import jax
import jax.numpy as jnp
from jax import lax
import numpy as np


D_MODEL = 1024
BATCH = 4
SEQ = 8192
DEPTH = 4

CTX_LEN = 256
GRID_W = 64
RET_HEADS = 4
RET_DK = 128
RET_DV = 128
RET_W = RET_HEADS * RET_DV
RET_CHUNK = 128
NA_HEADS = 8
NA_DH = 64
NA_W = NA_HEADS * NA_DH
NA_WIN_ROWS = 8
NA_WIN_COLS = 16
NA_ROW_BLOCK = 8
GQA_HEADS = 8
GQA_KV_HEADS = 2
GQA_DH = 64
GQA_W = GQA_HEADS * GQA_DH
GQA_KV_W = GQA_KV_HEADS * GQA_DH
Q_BLOCK = 128
ROPE_THETA = 10000.0
EPS = 1e-6
N_BRANCH = 3
IN_SPLITS = (RET_W, RET_W, RET_W, RET_W, NA_W, NA_W, NA_W, NA_W, GQA_W, GQA_KV_W, GQA_KV_W, GQA_W, N_BRANCH * D_MODEL)
IN_COLS = 4 * RET_W + 4 * NA_W + 2 * GQA_W + 2 * GQA_KV_W + N_BRANCH * D_MODEL

kernel_name = 'hybrid_retention_natten_gqa_prefix_trunk'


def rms_norm(x, w):
    xf = x.astype(jnp.float32)
    y = xf * lax.rsqrt(jnp.mean(xf * xf, axis=-1, keepdims=True) + EPS)
    return (y * w.astype(jnp.float32)).astype(x.dtype)


def heads(a, h):
    return a.reshape(a.shape[:-1] + (h, a.shape[-1] // h))


def split_cols(p):
    bounds = np.cumsum(IN_SPLITS)[:-1].tolist()
    return jnp.split(p, bounds, axis=-1)


def _flip(a, rev):
    return a[:, ::-1] if rev else a


def axial_rope(x):
    n, dh = x.shape[1], x.shape[-1]
    half = dh // 2
    quarter = half // 2
    t = jnp.arange(n)
    pos_r = (t // GRID_W).astype(jnp.float32)
    pos_c = (t % GRID_W).astype(jnp.float32)
    freqs = ROPE_THETA ** (-jnp.arange(quarter, dtype=jnp.float32) / quarter)

    def rot(xa, pos):
        ang = pos[:, None] * freqs[None, :]
        cos = jnp.cos(ang)[None, :, None, :]
        sin = jnp.sin(ang)[None, :, None, :]
        x1, x2 = xa[..., :quarter], xa[..., quarter:]
        return jnp.concatenate([x1 * cos - x2 * sin, x2 * cos + x1 * sin], axis=-1)

    xf = x.astype(jnp.float32)
    return jnp.concatenate([rot(xf[..., :half], pos_r), rot(xf[..., half:], pos_c)], axis=-1).astype(x.dtype)


def attend(q, k, v):
    s = jnp.einsum('btkgd,bskd->bkgts', q, k).astype(jnp.float32) * (q.shape[-1] ** -0.5)
    p = jax.nn.softmax(s, axis=-1)
    return jnp.einsum('bkgts,bskd->btkgd', p, v)


def ret_chunkwise(q, k, v, log_g, s0):
    b, t, h, dk = q.shape
    dv = v.shape[-1]
    c = RET_CHUNK
    n = t // c
    qc = q.reshape(b, n, c, h, dk)
    kc = k.reshape(b, n, c, h, dk)
    vc = v.reshape(b, n, c, h, dv)
    pos = jnp.arange(c, dtype=jnp.float32)
    diff = pos[:, None] - pos[None, :]
    decay = jnp.where(diff >= 0, jnp.exp(jnp.maximum(diff, 0.0)[None] * log_g[:, None, None]), 0.0)
    scores = jnp.einsum('bnihd,bnjhd->bnhij', qc, kc) * decay[None, None]
    intra = jnp.einsum('bnhij,bnjhe->bnihe', scores, vc)
    zeta = jnp.exp((c - 1 - pos)[None, :] * log_g[:, None])
    u = jnp.einsum('bnjhd,hj,bnjhe->nbhde', kc, zeta, vc)
    g_chunk = jnp.exp(c * log_g)[None, :, None, None]

    def step(s, u_n):
        return g_chunk * s + u_n, s

    s_fin, s_prev = lax.scan(step, s0, u)
    xi = jnp.exp((pos + 1.0)[None, :] * log_g[:, None])
    inter = jnp.einsum('bnihd,hi,nbhde->bnihe', qc, xi, s_prev)
    return (intra + inter).reshape(b, t, h, dv), s_fin


def ret_state(k, v, log_g):
    t = k.shape[1]
    pos = jnp.arange(t, dtype=jnp.float32)
    w = jnp.exp((t - 1 - pos)[None, :] * log_g[:, None])
    return jnp.einsum('bthd,ht,bthe->bhde', k, w, v)


def bidir_retention(q, k, v, qc, kc, vc, log_g, need_ctx):
    b, _, h, dk = q.shape
    dv = v.shape[-1]
    o_lat, o_ctx = [], []
    for d in range(2):
        rev = d == 1
        if need_ctx:
            s0 = jnp.zeros((b, h, dk, dv), jnp.float32)
            oc, s_ctx = ret_chunkwise(_flip(qc, rev), _flip(kc, rev), _flip(vc, rev), log_g[d], s0)
            o_ctx.append(_flip(oc, rev))
        else:
            s_ctx = ret_state(_flip(kc, rev), _flip(vc, rev), log_g[d])
        ol, _ = ret_chunkwise(_flip(q, rev), _flip(k, rev), _flip(v, rev), log_g[d], s_ctx)
        o_lat.append(_flip(ol, rev))
    return o_lat[0] + o_lat[1], (o_ctx[0] + o_ctx[1] if need_ctx else None)


def head_group_norm(o, w):
    mu = jnp.mean(o, axis=-1, keepdims=True)
    var = jnp.mean(jnp.square(o - mu), axis=-1, keepdims=True)
    y = (o - mu) * lax.rsqrt(var + EPS)
    return y.reshape(o.shape[0], o.shape[1], -1) * w.astype(jnp.float32)


def neighbourhood_attention(q, k, v, kc, vc, rpb, rows):
    b, n, h, dh = q.shape
    wr = min(NA_WIN_ROWS, rows)
    qcb = NA_WIN_COLS
    ncb = GRID_W // qcb
    band = 2 * qcb
    qcol = np.arange(ncb)[:, None] * qcb + np.arange(qcb)[None, :]
    cstart = np.clip(qcol - NA_WIN_COLS // 2, 0, GRID_W - NA_WIN_COLS)
    bstart = np.clip(np.arange(ncb) * qcb - NA_WIN_COLS // 2, 0, GRID_W - band)
    kcol = bstart[:, None] + np.arange(band)[None, :]
    col_ok = jnp.asarray((kcol[:, None, :] >= cstart[:, :, None]) & (kcol[:, None, :] < cstart[:, :, None] + NA_WIN_COLS))
    dc_idx = np.clip(kcol[:, None, :] - qcol[:, :, None] + NA_WIN_COLS - 1, 0, 2 * NA_WIN_COLS - 2)
    rpb_c = rpb.astype(jnp.float32)[:, :, dc_idx]

    kg = k.reshape(b, rows, GRID_W, h, dh)[:, :, kcol]
    vg = v.reshape(b, rows, GRID_W, h, dh)[:, :, kcol]
    rb = math.gcd(rows, NA_ROW_BLOCK)
    nrb = rows // rb
    qblocks = q.reshape(b, nrb, rb, ncb, qcb, h, dh).transpose(1, 0, 2, 3, 4, 5, 6)
    scale = dh ** -0.5
    n_loc = wr * band

    def block(args):
        i, qb = args
        r = i * rb + jnp.arange(rb)
        rs = jnp.clip(r - wr // 2, 0, rows - wr)
        ridx = rs[:, None] + jnp.arange(wr)[None, :]
        kb = jnp.take(kg, ridx, axis=1)
        vb = jnp.take(vg, ridx, axis=1)
        dr_idx = ridx - r[:, None] + NA_WIN_ROWS - 1
        bias = rpb_c[:, dr_idx].transpose(0, 1, 3, 4, 2, 5)
        s = jnp.einsum('brjqhd,brwjkhd->bhrjqwk', qb, kb).astype(jnp.float32) * scale + bias[None]
        s = jnp.where(col_ok[:, :, None, :], s, -jnp.inf)
        s_ctx = jnp.einsum('brjqhd,blhd->bhrjql', qb, kc).astype(jnp.float32) * scale
        s_all = jnp.concatenate([s.reshape(s.shape[:5] + (n_loc,)), s_ctx], axis=-1)
        p = jax.nn.softmax(s_all, axis=-1)
        p_loc = p[..., :n_loc].reshape(s.shape)
        p_ctx = p[..., n_loc:]
        return jnp.einsum('bhrjqwk,brwjkhd->brjqhd', p_loc, vb) + jnp.einsum('bhrjql,blhd->brjqhd', p_ctx, vc)

    o = lax.map(block, (jnp.arange(nrb), qblocks))
    return o.transpose(1, 0, 2, 3, 4, 5, 6).reshape(b, n, h * dh)


def gqa_blocks(q, k_all, v_all):
    b, n, hq, dh = q.shape
    hk = k_all.shape[2]
    nb = n // Q_BLOCK
    qb = q.reshape(b, nb, Q_BLOCK, hk, hq // hk, dh).transpose(1, 0, 2, 3, 4, 5)
    o = lax.map(lambda qi: attend(qi, k_all, v_all), qb)
    return o.transpose(1, 0, 2, 3, 4, 5).reshape(b, n, hq * dh)


def merge_branches(ret_o, na_o, gqa_o, gate_logits, w_ret_o, w_na_o, w_gqa_o, w_out):
    dt = w_out.dtype
    g_ret, g_na, g_gqa = jnp.split(jax.nn.sigmoid(gate_logits.astype(jnp.float32)), N_BRANCH, axis=-1)
    m = (g_ret * (ret_o.astype(dt) @ w_ret_o) + g_na * (na_o.astype(dt) @ w_na_o)
         + g_gqa * (gqa_o.astype(dt) @ w_gqa_o))
    return m.astype(dt) @ w_out


def hybrid_layer(x, y, c_silu, cc_silu, ada_w, ada_b, norm_w, w_in, ret_log_decay, ret_gn_w, na_rpb,
                 q_norm_w, k_norm_w, w_ret_o, w_na_o, w_gqa_o, w_out, need_ctx):
    b, n, _ = x.shape
    l = y.shape[1]
    rows = n // GRID_W
    g_grp = GQA_HEADS // GQA_KV_HEADS
    shift_x, scale_x, gate_x = jnp.split((c_silu @ ada_w + ada_b)[:, None, :], 3, axis=-1)
    shift_y, scale_y, gate_y = jnp.split(cc_silu @ ada_w + ada_b, 3, axis=-1)
    hx = rms_norm(x, norm_w) * (1.0 + scale_x) + shift_x
    hy = rms_norm(y, norm_w) * (1.0 + scale_y) + shift_y
    rq, rk, rv, rg, nq, nk, nv, ng, gq, gk, gv, gg, mg = split_cols(hx @ w_in)
    crq, crk, crv, crg, cnq, cnk, cnv, cng, cgq, cgk, cgv, cgg, cmg = split_cols(hy @ w_in)

    log_g = -jnp.exp(ret_log_decay.astype(jnp.float32))
    ksc = RET_DK ** -0.5
    o_lat, o_ctx = bidir_retention(heads(rq, RET_HEADS), heads(rk, RET_HEADS) * ksc, heads(rv, RET_HEADS),
                                   heads(crq, RET_HEADS), heads(crk, RET_HEADS) * ksc, heads(crv, RET_HEADS),
                                   log_g, need_ctx)
    ret_x = head_group_norm(o_lat, ret_gn_w) * jax.nn.silu(rg)

    kc_na = heads(cnk, NA_HEADS)
    vc_na = heads(cnv, NA_HEADS)
    na_x = neighbourhood_attention(heads(nq, NA_HEADS), heads(nk, NA_HEADS), heads(nv, NA_HEADS),
                                   kc_na, vc_na, na_rpb, rows) * jax.nn.silu(ng)

    kc_g = rms_norm(heads(cgk, GQA_KV_HEADS), k_norm_w)
    vc_g = heads(cgv, GQA_KV_HEADS)
    q_g = axial_rope(rms_norm(heads(gq, GQA_HEADS), q_norm_w))
    k_g = axial_rope(rms_norm(heads(gk, GQA_KV_HEADS), k_norm_w))
    k_all = jnp.concatenate([k_g, kc_g], axis=1)
    v_all = jnp.concatenate([heads(gv, GQA_KV_HEADS), vc_g], axis=1)
    gqa_x = gqa_blocks(q_g, k_all, v_all) * jax.nn.silu(gg)

    x = x + gate_x * merge_branches(ret_x, na_x, gqa_x, mg, w_ret_o, w_na_o, w_gqa_o, w_out)

    if need_ctx:
        ret_y = head_group_norm(o_ctx, ret_gn_w) * jax.nn.silu(crg)
        na_y = attend(heads(cnq, NA_HEADS)[:, :, :, None, :], kc_na, vc_na).reshape(b, l, NA_W) * jax.nn.silu(cng)
        qc_g = rms_norm(heads(cgq, GQA_HEADS), q_norm_w).reshape(b, l, GQA_KV_HEADS, g_grp, GQA_DH)
        gqa_y = attend(qc_g, kc_g, vc_g).reshape(b, l, GQA_W) * jax.nn.silu(cgg)
        y = y + gate_y * merge_branches(ret_y, na_y, gqa_y, cmg, w_ret_o, w_na_o, w_gqa_o, w_out)
    return x, y


def setup_inputs(seed: int = 0) -> dict:
    key = jax.random.key(seed)
    ks = jax.random.split(key, 18)
    f32 = jnp.float32
    d = D_MODEL

    def nrm(k, shape, scale):
        return jax.random.normal(k, shape, f32) * scale

    decay_base = jnp.asarray(np.log(-np.log(1.0 - 2.0 ** (-5.0 - np.arange(RET_HEADS)))), f32)
    return {
        'x': nrm(ks[0], (BATCH, SEQ, d), 1.0),
        'c': nrm(ks[1], (BATCH, d), 1.0),
        'ctx': nrm(ks[2], (BATCH, CTX_LEN, d), 1.0),
        'c_ctx': nrm(ks[3], (d,), 1.0),
        'ada_w': nrm(ks[4], (DEPTH, d, 3 * d), d ** -0.5),
        'ada_b': nrm(ks[5], (DEPTH, 3 * d), 0.02),
        'norm_w': 1.0 + nrm(ks[6], (DEPTH, d), 0.02),
        'w_in': nrm(ks[7], (DEPTH, d, IN_COLS), d ** -0.5),
        'ret_log_decay': decay_base + nrm(ks[8], (DEPTH, 2, RET_HEADS), 0.1),
        'ret_gn_w': 1.0 + nrm(ks[9], (DEPTH, RET_W), 0.02),
        'na_rpb': nrm(ks[10], (DEPTH, NA_HEADS, 2 * NA_WIN_ROWS - 1, 2 * NA_WIN_COLS - 1), 0.05),
        'q_norm_w': 1.0 + nrm(ks[11], (DEPTH, GQA_DH), 0.02),
        'k_norm_w': 1.0 + nrm(ks[12], (DEPTH, GQA_DH), 0.02),
        'w_ret_o': nrm(ks[13], (DEPTH, RET_W, d), RET_W ** -0.5),
        'w_na_o': nrm(ks[14], (DEPTH, NA_W, d), NA_W ** -0.5),
        'w_gqa_o': nrm(ks[15], (DEPTH, GQA_W, d), GQA_W ** -0.5),
        'w_out': nrm(ks[16], (DEPTH, d, d), d ** -0.5),
        'final_norm_w': 1.0 + nrm(ks[17], (d,), 0.02),
    }


def reference(x, c, ctx, c_ctx, ada_w, ada_b, norm_w, w_in, ret_log_decay, ret_gn_w, na_rpb,
              q_norm_w, k_norm_w, w_ret_o, w_na_o, w_gqa_o, w_out, final_norm_w):
    c_silu = jax.nn.silu(c)
    cc_silu = jax.nn.silu(c_ctx)
    y = ctx
    for layer in range(DEPTH):
        x, y = hybrid_layer(x, y, c_silu, cc_silu, ada_w[layer], ada_b[layer], norm_w[layer], w_in[layer],
                            ret_log_decay[layer], ret_gn_w[layer], na_rpb[layer], q_norm_w[layer], k_norm_w[layer],
                            w_ret_o[layer], w_na_o[layer], w_gqa_o[layer], w_out[layer],
                            need_ctx=layer < DEPTH - 1)
    return rms_norm(x, final_norm_w)
```

```cpp
#include <hip/hip_runtime.h>
#include <hip/hip_cooperative_groups.h>
#include <cstdio>
#include <cstdint>
namespace cg = cooperative_groups;

#ifndef MULTI_LAUNCH
#define MULTI_LAUNCH 0
#endif

typedef unsigned short bf16_t;
typedef short bf16x8 __attribute__((ext_vector_type(8)));
typedef float f32x4 __attribute__((ext_vector_type(4)));
typedef unsigned u32x4 __attribute__((ext_vector_type(4)));
typedef unsigned u32x2 __attribute__((ext_vector_type(2)));

#define DM 1024
#define NTOK 32768
#define NROWS 33792
#define PC 5376
#define INC 8448
#define LOG2E 1.4426950408889634f
#define EPSN 1e-6f
#define LDS_BYTES 73728

#define C_RQ 0
#define C_RK 512
#define C_RV 1024
#define C_RG 1536
#define C_NQ 2048
#define C_NK 2560
#define C_NV 3072
#define C_NG 3584
#define C_GQ 4096
#define C_GK 4608
#define C_GV 4736
#define C_GG 4864
#define C_M  512

#define WT_IN 0
#define WT_RET (8448 * 1024)
#define WT_NA (WT_RET + 1024 * 512)
#define WT_GQA (WT_NA + 1024 * 512)
#define WT_OUT (WT_GQA + 1024 * 512)
#define WT_TOTAL (WT_OUT + 1024 * 1024)

struct Params {
    const float *x, *c, *ctx, *c_ctx, *ada_w, *ada_b, *norm_w, *w_in, *ret_log_decay, *ret_gn_w, *na_rpb, *q_norm_w, *k_norm_w,
        *w_ret_o, *w_na_o, *w_gqa_o, *w_out, *final_norm_w;
    float* out;
    bf16_t* P;
    bf16_t* HX;
    bf16_t* Wt;
    bf16_t* SU;
    float* y;
    float* mod;
    float* rope;
};

__device__ __forceinline__ int tid_opaque() { int t = threadIdx.x; asm volatile("" : "+v"(t)); return t; }
__device__ __forceinline__ float bf2f(bf16_t v) { return __uint_as_float(((unsigned)v) << 16); }
typedef __bf16 bf16x2_t __attribute__((ext_vector_type(2)));
typedef float f32x2_t __attribute__((ext_vector_type(2)));
__device__ __forceinline__ unsigned pk2(float lo, float hi) {
    f32x2_t v = {lo, hi};
    union { bf16x2_t b; unsigned u; } x; x.b = __builtin_convertvector(v, bf16x2_t); return x.u;
}
__device__ __forceinline__ bf16_t f2bf(float f) { return (bf16_t)(pk2(f, 0.f) & 0xffffu); }
__device__ __forceinline__ float lo16(unsigned u) { return __uint_as_float(u << 16); }
__device__ __forceinline__ float hi16(unsigned u) { return __uint_as_float(u & 0xffff0000u); }
__device__ __forceinline__ float ex2(float x) { return __builtin_amdgcn_exp2f(x); }
__device__ __forceinline__ float silu_f(float x) { return x * __builtin_amdgcn_rcpf(1.f + ex2(-x * LOG2E)); }
__device__ __forceinline__ float sigm_f(float x) { return __builtin_amdgcn_rcpf(1.f + ex2(-x * LOG2E)); }
__device__ __forceinline__ f32x4 mfma16(bf16x8 a, bf16x8 b, f32x4 c) { return __builtin_amdgcn_mfma_f32_16x16x32_bf16(a, b, c, 0, 0, 0); }
__device__ __forceinline__ bf16x8 as_bf(u32x4 u) { union { u32x4 a; bf16x8 b; } x; x.a = u; return x.b; }
__device__ __forceinline__ u32x4 as_u(bf16x8 u) { union { u32x4 a; bf16x8 b; } x; x.b = u; return x.a; }
__device__ __forceinline__ u32x4 ldg16(const bf16_t* p) { return *(const u32x4*)p; }

template <int NI>
__device__ __forceinline__ void gemm_core(f32x4 (&acc)[NI][4], const bf16_t* __restrict__ X, int ldx, const bf16_t* __restrict__ W, int ldw, int K, unsigned char* lds) {
    const int t = tid_opaque(), lane = t & 63, w = t >> 6, wm = w >> 1, wn = w & 1;
    bf16_t* Xs = (bf16_t*)lds;
    bf16_t* Ws = Xs + 2 * 128 * 72;
    const int sr = t >> 3, sc = (t & 7) * 8;
    const bf16_t* xg = X + (size_t)sr * ldx + sc;
    const bf16_t* wg = W + (size_t)sr * ldw + sc;
    u32x4 xr[4], wr[NI];
#pragma unroll
    for (int i = 0; i < 4; ++i) xr[i] = ldg16(xg + (size_t)i * 32 * ldx);
#pragma unroll
    for (int i = 0; i < NI; ++i) wr[i] = ldg16(wg + (size_t)i * 32 * ldw);
    __syncthreads();
#pragma unroll
    for (int i = 0; i < 4; ++i) *(u32x4*)(Xs + (sr + i * 32) * 72 + sc) = xr[i];
#pragma unroll
    for (int i = 0; i < NI; ++i) *(u32x4*)(Ws + (sr + i * 32) * 72 + sc) = wr[i];
    __syncthreads();
    const int nk = K >> 6;
    for (int kt = 0; kt < nk; ++kt) {
        const int cur = kt & 1;
        if (kt + 1 < nk) {
            const int ko = (kt + 1) * 64;
#pragma unroll
            for (int i = 0; i < 4; ++i) xr[i] = ldg16(xg + (size_t)i * 32 * ldx + ko);
#pragma unroll
            for (int i = 0; i < NI; ++i) wr[i] = ldg16(wg + (size_t)i * 32 * ldw + ko);
        }
        const bf16_t* xs = Xs + cur * 128 * 72 + (wm * 64 + (lane & 15)) * 72 + (lane >> 4) * 8;
        const bf16_t* ws = Ws + cur * 128 * 72 + (wn * (NI * 16) + (lane & 15)) * 72 + (lane >> 4) * 8;
#pragma unroll
        for (int ks = 0; ks < 2; ++ks) {
            bf16x8 xf[4], wf[NI];
#pragma unroll
            for (int i = 0; i < 4; ++i) xf[i] = *(const bf16x8*)(xs + i * 16 * 72 + ks * 32);
#pragma unroll
            for (int i = 0; i < NI; ++i) wf[i] = *(const bf16x8*)(ws + i * 16 * 72 + ks * 32);
#pragma unroll
            for (int ni = 0; ni < NI; ++ni)
#pragma unroll
                for (int mi = 0; mi < 4; ++mi) acc[ni][mi] = mfma16(wf[ni], xf[mi], acc[ni][mi]);
        }
        if (kt + 1 < nk) {
            const int nx = cur ^ 1;
#pragma unroll
            for (int i = 0; i < 4; ++i) *(u32x4*)(Xs + nx * 128 * 72 + (sr + i * 32) * 72 + sc) = xr[i];
#pragma unroll
            for (int i = 0; i < NI; ++i) *(u32x4*)(Ws + nx * 128 * 72 + (sr + i * 32) * 72 + sc) = wr[i];
        }
        __syncthreads();
    }
}

__device__ void adaln_item(const Params& p, int item, unsigned char* lds) {
    const int t = tid_opaque(), lane = t & 63, w = t >> 6;
    const int l = item / 48, cgp = item % 48, j = cgp * 64 + lane;
    float* cs = (float*)lds;
    float* red = (float*)(lds + 20480);
    __syncthreads();
    for (int idx = t; idx < 5120; idx += 256) {
        const int bb = idx >> 10, k = idx & 1023;
        const float v = bb < 4 ? p.c[bb * 1024 + k] : p.c_ctx[k];
        cs[idx] = silu_f(v);
    }
    __syncthreads();
    float a0 = 0.f, a1 = 0.f, a2 = 0.f, a3 = 0.f, a4 = 0.f;
    const float* aw = p.ada_w + ((size_t)l * 1024 + w * 256) * 3072 + j;
    for (int k = 0; k < 256; ++k) {
        const float wv = aw[(size_t)k * 3072];
        const int kk = w * 256 + k;
        a0 += cs[kk] * wv; a1 += cs[1024 + kk] * wv; a2 += cs[2048 + kk] * wv; a3 += cs[3072 + kk] * wv; a4 += cs[4096 + kk] * wv;
    }
    red[(w * 5 + 0) * 64 + lane] = a0; red[(w * 5 + 1) * 64 + lane] = a1; red[(w * 5 + 2) * 64 + lane] = a2;
    red[(w * 5 + 3) * 64 + lane] = a3; red[(w * 5 + 4) * 64 + lane] = a4;
    __syncthreads();
    for (int idx = t; idx < 320; idx += 256) {
        const int bb = idx >> 6, ln = idx & 63;
        float v = p.ada_b[l * 3072 + cgp * 64 + ln];
#pragma unroll
        for (int ww = 0; ww < 4; ++ww) v += red[(ww * 5 + bb) * 64 + ln];
        p.mod[(l * 5 + bb) * 3072 + cgp * 64 + ln] = v;
    }
}

__device__ void transpose_tile(const float* __restrict__ src, int N, bf16_t* __restrict__ dst, int K, int k0, int n0, unsigned char* lds) {
    const int t = tid_opaque();
    bf16_t* T = (bf16_t*)lds;
    __syncthreads();
#pragma unroll
    for (int i = 0; i < 4; ++i) {
        const int k = (t >> 4) + 16 * i, n4 = (t & 15) * 4;
        const f32x4 v = *(const f32x4*)(src + (size_t)(k0 + k) * N + n0 + n4);
        T[(n4 + 0) * 72 + k] = f2bf(v[0]); T[(n4 + 1) * 72 + k] = f2bf(v[1]); T[(n4 + 2) * 72 + k] = f2bf(v[2]); T[(n4 + 3) * 72 + k] = f2bf(v[3]);
    }
    __syncthreads();
#pragma unroll
    for (int i = 0; i < 2; ++i) {
        const int cidx = t + 256 * i, n = cidx >> 3, kc = cidx & 7;
        *(u32x4*)(dst + (size_t)(n0 + n) * K + k0 + kc * 8) = *(const u32x4*)(T + n * 72 + kc * 8);
    }
}

#define NCONV_ITEMS (2112 + 3 * 128 + 256)
__device__ void convert_item(const Params& p, int l, int item, unsigned char* lds) {
    if (item < 2112) {
        const int kt = item / 132, nt = item % 132;
        transpose_tile(p.w_in + (size_t)l * 1024 * INC, INC, p.Wt + WT_IN, 1024, kt * 64, nt * 64, lds);
    } else if (item < 2112 + 384) {
        const int it = item - 2112, which = it / 128, r = it % 128, kt = r / 16, nt = r % 16;
        const float* src = (which == 0 ? p.w_ret_o : which == 1 ? p.w_na_o : p.w_gqa_o) + (size_t)l * 512 * 1024;
        bf16_t* dst = p.Wt + (which == 0 ? WT_RET : which == 1 ? WT_NA : WT_GQA);
        transpose_tile(src, 1024, dst, 512, kt * 64, nt * 64, lds);
    } else {
        const int it = item - 2112 - 384, kt = it / 16, nt = it % 16;
        transpose_tile(p.w_out + (size_t)l * 1024 * 1024, 1024, p.Wt + WT_OUT, 1024, kt * 64, nt * 64, lds);
    }
}

__device__ void rope_table(const Params& p) {
    for (int idx = tid_opaque(); idx < 2048; idx += 256) {
        const int pos = idx >> 4, i = idx & 15;
        const float f = ex2(-(float)i * (13.287712379549449f / 16.f));
        const float ang = (float)pos * f;
        float rev = ang * 0.15915494309189535f;
        rev = rev - rintf(rev);
        p.rope[idx * 2 + 0] = __builtin_amdgcn_cosf(rev);
        p.rope[idx * 2 + 1] = __builtin_amdgcn_sinf(rev);
    }
}

__device__ void phase_p0(const Params& p, unsigned char* lds) {
    const int total = 192 + NCONV_ITEMS + 1;
    for (int item = blockIdx.x; item < total; item += gridDim.x) {
        if (item < 192) adaln_item(p, item, lds);
        else if (item < 192 + NCONV_ITEMS) convert_item(p, 0, item - 192, lds);
        else rope_table(p);
    }
}

__device__ void norm_rows(const Params& p, int lnext, const float* xsrc, const float* ysrc) {
    const int t = tid_opaque(), lane = t & 63, w = t >> 6;
    const int nrows = lnext < 4 ? NROWS : NTOK;
    for (int row = blockIdx.x * 4 + w; row < nrows; row += gridDim.x * 4) {
        const float* src = row < NTOK ? xsrc + (size_t)row * DM : ysrc + (size_t)(row - NTOK) * DM;
        f32x4 v[4];
        float ss = 0.f;
#pragma unroll
        for (int i = 0; i < 4; ++i) { v[i] = *(const f32x4*)(src + i * 256 + lane * 4); ss += v[i][0] * v[i][0] + v[i][1] * v[i][1] + v[i][2] * v[i][2] + v[i][3] * v[i][3]; }
#pragma unroll
        for (int o = 32; o >= 1; o >>= 1) ss += __shfl_xor(ss, o);
        const float rstd = rsqrtf(ss * (1.f / 1024.f) + EPSN);
        if (lnext < 4) {
            const int bb = row < NTOK ? (row >> 13) : 4;
            const float* md = p.mod + (size_t)(lnext * 5 + bb) * 3072;
            const float* nw = p.norm_w + lnext * 1024;
#pragma unroll
            for (int i = 0; i < 4; ++i) {
                const int col = i * 256 + lane * 4;
                const f32x4 nwv = *(const f32x4*)(nw + col), sh = *(const f32x4*)(md + col), scl = *(const f32x4*)(md + 1024 + col);
                f32x4 h = v[i] * rstd * nwv * (scl + 1.f) + sh;
                u32x2 o2; o2.x = pk2(h[0], h[1]); o2.y = pk2(h[2], h[3]);
                *(u32x2*)(p.HX + (size_t)row * DM + col) = o2;
            }
        } else {
#pragma unroll
            for (int i = 0; i < 4; ++i) {
                const int col = i * 256 + lane * 4;
                const f32x4 nwv = *(const f32x4*)(p.final_norm_w + col);
                f32x4 ov = v[i] * rstd * nwv;
#ifdef SANITIZE
                for (int e = 0; e < 4; ++e) if (!(fabsf(ov[e]) < 1e30f)) ov[e] = 1000.f;
#endif
                *(f32x4*)(p.out + (size_t)row * DM + col) = ov;
            }
        }
    }
}

__device__ void phase_a(const Params& p, int l, unsigned char* lds) {
    const int t = tid_opaque(), lane = t & 63, w = t >> 6, wm = w >> 1, wn = w & 1;
    const int total = 264 * 42;
    for (int item = blockIdx.x; item < total; item += gridDim.x) {
        const int mt = item / 42, nt = item % 42;
        f32x4 acc[4][4];
#pragma unroll
        for (int a = 0; a < 4; ++a)
#pragma unroll
            for (int b = 0; b < 4; ++b) acc[a][b] = (f32x4){0.f, 0.f, 0.f, 0.f};
        gemm_core<4>(acc, p.HX + (size_t)mt * 128 * DM, DM, p.Wt + WT_IN + (size_t)nt * 128 * DM, DM, DM, lds);
#pragma unroll
        for (int ni = 0; ni < 4; ++ni)
#pragma unroll
            for (int mi = 0; mi < 4; ++mi) {
                const int n = nt * 128 + wn * 64 + ni * 16 + (lane >> 4) * 4, m = mt * 128 + wm * 64 + mi * 16 + (lane & 15);
                u32x2 o2; o2.x = pk2(acc[ni][mi][0], acc[ni][mi][1]); o2.y = pk2(acc[ni][mi][2], acc[ni][mi][3]);
                *(u32x2*)(p.P + (size_t)m * PC + n) = o2;
            }
    }
}

__device__ __forceinline__ int chunk_row(int b, int cidx) { return cidx < 64 ? b * 8192 + cidx * 128 : NTOK + b * 256 + (cidx - 64) * 128; }

__device__ void ret_state_item(const Params& p, int l, int b, int h, int cidx, unsigned char* lds) {
    const int t = tid_opaque(), lane = t & 63, w = t >> 6, g = lane >> 4, c = lane & 15;
    bf16_t* Ktf = (bf16_t*)lds;
    bf16_t* Vt = Ktf + 128 * 72;
    const float lgf = -__expf(p.ret_log_decay[l * 8 + h]) * LOG2E, lgb = -__expf(p.ret_log_decay[l * 8 + 4 + h]) * LOG2E;
    const float ksc = 0.08838834764831845f;
    const int rowbase = chunk_row(b, cidx);
    for (int dir = 0; dir < 2; ++dir) {
        f32x4 acc[2][8];
#pragma unroll
        for (int i = 0; i < 2; ++i)
#pragma unroll
            for (int d = 0; d < 8; ++d) acc[i][d] = (f32x4){0.f, 0.f, 0.f, 0.f};
        const float lg = dir ? lgb : lgf;
#pragma unroll 1
        for (int half = 0; half < 2; ++half) {
            __syncthreads();
#pragma unroll
            for (int i = 0; i < 4; ++i) {
                const int cc = t + 256 * i, tok = cc & 63, dch = cc >> 6, j = half * 64 + tok;
                const float wgt = ex2(lg * (float)(dir ? j : 127 - j)) * ksc;
                const bf16_t* rp = p.P + (size_t)(rowbase + j) * PC + h * 128 + dch * 8;
                const u32x4 kv = ldg16(rp + C_RK), vv = ldg16(rp + C_RV);
#pragma unroll
                for (int e = 0; e < 4; ++e) {
                    const int r0 = (dch * 8 + 2 * e) * 72 + tok, r1 = r0 + 72;
                    Ktf[r0] = f2bf(lo16(kv[e]) * wgt); Ktf[r1] = f2bf(hi16(kv[e]) * wgt);
                    Vt[r0] = (bf16_t)(vv[e] & 0xffffu); Vt[r1] = (bf16_t)(vv[e] >> 16);
                }
            }
            __syncthreads();
#pragma unroll
            for (int ks = 0; ks < 2; ++ks) {
                bf16x8 kf[2];
#pragma unroll
                for (int i = 0; i < 2; ++i) kf[i] = *(const bf16x8*)(Ktf + (w * 32 + i * 16 + c) * 72 + ks * 32 + g * 8);
#pragma unroll
                for (int d = 0; d < 8; ++d) {
                    const bf16x8 vf = *(const bf16x8*)(Vt + (d * 16 + c) * 72 + ks * 32 + g * 8);
#pragma unroll
                    for (int i = 0; i < 2; ++i) acc[i][d] = mfma16(kf[i], vf, acc[i][d]);
                }
            }
        }
        bf16_t* Sd = p.SU + ((size_t)((dir * 4 + b) * 4 + h) * 66 + cidx) * 16384;
#pragma unroll
        for (int i = 0; i < 2; ++i)
#pragma unroll
            for (int d = 0; d < 8; ++d) {
                const int dk = w * 32 + i * 16 + g * 4, dv = d * 16 + c;
                u32x2 o2; o2.x = pk2(acc[i][d][0], acc[i][d][1]); o2.y = pk2(acc[i][d][2], acc[i][d][3]);
                *(u32x2*)(Sd + dv * 128 + dk) = o2;
            }
    }
}

__device__ void qk_prep_item(const Params& p, int l, int item) {
    const int t = tid_opaque(), tok = t >> 2, sub = t & 3;
    const int row = item * 64 + tok;
    const bool lat = row < NTOK;
    const int tseq = row & 8191, pr = tseq >> 6, pc = tseq & 63;
    for (int hv = sub; hv < 10; hv += 4) {
        bf16_t* ptr = p.P + (size_t)row * PC + (hv < 8 ? C_GQ + hv * 64 : C_GK + (hv - 8) * 64);
        const float* nw = hv < 8 ? p.q_norm_w + l * 64 : p.k_norm_w + l * 64;
        float x[64];
        float ss = 0.f;
#pragma unroll
        for (int i = 0; i < 8; ++i) {
            const u32x4 u = ldg16(ptr + i * 8);
#pragma unroll
            for (int e = 0; e < 4; ++e) { x[i * 8 + 2 * e] = lo16(u[e]); x[i * 8 + 2 * e + 1] = hi16(u[e]); }
        }
#pragma unroll
        for (int d = 0; d < 64; ++d) ss += x[d] * x[d];
        const float rstd = rsqrtf(ss * (1.f / 64.f) + EPSN);
#pragma unroll
        for (int d = 0; d < 64; ++d) x[d] = x[d] * rstd * nw[d];
        if (lat) {
#pragma unroll
            for (int i = 0; i < 16; ++i) {
                const float cr = p.rope[(pr * 16 + i) * 2], sr = p.rope[(pr * 16 + i) * 2 + 1];
                const float cc = p.rope[(pc * 16 + i) * 2], sc = p.rope[(pc * 16 + i) * 2 + 1];
                const float a = x[i], b2 = x[16 + i], a2 = x[32 + i], b3 = x[48 + i];
                x[i] = a * cr - b2 * sr; x[16 + i] = b2 * cr + a * sr;
                x[32 + i] = a2 * cc - b3 * sc; x[48 + i] = b3 * cc + a2 * sc;
            }
        }
#pragma unroll
        for (int i = 0; i < 8; ++i) {
            u32x4 u;
#pragma unroll
            for (int e = 0; e < 4; ++e) u[e] = pk2(x[i * 8 + 2 * e], x[i * 8 + 2 * e + 1]);
            *(u32x4*)(ptr + i * 8) = u;
        }
    }
}

__device__ void phase_b(const Params& p, int l, unsigned char* lds) {
    const int total = 1056 + 528;
    for (int item = blockIdx.x; item < total; item += gridDim.x) {
        if (item < 1056) { const int cidx = item % 66, bh = item / 66; ret_state_item(p, l, bh >> 2, bh & 3, cidx, lds); }
        else qk_prep_item(p, l, item - 1056);
    }
}

__device__ void phase_c(const Params& p, int l) {
    const int t = tid_opaque();
    for (int item = blockIdx.x; item < 256; item += gridDim.x) {
        const int part = item & 7, dbh = item >> 3, dir = dbh >> 4, h = dbh & 3;
        const float lg = -__expf(p.ret_log_decay[l * 8 + dir * 4 + h]) * LOG2E;
        const float gc = ex2(lg * 128.f);
        bf16_t* base = p.SU + (size_t)dbh * 66 * 16384 + part * 2048 + t * 8;
        float s[8];
#pragma unroll
        for (int e = 0; e < 8; ++e) s[e] = 0.f;
        for (int st0 = 0; st0 < 66; st0 += 11) {
            u32x4 u[11];
#pragma unroll
            for (int q = 0; q < 11; ++q) {
                const int st = st0 + q;
                const int n = dir == 0 ? (st < 2 ? 64 + st : st - 2) : (st < 2 ? 65 - st : 65 - st);
                u[q] = *(const u32x4*)(base + (size_t)n * 16384);
            }
#pragma unroll
            for (int q = 0; q < 11; ++q) {
                const int st = st0 + q;
                const int n = dir == 0 ? (st < 2 ? 64 + st : st - 2) : (st < 2 ? 65 - st : 65 - st);
                u32x4 o;
#pragma unroll
                for (int e = 0; e < 4; ++e) o[e] = pk2(s[2 * e], s[2 * e + 1]);
                *(u32x4*)(base + (size_t)n * 16384) = o;
#pragma unroll
                for (int e = 0; e < 4; ++e) { s[2 * e] = gc * s[2 * e] + lo16(u[q][e]); s[2 * e + 1] = gc * s[2 * e + 1] + hi16(u[q][e]); }
            }
        }
    }
}

template <int MODE>
__device__ void attn_item(const Params& p, int l, int b, int i1, int i2, int i3, unsigned char* lds) {
    constexpr int NQB = (MODE == 2) ? 2 : 4, NHQ = NQB / 2;
    const int t = tid_opaque(), lane = t & 63, w = t >> 6, g = lane >> 4, c = lane & 15;
    bf16_t* Ks = (bf16_t*)lds;
    bf16_t* Vt = Ks + 2 * 64 * 72;
    u32x4* Qs = (u32x4*)(lds + 36864) + w * 512;
    float* rpbs = (float*)(lds + 36864 + 32768);
    int qbase, qstep, qcol, kcol, vcol, gcol, ntiles;
    int R0 = 0, c0 = 0, start = 0, bstart = 0, hh = 0;
    if (MODE == 0 || MODE == 1) {
        const int kvh = i1, qt = i2, head = kvh * 4 + w;
        qbase = (MODE == 0 ? b * 8192 : NTOK + b * 256) + qt * 64; qstep = 16;
        qcol = C_GQ + head * 64; kcol = C_GK + kvh * 64; vcol = C_GV + kvh * 64; gcol = C_GG + head * 64;
        ntiles = MODE == 0 ? 132 : 4;
    } else if (MODE == 2) {
        hh = i1; R0 = i2 * 8; c0 = i3 * 16;
        start = min(max(R0 - 4, 0), 112); bstart = min(max(c0 - 8, 0), 32);
        qbase = b * 8192 + (R0 + w * 2) * 64 + c0; qstep = 64;
        qcol = C_NQ + hh * 64; kcol = C_NK + hh * 64; vcol = C_NV + hh * 64; gcol = C_NG + hh * 64;
        ntiles = 12;
    } else {
        hh = i1;
        qbase = NTOK + b * 256 + w * 64; qstep = 16;
        qcol = C_NQ + hh * 64; kcol = C_NK + hh * 64; vcol = C_NV + hh * 64; gcol = C_NG + hh * 64;
        ntiles = 4;
    }
    const float scale = 0.125f * LOG2E;
    f32x4 o[NQB][4];
    float mrun[NQB], lsum[NQB];
#pragma unroll
    for (int qb = 0; qb < NQB; ++qb) {
        mrun[qb] = -INFINITY; lsum[qb] = 0.f;
#pragma unroll
        for (int d = 0; d < 4; ++d) o[qb][d] = (f32x4){0.f, 0.f, 0.f, 0.f};
    }
    const int kkey = t >> 3, kch = (t & 7) * 8;
    const int vkey = t & 63, vch = (t >> 6);
    u32x4 kr[2], vr[2];
    auto load_tile = [&](int tt) {
        int base, rstep;
        if (MODE == 0) { base = tt < 128 ? b * 8192 + tt * 64 : NTOK + b * 256 + (tt - 128) * 64; rstep = 32; }
        else if (MODE == 2) {
            if (tt < 4) { base = NTOK + b * 256 + tt * 64; rstep = 32; }
            else { base = b * 8192 + (start + 2 * (tt - 4)) * 64 + bstart; rstep = 64; }
        } else { base = NTOK + b * 256 + tt * 64; rstep = 32; }
#pragma unroll
        for (int i = 0; i < 2; ++i) {
            const int key = kkey + 32 * i;
            kr[i] = ldg16(p.P + (size_t)(base + (key >> 5) * rstep + (key & 31)) * PC + kcol + kch);
            vr[i] = ldg16(p.P + (size_t)(base + (vkey >> 5) * rstep + (vkey & 31)) * PC + vcol + (vch + 4 * i) * 8);
        }
    };
    auto store_tile = [&](int buf) {
        bf16_t* ks_ = Ks + buf * 64 * 72; bf16_t* vt_ = Vt + buf * 64 * 72;
#pragma unroll
        for (int i = 0; i < 2; ++i) {
            *(u32x4*)(ks_ + (kkey + 32 * i) * 72 + kch) = kr[i];
#pragma unroll
            for (int e = 0; e < 4; ++e) {
                const int d = (vch + 4 * i) * 8 + 2 * e;
                vt_[d * 72 + vkey] = (bf16_t)(vr[i][e] & 0xffffu);
                vt_[(d + 1) * 72 + vkey] = (bf16_t)(vr[i][e] >> 16);
            }
        }
    };
    load_tile(0);
    __syncthreads();
#pragma unroll
    for (int qb = 0; qb < NQB; ++qb)
#pragma unroll
        for (int ks = 0; ks < 2; ++ks) Qs[(qb * 2 + ks) * 64 + lane] = ldg16(p.P + (size_t)(qbase + qb * qstep + c) * PC + qcol + ks * 32 + g * 8);
    if (MODE == 2) for (int idx = t; idx < 465; idx += 256) rpbs[idx] = p.na_rpb[((size_t)l * 8 + hh) * 465 + idx] * LOG2E;
    store_tile(0);
    __syncthreads();
    const int wlo = min(max(R0 + w * 2 - 4, 0), 120), whi = min(max(R0 + w * 2 + 1 - 4, 0), 120) + 7;
    int colterm[8];
    if (MODE == 2) {
        const int qc = c0 + c, cs = min(max(qc - 8, 0), 48);
#pragma unroll
        for (int j = 0; j < 8; ++j) {
            const int kc = bstart + (j >> 2) * 16 + g * 4 + (j & 3);
            colterm[j] = ((unsigned)(kc - cs) < 16u) ? (kc - qc + 15) : -1;
        }
    }
    for (int tt = 0; tt < ntiles; ++tt) {
        const int cur = tt & 1;
        if (tt + 1 < ntiles) load_tile(tt + 1);
        bool skip = false;
        int krow0 = 0;
        if (MODE == 2 && tt >= 4) { krow0 = start + 2 * (tt - 4); skip = (krow0 + 1 < wlo) || (krow0 > whi); }
        if (!skip) {
            const bf16_t* ks_ = Ks + cur * 64 * 72; const bf16_t* vt_ = Vt + cur * 64 * 72;
#pragma unroll
            for (int hq = 0; hq < NHQ; ++hq) {
                f32x4 s[2][4];
#pragma unroll
                for (int qq = 0; qq < 2; ++qq)
#pragma unroll
                    for (int kb = 0; kb < 4; ++kb) s[qq][kb] = (f32x4){0.f, 0.f, 0.f, 0.f};
#pragma unroll
                for (int ks = 0; ks < 2; ++ks) {
                    const bf16x8 q0 = as_bf(Qs[((hq * 2) * 2 + ks) * 64 + lane]), q1 = as_bf(Qs[((hq * 2 + 1) * 2 + ks) * 64 + lane]);
#pragma unroll
                    for (int kb = 0; kb < 4; ++kb) {
                        const bf16x8 kf = *(const bf16x8*)(ks_ + (kb * 16 + c) * 72 + ks * 32 + g * 8);
                        s[0][kb] = mfma16(kf, q0, s[0][kb]);
                        s[1][kb] = mfma16(kf, q1, s[1][kb]);
                    }
                }
                bf16x8 pf[2][2];
#pragma unroll
                for (int qq = 0; qq < 2; ++qq) {
                    const int qb = hq * 2 + qq;
                    if (MODE == 2 && tt >= 4) {
                        const int qrow = R0 + w * 2 + qb;
                        const int rs = min(max(qrow - 4, 0), 120);
#pragma unroll
                        for (int kb = 0; kb < 4; ++kb) {
                            const int krow = krow0 + (kb >> 1);
                            const bool rowok = (unsigned)(krow - rs) < 8u;
                            const int ridx = (krow - qrow + 7) * 31;
#pragma unroll
                            for (int r = 0; r < 4; ++r) {
                                const int ct = colterm[(kb & 1) * 4 + r];
                                const bool valid = rowok && ct >= 0;
                                const float bias = rpbs[valid ? ridx + ct : 0];
                                s[qq][kb][r] = valid ? s[qq][kb][r] * scale + bias : -INFINITY;
                            }
                        }
                    } else {
#pragma unroll
                        for (int kb = 0; kb < 4; ++kb) s[qq][kb] = s[qq][kb] * scale;
                    }
                    float tmax = s[qq][0][0];
#pragma unroll
                    for (int kb = 0; kb < 4; ++kb)
#pragma unroll
                        for (int r = 0; r < 4; ++r) tmax = fmaxf(tmax, s[qq][kb][r]);
                    tmax = fmaxf(tmax, __shfl_xor(tmax, 16)); tmax = fmaxf(tmax, __shfl_xor(tmax, 32));
                    const float mn = fmaxf(mrun[qb], tmax);
                    const float alpha = ex2(mrun[qb] - mn);
                    mrun[qb] = mn;
                    float psum = 0.f;
#pragma unroll
                    for (int kb = 0; kb < 4; ++kb)
#pragma unroll
                        for (int r = 0; r < 4; ++r) { const float pv = ex2(s[qq][kb][r] - mn); s[qq][kb][r] = pv; psum += pv; }
                    lsum[qb] = lsum[qb] * alpha + psum;
#pragma unroll
                    for (int d = 0; d < 4; ++d) o[qb][d] = o[qb][d] * alpha;
#pragma unroll
                    for (int kk = 0; kk < 2; ++kk) {
                        u32x4 u;
                        u[0] = pk2(s[qq][2 * kk][0], s[qq][2 * kk][1]); u[1] = pk2(s[qq][2 * kk][2], s[qq][2 * kk][3]);
                        u[2] = pk2(s[qq][2 * kk + 1][0], s[qq][2 * kk + 1][1]); u[3] = pk2(s[qq][2 * kk + 1][2], s[qq][2 * kk + 1][3]);
                        pf[qq][kk] = as_bf(u);
                    }
                }
#pragma unroll
                for (int kk = 0; kk < 2; ++kk)
#pragma unroll
                    for (int d = 0; d < 4; ++d) {
                        const u32x2 vlo = *(const u32x2*)(vt_ + (d * 16 + c) * 72 + kk * 32 + g * 4);
                        const u32x2 vhi = *(const u32x2*)(vt_ + (d * 16 + c) * 72 + kk * 32 + 16 + g * 4);
                        u32x4 vv; vv[0] = vlo[0]; vv[1] = vlo[1]; vv[2] = vhi[0]; vv[3] = vhi[1];
                        const bf16x8 vf = as_bf(vv);
                        o[hq * 2][d] = mfma16(vf, pf[0][kk], o[hq * 2][d]);
                        o[hq * 2 + 1][d] = mfma16(vf, pf[1][kk], o[hq * 2 + 1][d]);
                    }
            }
        }
        if (tt + 1 < ntiles) store_tile(cur ^ 1);
        __syncthreads();
    }
#pragma unroll
    for (int qb = 0; qb < NQB; ++qb) {
        float ls = lsum[qb];
        ls += __shfl_xor(ls, 16); ls += __shfl_xor(ls, 32);
        const float inv = __builtin_amdgcn_rcpf(ls);
        bf16_t* rowp = p.P + (size_t)(qbase + qb * qstep + c) * PC;
#pragma unroll
        for (int d = 0; d < 4; ++d) {
            const int dd = d * 16 + g * 4;
            const u32x2 gt = *(const u32x2*)(rowp + gcol + dd);
            const float v0 = o[qb][d][0] * inv * silu_f(lo16(gt[0])), v1 = o[qb][d][1] * inv * silu_f(hi16(gt[0]));
            const float v2 = o[qb][d][2] * inv * silu_f(lo16(gt[1])), v3 = o[qb][d][3] * inv * silu_f(hi16(gt[1]));
            u32x2 o2; o2.x = pk2(v0, v1); o2.y = pk2(v2, v3);
            *(u32x2*)(rowp + qcol + dd) = o2;
        }
    }
}

__device__ __forceinline__ bf16x8 scale_frag(bf16x8 f, float sc) {
    u32x4 u = as_u(f), r;
#pragma unroll
    for (int e = 0; e < 4; ++e) r[e] = pk2(lo16(u[e]) * sc, hi16(u[e]) * sc);
    return as_bf(r);
}

__device__ void ret_item(const Params& p, int l, int b, int h, int cidx, int hf, unsigned char* lds) {
    const int t = tid_opaque(), lane = t & 63, w = t >> 6, g = lane >> 4, c = lane & 15;
    bf16_t* B0 = (bf16_t*)lds;
    bf16_t* B1 = B0 + 128 * 136;
    const float lgf = -__expf(p.ret_log_decay[l * 8 + h]) * LOG2E, lgb = -__expf(p.ret_log_decay[l * 8 + 4 + h]) * LOG2E;
    const float ksc = 0.08838834764831845f;
    const int rowbase = chunk_row(b, cidx);
    const int ti = hf * 64 + w * 16 + c;
    bf16x8 qf[4];
#pragma unroll
    for (int ks = 0; ks < 4; ++ks) qf[ks] = as_bf(ldg16(p.P + (size_t)(rowbase + ti) * PC + C_RQ + h * 128 + ks * 32 + g * 8));
    __syncthreads();
#pragma unroll
    for (int i = 0; i < 8; ++i) {
        const int cc = t + 256 * i;
        { const int r = cc >> 4, ch = cc & 15; *(u32x4*)(B0 + r * 136 + ch * 8) = ldg16(p.P + (size_t)(rowbase + r) * PC + C_RK + h * 128 + ch * 8); }
        { const int tok = cc & 127, ch = cc >> 7;
          const u32x4 vv = ldg16(p.P + (size_t)(rowbase + tok) * PC + C_RV + h * 128 + ch * 8);
#pragma unroll
          for (int e = 0; e < 4; ++e) { B1[(ch * 8 + 2 * e) * 136 + tok] = (bf16_t)(vv[e] & 0xffffu); B1[(ch * 8 + 2 * e + 1) * 136 + tok] = (bf16_t)(vv[e] >> 16); } }
    }
    __syncthreads();
    bf16x8 pf[4];
    {
        f32x4 s[8];
#pragma unroll
        for (int kb = 0; kb < 8; ++kb) s[kb] = (f32x4){0.f, 0.f, 0.f, 0.f};
#pragma unroll
        for (int ks = 0; ks < 4; ++ks)
#pragma unroll
            for (int kb = 0; kb < 8; ++kb) {
                const bf16x8 kf = *(const bf16x8*)(B0 + (kb * 16 + c) * 136 + ks * 32 + g * 8);
                s[kb] = mfma16(kf, qf[ks], s[kb]);
            }
#pragma unroll
        for (int kb = 0; kb < 8; ++kb)
#pragma unroll
            for (int r = 0; r < 4; ++r) {
                const int j = kb * 16 + g * 4 + r, d = ti - j;
                const float wgt = d > 0 ? ex2(lgf * (float)d) : (d < 0 ? ex2(lgb * (float)(-d)) : 2.f);
                s[kb][r] *= wgt * ksc;
            }
#pragma unroll
        for (int kk = 0; kk < 4; ++kk) {
            u32x4 u;
            u[0] = pk2(s[2 * kk][0], s[2 * kk][1]); u[1] = pk2(s[2 * kk][2], s[2 * kk][3]);
            u[2] = pk2(s[2 * kk + 1][0], s[2 * kk + 1][1]); u[3] = pk2(s[2 * kk + 1][2], s[2 * kk + 1][3]);
            pf[kk] = as_bf(u);
        }
    }
    f32x4 o[8];
#pragma unroll
    for (int d = 0; d < 8; ++d) o[d] = (f32x4){0.f, 0.f, 0.f, 0.f};
#pragma unroll
    for (int kk = 0; kk < 4; ++kk)
#pragma unroll
        for (int d = 0; d < 8; ++d) {
            const u32x2 vlo = *(const u32x2*)(B1 + (d * 16 + c) * 136 + kk * 32 + g * 4);
            const u32x2 vhi = *(const u32x2*)(B1 + (d * 16 + c) * 136 + kk * 32 + 16 + g * 4);
            u32x4 vv; vv[0] = vlo[0]; vv[1] = vlo[1]; vv[2] = vhi[0]; vv[3] = vhi[1];
            o[d] = mfma16(as_bf(vv), pf[kk], o[d]);
        }
    __syncthreads();
    {
        const bf16_t* Sf = p.SU + ((size_t)((0 * 4 + b) * 4 + h) * 66 + cidx) * 16384;
        const bf16_t* Sb = p.SU + ((size_t)((1 * 4 + b) * 4 + h) * 66 + cidx) * 16384;
#pragma unroll
        for (int i = 0; i < 8; ++i) {
            const int cc = t + 256 * i, r = cc >> 4, ch = cc & 15;
            *(u32x4*)(B0 + r * 136 + ch * 8) = ldg16(Sf + r * 128 + ch * 8);
            *(u32x4*)(B1 + r * 136 + ch * 8) = ldg16(Sb + r * 128 + ch * 8);
        }
    }
    __syncthreads();
#pragma unroll
    for (int dir = 0; dir < 2; ++dir) {
        const bf16_t* Bd = dir ? B1 : B0;
        const float xi = dir == 0 ? ex2(lgf * (float)(ti + 1)) : ex2(lgb * (float)(128 - ti));
        bf16x8 qs[4];
#pragma unroll
        for (int ks = 0; ks < 4; ++ks) qs[ks] = scale_frag(qf[ks], xi);
#pragma unroll
        for (int ks = 0; ks < 4; ++ks)
#pragma unroll
            for (int d = 0; d < 8; ++d) {
                const bf16x8 sf = *(const bf16x8*)(Bd + (d * 16 + c) * 136 + ks * 32 + g * 8);
                o[d] = mfma16(sf, qs[ks], o[d]);
            }
    }
    {
        float sum = 0.f;
#pragma unroll
        for (int d = 0; d < 8; ++d) sum += (o[d][0] + o[d][1]) + (o[d][2] + o[d][3]);
        sum += __shfl_xor(sum, 16); sum += __shfl_xor(sum, 32);
        const float mu = sum * (1.f / 128.f);
        float var = 0.f;
#pragma unroll
        for (int d = 0; d < 8; ++d)
#pragma unroll
            for (int r = 0; r < 4; ++r) { const float dd = o[d][r] - mu; var += dd * dd; }
        var += __shfl_xor(var, 16); var += __shfl_xor(var, 32);
        const float rstd = rsqrtf(var * (1.f / 128.f) + EPSN);
        bf16_t* rowp = p.P + (size_t)(rowbase + ti) * PC;
#pragma unroll
        for (int d = 0; d < 8; ++d) {
            const int dv = d * 16 + g * 4;
            const f32x4 gn = *(const f32x4*)(p.ret_gn_w + l * 512 + h * 128 + dv);
            const u32x2 gt = *(const u32x2*)(rowp + C_RG + h * 128 + dv);
            const float v0 = (o[d][0] - mu) * rstd * gn[0] * silu_f(lo16(gt[0])), v1 = (o[d][1] - mu) * rstd * gn[1] * silu_f(hi16(gt[0]));
            const float v2 = (o[d][2] - mu) * rstd * gn[2] * silu_f(lo16(gt[1])), v3 = (o[d][3] - mu) * rstd * gn[3] * silu_f(hi16(gt[1]));
            u32x2 o2; o2.x = pk2(v0, v1); o2.y = pk2(v2, v3);
            *(u32x2*)(rowp + C_RQ + h * 128 + dv) = o2;
        }
    }
}

__device__ void phase_d(const Params& p, int l, unsigned char* lds) {
    const bool need_ctx = l < 3;
    const int G = gridDim.x, bid = blockIdx.x;
#pragma unroll 1
    for (int it = bid; it < 1024; it += G) attn_item<0>(p, l, it >> 8, (it >> 7) & 1, it & 127, 0, lds);
    __syncthreads();
#pragma unroll 1
    for (int it = bid; it < 2048; it += G) attn_item<2>(p, l, it >> 9, (it >> 6) & 7, (it >> 2) & 15, it & 3, lds);
    __syncthreads();
    {
        const int nch = need_ctx ? 66 : 64, n_ret = nch * 32;
#pragma unroll 1
        for (int it = G - 1 - bid; it < n_ret; it += G) {
            const int hf = it & 1, it2 = it >> 1;
            const int cidx = it2 % nch, bh = it2 / nch;
            ret_item(p, l, bh >> 2, bh & 3, cidx, hf, lds);
        }
    }
    __syncthreads();
    if (need_ctx) {
#pragma unroll 1
        for (int it = G - 1 - bid; it < 32; it += G) attn_item<1>(p, l, it >> 3, (it >> 2) & 1, it & 3, 0, lds);
        __syncthreads();
#pragma unroll 1
        for (int it = G - 1 - bid - 32; it < 32; it += G) { if (it >= 0) attn_item<3>(p, l, it >> 3, it & 7, 0, 0, lds); }
    }
}

__device__ void phase_e1(const Params& p, int l, unsigned char* lds) {
    const int t = tid_opaque(), lane = t & 63, w = t >> 6, wm = w >> 1, wn = w & 1;
    const int nmt = l < 3 ? 264 : 256;
    const int total = nmt * 16;
    for (int item = blockIdx.x; item < total; item += gridDim.x) {
        const int mt = item >> 4, nt = item & 15;
        f32x4 macc[2][4];
#pragma unroll
        for (int a = 0; a < 2; ++a)
#pragma unroll
            for (int b = 0; b < 4; ++b) macc[a][b] = (f32x4){0.f, 0.f, 0.f, 0.f};
#pragma unroll 1
        for (int br = 0; br < 3; ++br) {
            f32x4 gacc[2][4];
#pragma unroll
            for (int a = 0; a < 2; ++a)
#pragma unroll
                for (int b = 0; b < 4; ++b) gacc[a][b] = (f32x4){0.f, 0.f, 0.f, 0.f};
            gemm_core<2>(gacc, p.HX + (size_t)mt * 128 * DM, DM, p.Wt + WT_IN + (size_t)(PC + br * 1024 + nt * 64) * DM, DM, DM, lds);
#pragma unroll
            for (int a = 0; a < 2; ++a)
#pragma unroll
                for (int b = 0; b < 4; ++b)
#pragma unroll
                    for (int r = 0; r < 4; ++r) gacc[a][b][r] = sigm_f(gacc[a][b][r]);
            f32x4 pacc[2][4];
#pragma unroll
            for (int a = 0; a < 2; ++a)
#pragma unroll
                for (int b = 0; b < 4; ++b) pacc[a][b] = (f32x4){0.f, 0.f, 0.f, 0.f};
            const int xcol = br == 0 ? C_RQ : (br == 1 ? C_NQ : C_GQ);
            const int woff = br == 0 ? WT_RET : (br == 1 ? WT_NA : WT_GQA);
            gemm_core<2>(pacc, p.P + (size_t)mt * 128 * PC + xcol, PC, p.Wt + woff + (size_t)nt * 64 * 512, 512, 512, lds);
#pragma unroll
            for (int a = 0; a < 2; ++a)
#pragma unroll
                for (int b = 0; b < 4; ++b) macc[a][b] += gacc[a][b] * pacc[a][b];
        }
#pragma unroll
        for (int ni = 0; ni < 2; ++ni)
#pragma unroll
            for (int mi = 0; mi < 4; ++mi) {
                const int n = nt * 64 + wn * 32 + ni * 16 + (lane >> 4) * 4, m = mt * 128 + wm * 64 + mi * 16 + (lane & 15);
                u32x2 o2; o2.x = pk2(macc[ni][mi][0], macc[ni][mi][1]); o2.y = pk2(macc[ni][mi][2], macc[ni][mi][3]);
                *(u32x2*)(p.P + (size_t)m * PC + C_M + n) = o2;
            }
    }
}

__device__ void phase_e2(const Params& p, int l, unsigned char* lds) {
    const int t = tid_opaque(), lane = t & 63, w = t >> 6, wm = w >> 1, wn = w & 1;
    const int nmt = l < 3 ? 264 : 256;
    const int total = nmt * 8;
    const float* xsrc = l == 0 ? p.x : p.out;
    const float* ysrc = l == 0 ? p.ctx : p.y;
    for (int item = blockIdx.x; item < total; item += gridDim.x) {
        const int mt = item >> 3, nt = item & 7;
        f32x4 acc[4][4];
#pragma unroll
        for (int a = 0; a < 4; ++a)
#pragma unroll
            for (int b = 0; b < 4; ++b) acc[a][b] = (f32x4){0.f, 0.f, 0.f, 0.f};
        gemm_core<4>(acc, p.P + (size_t)mt * 128 * PC + C_M, PC, p.Wt + WT_OUT + (size_t)nt * 128 * DM, DM, DM, lds);
#pragma unroll
        for (int mi = 0; mi < 4; ++mi) {
            const int m = mt * 128 + wm * 64 + mi * 16 + (lane & 15);
            const bool lat = m < NTOK;
            const int bb = lat ? (m >> 13) : 4;
            const float* src = lat ? xsrc + (size_t)m * DM : ysrc + (size_t)(m - NTOK) * DM;
            float* dst = lat ? p.out + (size_t)m * DM : p.y + (size_t)(m - NTOK) * DM;
            const float* gate = p.mod + (size_t)(l * 5 + bb) * 3072 + 2048;
#pragma unroll
            for (int ni = 0; ni < 4; ++ni) {
                const int n = nt * 128 + wn * 64 + ni * 16 + (lane >> 4) * 4;
                const f32x4 xo = *(const f32x4*)(src + n), gv = *(const f32x4*)(gate + n);
                *(f32x4*)(dst + n) = xo + gv * acc[ni][mi];
            }
        }
    }
}

__device__ void phase_e3(const Params& p, int l, unsigned char* lds) {
    norm_rows(p, l + 1, p.out, p.y);
    if (l < 3)
        for (int item = blockIdx.x; item < NCONV_ITEMS; item += gridDim.x) convert_item(p, l + 1, item, lds);
}


#ifdef DIAG
__device__ void scan_bf16(const bf16_t* ptr, size_t n, unsigned* flag, unsigned bit) {
    const size_t nch = n / 8;
    bool bad = false;
    for (size_t i = (size_t)blockIdx.x * 256 + threadIdx.x; i < nch; i += (size_t)gridDim.x * 256) {
        const u32x4 u = *(const u32x4*)(ptr + i * 8);
#pragma unroll
        for (int e = 0; e < 4; ++e) { if ((u[e] & 0x7F80u) == 0x7F80u) bad = true; if ((u[e] & 0x7F800000u) == 0x7F800000u) bad = true; }
    }
    if (bad) atomicOr(flag, bit);
}
__device__ void scan_f32(const float* ptr, size_t n, unsigned* flag, unsigned bit) {
    bool bad = false;
    for (size_t i = (size_t)blockIdx.x * 256 + threadIdx.x; i < n; i += (size_t)gridDim.x * 256) {
        if ((__float_as_uint(ptr[i]) & 0x7F800000u) == 0x7F800000u) bad = true;
    }
    if (bad) atomicOr(flag, bit);
}
#endif
__device__ __forceinline__ void run_phase(const Params& p, int ph, int l, unsigned char* lds) {
    switch (ph) {
        case 0: phase_p0(p, lds); break;
        case 1: norm_rows(p, 0, p.x, p.ctx); break;
        case 2: phase_a(p, l, lds); break;
        case 3: phase_b(p, l, lds); break;
        case 4: phase_c(p, l); break;
        case 5: phase_d(p, l, lds); break;
        case 6: phase_e1(p, l, lds); break;
        case 7: phase_e2(p, l, lds); break;
        default: phase_e3(p, l, lds); break;
    }
}

#if MULTI_LAUNCH
__global__ void __launch_bounds__(256, 2) phase_kernel(Params p, int ph, int l) {
    __shared__ __attribute__((aligned(16))) unsigned char lds[LDS_BYTES];
    run_phase(p, ph, l, lds);
}
#else
#define GSYNC() do { __threadfence(); grid.sync(); __threadfence(); } while (0)
__global__ void __launch_bounds__(256, 2) mega_kernel(Params p) {
    __shared__ __attribute__((aligned(16))) unsigned char lds[LDS_BYTES];
    cg::grid_group grid = cg::this_grid();
#ifdef DIAG
    unsigned* flag = (unsigned*)(p.rope + 4096);
    if (blockIdx.x == 0 && threadIdx.x == 0) *flag = 0u;
    int l0 = 0; asm volatile("" : "+s"(l0));
#pragma unroll 1
    for (int ph = 0; ph <= DIAG_LAST; ++ph) {
        run_phase(p, ph, l0, lds); GSYNC();
        if (ph == 0) { scan_f32(p.mod, 4 * 5 * 3072, flag, 1u); scan_f32(p.rope, 4096, flag, 1u); scan_bf16(p.Wt, WT_TOTAL, flag, 1u); }
        else if (ph == 1) scan_bf16(p.HX, (size_t)NROWS * DM, flag, 1u);
        else if (ph == 4) scan_bf16(p.SU, (size_t)2 * 4 * 4 * 66 * 16384, flag, 8u);
        else {
            scan_bf16(p.P, (size_t)NROWS * PC, flag, ph == 2 ? 2u : ph == 3 ? 4u : ph == 5 ? 16u : 32u);
            if (ph == 3) scan_bf16(p.SU, (size_t)2 * 4 * 4 * 66 * 16384, flag, 4u);
        }
        GSYNC();
    }
    {
#if DIAG_LAST == 2
        unsigned* cnt = flag + 1;
        if (blockIdx.x == 0 && threadIdx.x == 0) { for (int i = 0; i < 8; ++i) cnt[i] = 0u; *flag = 0u; }
        GSYNC();
        {
            bool huge = false;
            const size_t nch = (size_t)NROWS * DM / 8;
            for (size_t i = (size_t)blockIdx.x * 256 + threadIdx.x; i < nch; i += (size_t)gridDim.x * 256) {
                const u32x4 u = *(const u32x4*)(p.HX + i * 8);
                for (int e = 0; e < 4; ++e) { if (fabsf(lo16(u[e])) > 1e4f || fabsf(hi16(u[e])) > 1e4f) huge = true; }
            }
            const size_t nch2 = (size_t)8448 * DM / 8;
            for (size_t i = (size_t)blockIdx.x * 256 + threadIdx.x; i < nch2; i += (size_t)gridDim.x * 256) {
                const u32x4 u = *(const u32x4*)(p.Wt + i * 8);
                for (int e = 0; e < 4; ++e) { if (fabsf(lo16(u[e])) > 1e4f || fabsf(hi16(u[e])) > 1e4f) huge = true; }
            }
            if (huge) atomicAdd(cnt + 4, 1u);
        }
        if (blockIdx.x < 4) {
            const int mts[4] = {0, 0, 1, 3}, nts[4] = {0, 1, 0, 5};
            const int mt = mts[blockIdx.x], nt = nts[blockIdx.x];
            unsigned bad = 0;
            for (int j = 0; j < 64; ++j) {
                const int e = threadIdx.x + 256 * j, m = mt * 128 + (e >> 7), n = nt * 128 + (e & 127);
                float d = 0.f;
                for (int k = 0; k < 1024; ++k) d += bf2f(p.HX[(size_t)m * DM + k]) * bf2f(p.Wt[WT_IN + (size_t)n * DM + k]);
                const float pv = bf2f(p.P[(size_t)m * PC + n]);
                if (!(fabsf(d - pv) <= 0.05f + 0.05f * fabsf(d))) ++bad;
            }
            if (bad) atomicAdd(cnt + blockIdx.x, bad);
        }
        GSYNC();
        if (blockIdx.x == 0 && threadIdx.x == 0) {
            unsigned f = 0;
            if (cnt[0] > 0u) f |= 1u;
            if (cnt[0] > 8192u) f |= 2u;
            if (cnt[1] > 0u) f |= 4u;
            if (cnt[2] > 0u) f |= 8u;
            if (cnt[3] > 0u) f |= 16u;
            if (cnt[4] > 0u) f |= 32u;
            *flag = f;
        }
        GSYNC();
#endif
        const float code = (10.f + (float)(*flag)) * 100.f;
        for (size_t i = (size_t)blockIdx.x * 256 + threadIdx.x; i < (size_t)NTOK * DM; i += (size_t)gridDim.x * 256) p.out[i] = i == 0 ? code : 0.f;
    }
#else
    run_phase(p, 0, 0, lds); GSYNC();
    run_phase(p, 1, 0, lds); GSYNC();
    for (int l = 0; l < 4; ++l) {
#pragma unroll 1
        for (int ph = 2; ph <= 8; ++ph) {
            run_phase(p, ph, l, lds);
            if (!(l == 3 && ph == 8)) GSYNC();
        }
    }
#endif
}
#endif

extern "C" void kernel_launch(void* const* d_in, const int* in_sizes, int n_in, void* d_out, int out_size, void* d_ws, size_t ws_size, hipStream_t stream) {
    Params p{};
    p.x = (const float*)d_in[0]; p.c = (const float*)d_in[1]; p.ctx = (const float*)d_in[2]; p.c_ctx = (const float*)d_in[3];
    p.ada_w = (const float*)d_in[4]; p.ada_b = (const float*)d_in[5]; p.norm_w = (const float*)d_in[6]; p.w_in = (const float*)d_in[7];
    p.ret_log_decay = (const float*)d_in[8]; p.ret_gn_w = (const float*)d_in[9]; p.na_rpb = (const float*)d_in[10];
    p.q_norm_w = (const float*)d_in[11]; p.k_norm_w = (const float*)d_in[12]; p.w_ret_o = (const float*)d_in[13];
    p.w_na_o = (const float*)d_in[14]; p.w_gqa_o = (const float*)d_in[15]; p.w_out = (const float*)d_in[16]; p.final_norm_w = (const float*)d_in[17];
    p.out = (float*)d_out;
    unsigned char* ws = (unsigned char*)d_ws;
    size_t off = 0;
    p.P = (bf16_t*)(ws + off); off += (size_t)NROWS * PC * 2;
    p.HX = (bf16_t*)(ws + off); off += (size_t)NROWS * DM * 2;
    p.Wt = (bf16_t*)(ws + off); off += (size_t)WT_TOTAL * 2;
    p.SU = (bf16_t*)(ws + off); off += (size_t)2 * 4 * 4 * 66 * 16384 * 2;
    p.y = (float*)(ws + off); off += (size_t)1024 * 1024 * 4;
    p.mod = (float*)(ws + off); off += (size_t)4 * 5 * 3072 * 4;
    p.rope = (float*)(ws + off); off += (size_t)128 * 16 * 2 * 4 + 256;
    if (off > ws_size) { fprintf(stderr, "workspace too small: need %zu have %zu\n", off, ws_size); return; }
#if MULTI_LAUNCH
    const int grid = 512;
    phase_kernel<<<grid, 256, 0, stream>>>(p, 0, 0);
    phase_kernel<<<grid, 256, 0, stream>>>(p, 1, 0);
    for (int l = 0; l < 4; ++l)
        for (int ph = 2; ph <= 8; ++ph) phase_kernel<<<grid, 256, 0, stream>>>(p, ph, l);
#else
    static int grid_blocks = 0;
    if (!grid_blocks) {
        int dev = 0, cus = 0, per_cu = 0;
        hipGetDevice(&dev);
        hipDeviceGetAttribute(&cus, hipDeviceAttributeMultiprocessorCount, dev);
        hipOccupancyMaxActiveBlocksPerMultiprocessor(&per_cu, mega_kernel, 256, 0);
        if (per_cu > 2) per_cu = 2;
        grid_blocks = cus * per_cu;
    }
    void* args[] = {&p};
    hipError_t e = hipLaunchCooperativeKernel((void*)mega_kernel, dim3(grid_blocks), dim3(256), args, 0, stream);
    if (e != hipSuccess) fprintf(stderr, "cooperative launch failed: %s (grid %d)\n", hipGetErrorString(e), grid_blocks);
#endif
}
```

```cpp
#include <hip/hip_runtime.h>
#include <hip/hip_cooperative_groups.h>
#include <cstdio>
#include <cstdint>
namespace cg = cooperative_groups;

#ifndef PROBE
#define PROBE 0
#endif
#ifndef MULTI_LAUNCH
#define MULTI_LAUNCH 0
#endif

typedef unsigned short bf16_t;
typedef short bf16x8 __attribute__((ext_vector_type(8)));
typedef float f32x4 __attribute__((ext_vector_type(4)));
typedef unsigned u32x4 __attribute__((ext_vector_type(4)));
typedef unsigned u32x2 __attribute__((ext_vector_type(2)));

#define DM 1024
#define NTOK 32768
#define NROWS 33792
#define PC 5376
#define INC 8448
#define LOG2E 1.4426950408889634f
#define EPSN 1e-6f
#define LDS_BYTES 73728

#define C_RQ 0
#define C_RK 512
#define C_RV 1024
#define C_RG 1536
#define C_NQ 2048
#define C_NK 2560
#define C_NV 3072
#define C_NG 3584
#define C_GQ 4096
#define C_GK 4608
#define C_GV 4736
#define C_GG 4864
#define C_M  512

#define WT_IN 0
#define WT_RET (8448 * 1024)
#define WT_NA (WT_RET + 1024 * 512)
#define WT_GQA (WT_NA + 1024 * 512)
#define WT_OUT (WT_GQA + 1024 * 512)
#define WT_TOTAL (WT_OUT + 1024 * 1024)

#define VG(p) ((bf16_t*)((unsigned char*)(p).bar + 4096))
struct Params {
    const float *x, *c, *ctx, *c_ctx, *ada_w, *ada_b, *norm_w, *w_in, *ret_log_decay, *ret_gn_w, *na_rpb, *q_norm_w, *k_norm_w,
        *w_ret_o, *w_na_o, *w_gqa_o, *w_out, *final_norm_w;
    float* out;
    bf16_t* P;
    bf16_t* HX;
    bf16_t* Wt;
    bf16_t* SU;
    float* y;
    float* mod;
    float* rope;
    unsigned* bar;
};

__device__ __forceinline__ int tid_opaque() { int t = threadIdx.x; asm volatile("" : "+v"(t)); return t; }
__device__ __forceinline__ float bf2f(bf16_t v) { return __uint_as_float(((unsigned)v) << 16); }
typedef __bf16 bf16x2_t __attribute__((ext_vector_type(2)));
typedef float f32x2_t __attribute__((ext_vector_type(2)));
__device__ __forceinline__ unsigned pk2(float lo, float hi) {
    f32x2_t v = {lo, hi};
    union { bf16x2_t b; unsigned u; } x; x.b = __builtin_convertvector(v, bf16x2_t); return x.u;
}
__device__ __forceinline__ bf16_t f2bf(float f) { return (bf16_t)(pk2(f, 0.f) & 0xffffu); }
__device__ __forceinline__ float lo16(unsigned u) { return __uint_as_float(u << 16); }
__device__ __forceinline__ float hi16(unsigned u) { return __uint_as_float(u & 0xffff0000u); }
__device__ __forceinline__ float ex2(float x) { return __builtin_amdgcn_exp2f(x); }
__device__ __forceinline__ float silu_f(float x) { return x * __builtin_amdgcn_rcpf(1.f + ex2(-x * LOG2E)); }
__device__ __forceinline__ float sigm_f(float x) { return __builtin_amdgcn_rcpf(1.f + ex2(-x * LOG2E)); }
__device__ __forceinline__ f32x4 mfma16(bf16x8 a, bf16x8 b, f32x4 c) { return __builtin_amdgcn_mfma_f32_16x16x32_bf16(a, b, c, 0, 0, 0); }
__device__ __forceinline__ bf16x8 as_bf(u32x4 u) { union { u32x4 a; bf16x8 b; } x; x.a = u; return x.b; }
__device__ __forceinline__ u32x4 as_u(bf16x8 u) { union { u32x4 a; bf16x8 b; } x; x.b = u; return x.a; }
__device__ __forceinline__ u32x4 ldg16(const bf16_t* p) { return *(const u32x4*)p; }

template <int NI>
__device__ __forceinline__ void gemm_core(f32x4 (&acc)[NI][4], const bf16_t* __restrict__ X, int ldx, const bf16_t* __restrict__ W, int ldw, int K, unsigned char* lds) {
    const int t = tid_opaque(), lane = t & 63, w = t >> 6, wm = w >> 1, wn = w & 1;
    bf16_t* Xs = (bf16_t*)lds;
    bf16_t* Ws = Xs + 2 * 128 * 72;
    const int sr = t >> 3, sc = (t & 7) * 8;
    const bf16_t* xg = X + (size_t)sr * ldx + sc;
    const bf16_t* wg = W + (size_t)sr * ldw + sc;
    u32x4 xr[4], wr[NI];
#pragma unroll
    for (int i = 0; i < 4; ++i) xr[i] = ldg16(xg + (size_t)i * 32 * ldx);
#pragma unroll
    for (int i = 0; i < NI; ++i) wr[i] = ldg16(wg + (size_t)i * 32 * ldw);
    __syncthreads();
#pragma unroll
    for (int i = 0; i < 4; ++i) *(u32x4*)(Xs + (sr + i * 32) * 72 + sc) = xr[i];
#pragma unroll
    for (int i = 0; i < NI; ++i) *(u32x4*)(Ws + (sr + i * 32) * 72 + sc) = wr[i];
    __syncthreads();
    const int nk = K >> 6;
    for (int kt = 0; kt < nk; ++kt) {
        const int cur = kt & 1;
        if (kt + 1 < nk) {
            const int ko = (kt + 1) * 64;
#pragma unroll
            for (int i = 0; i < 4; ++i) xr[i] = ldg16(xg + (size_t)i * 32 * ldx + ko);
#pragma unroll
            for (int i = 0; i < NI; ++i) wr[i] = ldg16(wg + (size_t)i * 32 * ldw + ko);
        }
        __builtin_amdgcn_sched_barrier(0);
        const bf16_t* xs = Xs + cur * 128 * 72 + (wm * 64 + (lane & 15)) * 72 + (lane >> 4) * 8;
        const bf16_t* ws = Ws + cur * 128 * 72 + (wn * (NI * 16) + (lane & 15)) * 72 + (lane >> 4) * 8;
#pragma unroll
        for (int ks = 0; ks < 2; ++ks) {
            bf16x8 xf[4], wf[NI];
#pragma unroll
            for (int i = 0; i < 4; ++i) xf[i] = *(const bf16x8*)(xs + i * 16 * 72 + ks * 32);
#pragma unroll
            for (int i = 0; i < NI; ++i) wf[i] = *(const bf16x8*)(ws + i * 16 * 72 + ks * 32);
#pragma unroll
            for (int ni = 0; ni < NI; ++ni)
#pragma unroll
                for (int mi = 0; mi < 4; ++mi) acc[ni][mi] = mfma16(wf[ni], xf[mi], acc[ni][mi]);
        }
        if (kt + 1 < nk) {
            const int nx = cur ^ 1;
#pragma unroll
            for (int i = 0; i < 4; ++i) *(u32x4*)(Xs + nx * 128 * 72 + (sr + i * 32) * 72 + sc) = xr[i];
#pragma unroll
            for (int i = 0; i < NI; ++i) *(u32x4*)(Ws + nx * 128 * 72 + (sr + i * 32) * 72 + sc) = wr[i];
        }
        __syncthreads();
    }
}

__device__ __forceinline__ void gemm_big(f32x4 (&acc)[4][8], const bf16_t* __restrict__ X, int ldx, const bf16_t* __restrict__ W, int ldw, int K, unsigned char* lds) {
    const int t = tid_opaque(), lane = t & 63, w = t >> 6, wm = w >> 1, wn = w & 1;
    bf16_t* Xs = (bf16_t*)lds;
    bf16_t* Ws = Xs + 2 * 256 * 40;
    const int sr = t >> 2, sc = (t & 3) * 8;
    const bf16_t* xg = X + (size_t)sr * ldx + sc;
    const bf16_t* wg = W + (size_t)sr * ldw + sc;
    u32x4 ra[6], rb[6];
#define GB_LOAD(r, ko) do { _Pragma("unroll") for (int i = 0; i < 4; ++i) r[i] = ldg16(xg + (size_t)i * 64 * ldx + (ko)); _Pragma("unroll") for (int i = 0; i < 2; ++i) r[4 + i] = ldg16(wg + (size_t)i * 64 * ldw + (ko)); } while (0)
#define GB_ST1(r, st, i) do { if ((i) < 4) *(u32x4*)(Xs + (st) * 256 * 40 + (sr + (i) * 64) * 40 + sc) = r[i]; else *(u32x4*)(Ws + (st) * 128 * 40 + (sr + ((i) - 4) * 64) * 40 + sc) = r[i]; } while (0)
#define GB_STEP(st, r, dostore) do { \
        const bf16_t* xs = Xs + (st) * 256 * 40 + (wm * 128 + (lane & 15)) * 40 + (lane >> 4) * 8; \
        const bf16_t* ws = Ws + (st) * 128 * 40 + (wn * 64 + (lane & 15)) * 40 + (lane >> 4) * 8; \
        bf16x8 wf[4]; \
        _Pragma("unroll") for (int i = 0; i < 4; ++i) wf[i] = *(const bf16x8*)(ws + i * 16 * 40); \
        _Pragma("unroll") for (int mi = 0; mi < 8; ++mi) { \
            const bf16x8 xf = *(const bf16x8*)(xs + mi * 16 * 40); \
            _Pragma("unroll") for (int ni = 0; ni < 4; ++ni) acc[ni][mi] = mfma16(wf[ni], xf, acc[ni][mi]); \
            if ((dostore) && mi >= 1 && mi <= 6) GB_ST1(r, (st) ^ 1, mi - 1); } } while (0)
    GB_LOAD(ra, 0);
    GB_LOAD(rb, 32);
    __syncthreads();
#pragma unroll
    for (int i = 0; i < 6; ++i) GB_ST1(ra, 0, i);
    __syncthreads();
    const int nk = K >> 5;
    for (int kt = 0; kt < nk; kt += 2) {
        if (kt + 2 < nk) GB_LOAD(ra, (kt + 2) * 32);
        GB_STEP(0, rb, true);
        __syncthreads();
        if (kt + 3 < nk) GB_LOAD(rb, (kt + 3) * 32);
        GB_STEP(1, ra, kt + 2 < nk);
        __syncthreads();
    }
#undef GB_LOAD
#undef GB_ST1
#undef GB_STEP
}

__device__ void adaln_item(const Params& p, int item, unsigned char* lds) {
    const int t = tid_opaque(), lane = t & 63, w = t >> 6;
    const int l = item / 48, cgp = item % 48, j = cgp * 64 + lane;
    float* cs = (float*)lds;
    float* red = (float*)(lds + 20480);
    __syncthreads();
    for (int idx = t; idx < 5120; idx += 256) {
        const int bb = idx >> 10, k = idx & 1023;
        const float v = bb < 4 ? p.c[bb * 1024 + k] : p.c_ctx[k];
        cs[idx] = silu_f(v);
    }
    __syncthreads();
    float a0 = 0.f, a1 = 0.f, a2 = 0.f, a3 = 0.f, a4 = 0.f;
    const float* aw = p.ada_w + ((size_t)l * 1024 + w * 256) * 3072 + j;
    for (int k = 0; k < 256; ++k) {
        const float wv = aw[(size_t)k * 3072];
        const int kk = w * 256 + k;
        a0 += cs[kk] * wv; a1 += cs[1024 + kk] * wv; a2 += cs[2048 + kk] * wv; a3 += cs[3072 + kk] * wv; a4 += cs[4096 + kk] * wv;
    }
    red[(w * 5 + 0) * 64 + lane] = a0; red[(w * 5 + 1) * 64 + lane] = a1; red[(w * 5 + 2) * 64 + lane] = a2;
    red[(w * 5 + 3) * 64 + lane] = a3; red[(w * 5 + 4) * 64 + lane] = a4;
    __syncthreads();
    for (int idx = t; idx < 320; idx += 256) {
        const int bb = idx >> 6, ln = idx & 63;
        float v = p.ada_b[l * 3072 + cgp * 64 + ln];
#pragma unroll
        for (int ww = 0; ww < 4; ++ww) v += red[(ww * 5 + bb) * 64 + ln];
        p.mod[(l * 5 + bb) * 3072 + cgp * 64 + ln] = v;
    }
}

__device__ void transpose_tile(const float* __restrict__ src, int N, bf16_t* __restrict__ dst, int K, int k0, int n0, unsigned char* lds) {
    const int t = tid_opaque();
    bf16_t* T = (bf16_t*)lds;
    __syncthreads();
#pragma unroll
    for (int i = 0; i < 4; ++i) {
        const int k = (t >> 4) + 16 * i, n4 = (t & 15) * 4;
        const f32x4 v = *(const f32x4*)(src + (size_t)(k0 + k) * N + n0 + n4);
        T[(n4 + 0) * 72 + k] = f2bf(v[0]); T[(n4 + 1) * 72 + k] = f2bf(v[1]); T[(n4 + 2) * 72 + k] = f2bf(v[2]); T[(n4 + 3) * 72 + k] = f2bf(v[3]);
    }
    __syncthreads();
#pragma unroll
    for (int i = 0; i < 2; ++i) {
        const int cidx = t + 256 * i, n = cidx >> 3, kc = cidx & 7;
        *(u32x4*)(dst + (size_t)(n0 + n) * K + k0 + kc * 8) = *(const u32x4*)(T + n * 72 + kc * 8);
    }
}

#define NCONV_ITEMS (2112 + 3 * 128 + 256)
__device__ void convert_item(const Params& p, int l, int item, unsigned char* lds) {
    if (item < 2112) {
        const int kt = item / 132, nt = item % 132;
        transpose_tile(p.w_in + (size_t)l * 1024 * INC, INC, p.Wt + WT_IN, 1024, kt * 64, nt * 64, lds);
    } else if (item < 2112 + 384) {
        const int it = item - 2112, which = it / 128, r = it % 128, kt = r / 16, nt = r % 16;
        const float* src = (which == 0 ? p.w_ret_o : which == 1 ? p.w_na_o : p.w_gqa_o) + (size_t)l * 512 * 1024;
        bf16_t* dst = p.Wt + (which == 0 ? WT_RET : which == 1 ? WT_NA : WT_GQA);
        transpose_tile(src, 1024, dst, 512, kt * 64, nt * 64, lds);
    } else {
        const int it = item - 2112 - 384, kt = it / 16, nt = it % 16;
        transpose_tile(p.w_out + (size_t)l * 1024 * 1024, 1024, p.Wt + WT_OUT, 1024, kt * 64, nt * 64, lds);
    }
}

__device__ void rope_table(const Params& p) {
    for (int idx = tid_opaque(); idx < 2048; idx += 256) {
        const int pos = idx >> 4, i = idx & 15;
        const float f = ex2(-(float)i * (13.287712379549449f / 16.f));
        const float ang = (float)pos * f;
        float rev = ang * 0.15915494309189535f;
        rev = rev - rintf(rev);
        p.rope[idx * 2 + 0] = __builtin_amdgcn_cosf(rev);
        p.rope[idx * 2 + 1] = __builtin_amdgcn_sinf(rev);
    }
}

__device__ void phase_p0(const Params& p, unsigned char* lds) {
    const int total = 192 + NCONV_ITEMS + 1;
    for (int item = blockIdx.x; item < total; item += gridDim.x) {
        if (item < 192) adaln_item(p, item, lds);
        else if (item < 192 + NCONV_ITEMS) convert_item(p, 0, item - 192, lds);
        else rope_table(p);
    }
}

__device__ void norm_rows(const Params& p, int lnext, const float* xsrc, const float* ysrc) {
    const int t = tid_opaque(), lane = t & 63, w = t >> 6;
    const int nrows = lnext < 4 ? NROWS : NTOK;
    for (int row = blockIdx.x * 4 + w; row < nrows; row += gridDim.x * 4) {
        const float* src = row < NTOK ? xsrc + (size_t)row * DM : ysrc + (size_t)(row - NTOK) * DM;
        f32x4 v[4];
        float ss = 0.f;
#pragma unroll
        for (int i = 0; i < 4; ++i) { v[i] = *(const f32x4*)(src + i * 256 + lane * 4); ss += v[i][0] * v[i][0] + v[i][1] * v[i][1] + v[i][2] * v[i][2] + v[i][3] * v[i][3]; }
#pragma unroll
        for (int o = 32; o >= 1; o >>= 1) ss += __shfl_xor(ss, o);
        const float rstd = rsqrtf(ss * (1.f / 1024.f) + EPSN);
        if (lnext < 4) {
            const int bb = row < NTOK ? (row >> 13) : 4;
            const float* md = p.mod + (size_t)(lnext * 5 + bb) * 3072;
            const float* nw = p.norm_w + lnext * 1024;
#pragma unroll
            for (int i = 0; i < 4; ++i) {
                const int col = i * 256 + lane * 4;
                const f32x4 nwv = *(const f32x4*)(nw + col), sh = *(const f32x4*)(md + col), scl = *(const f32x4*)(md + 1024 + col);
                f32x4 h = v[i] * rstd * nwv * (scl + 1.f) + sh;
                u32x2 o2; o2.x = pk2(h[0], h[1]); o2.y = pk2(h[2], h[3]);
                *(u32x2*)(p.HX + (size_t)row * DM + col) = o2;
            }
        } else {
#pragma unroll
            for (int i = 0; i < 4; ++i) {
                const int col = i * 256 + lane * 4;
                const f32x4 nwv = *(const f32x4*)(p.final_norm_w + col);
                f32x4 ov = v[i] * rstd * nwv;
#ifdef SANITIZE
                for (int e = 0; e < 4; ++e) if (!(fabsf(ov[e]) < 1e30f)) ov[e] = 1000.f;
#endif
                *(f32x4*)(p.out + (size_t)row * DM + col) = ov;
            }
        }
    }
}

__device__ void phase_a(const Params& p, int l, unsigned char* lds) {
    const int t = tid_opaque(), lane = t & 63, w = t >> 6, wm = w >> 1, wn = w & 1;
    const int total = 132 * 42;
    const bool xmap = (gridDim.x & 7) == 0;
    const int per = xmap ? (total + 7) / 8 : total;
    const int lo = xmap ? (int)(blockIdx.x & 7) * per : 0, hi = min(lo + per, total);
    const int step = xmap ? (int)(gridDim.x >> 3) : (int)gridDim.x;
    for (int idx = lo + (xmap ? (int)(blockIdx.x >> 3) : (int)blockIdx.x); idx < hi; idx += step) {
        const int nb = idx / 924, rem = idx - nb * 924;
        const int mt = rem / 7, nt = nb * 7 + (rem - mt * 7);
        f32x4 acc[4][8];
#pragma unroll
        for (int a = 0; a < 4; ++a)
#pragma unroll
            for (int b = 0; b < 8; ++b) acc[a][b] = (f32x4){0.f, 0.f, 0.f, 0.f};
        gemm_big(acc, p.HX + (size_t)mt * 256 * DM, DM, p.Wt + WT_IN + (size_t)nt * 128 * DM, DM, DM, lds);
#pragma unroll
        for (int ni = 0; ni < 4; ++ni)
#pragma unroll
            for (int mi = 0; mi < 8; ++mi) {
                const int n = nt * 128 + wn * 64 + ni * 16 + (lane >> 4) * 4, m = mt * 256 + wm * 128 + mi * 16 + (lane & 15);
                u32x2 o2; o2.x = pk2(acc[ni][mi][0], acc[ni][mi][1]); o2.y = pk2(acc[ni][mi][2], acc[ni][mi][3]);
                *(u32x2*)(p.P + (size_t)m * PC + n) = o2;
            }
    }
}

__device__ __forceinline__ int chunk_row(int b, int cidx) { return cidx < 64 ? b * 8192 + cidx * 128 : NTOK + b * 256 + (cidx - 64) * 128; }

__device__ void ret_state_item(const Params& p, int l, int b, int h, int cidx, unsigned char* lds) {
    const int t = tid_opaque(), lane = t & 63, w = t >> 6, g = lane >> 4, c = lane & 15;
    bf16_t* Ktf = (bf16_t*)lds;
    bf16_t* Vt = Ktf + 128 * 72;
    const float lgf = -__expf(p.ret_log_decay[l * 8 + h]) * LOG2E, lgb = -__expf(p.ret_log_decay[l * 8 + 4 + h]) * LOG2E;
    const float ksc = 0.08838834764831845f;
    const int rowbase = chunk_row(b, cidx);
    for (int dir = 0; dir < 2; ++dir) {
        f32x4 acc[2][8];
#pragma unroll
        for (int i = 0; i < 2; ++i)
#pragma unroll
            for (int d = 0; d < 8; ++d) acc[i][d] = (f32x4){0.f, 0.f, 0.f, 0.f};
        const float lg = dir ? lgb : lgf;
#pragma unroll 1
        for (int half = 0; half < 2; ++half) {
            __syncthreads();
#pragma unroll
            for (int i = 0; i < 4; ++i) {
                const int cc = t + 256 * i, tok = cc & 63, dch = cc >> 6, j = half * 64 + tok;
                const float wgt = ex2(lg * (float)(dir ? j : 127 - j)) * ksc;
                const bf16_t* rp = p.P + (size_t)(rowbase + j) * PC + h * 128 + dch * 8;
                const u32x4 kv = ldg16(rp + C_RK), vv = ldg16(rp + C_RV);
#pragma unroll
                for (int e = 0; e < 4; ++e) {
                    const int r0 = (dch * 8 + 2 * e) * 72 + tok, r1 = r0 + 72;
                    Ktf[r0] = f2bf(lo16(kv[e]) * wgt); Ktf[r1] = f2bf(hi16(kv[e]) * wgt);
                    Vt[r0] = (bf16_t)(vv[e] & 0xffffu); Vt[r1] = (bf16_t)(vv[e] >> 16);
                }
            }
            __syncthreads();
#pragma unroll
            for (int ks = 0; ks < 2; ++ks) {
                bf16x8 kf[2];
#pragma unroll
                for (int i = 0; i < 2; ++i) kf[i] = *(const bf16x8*)(Ktf + (w * 32 + i * 16 + c) * 72 + ks * 32 + g * 8);
#pragma unroll
                for (int d = 0; d < 8; ++d) {
                    const bf16x8 vf = *(const bf16x8*)(Vt + (d * 16 + c) * 72 + ks * 32 + g * 8);
#pragma unroll
                    for (int i = 0; i < 2; ++i) acc[i][d] = mfma16(kf[i], vf, acc[i][d]);
                }
            }
        }
        bf16_t* Sd = p.SU + ((size_t)((dir * 4 + b) * 4 + h) * 66 + cidx) * 16384;
#pragma unroll
        for (int i = 0; i < 2; ++i)
#pragma unroll
            for (int d = 0; d < 8; ++d) {
                const int dk = w * 32 + i * 16 + g * 4, dv = d * 16 + c;
                u32x2 o2; o2.x = pk2(acc[i][d][0], acc[i][d][1]); o2.y = pk2(acc[i][d][2], acc[i][d][3]);
                *(u32x2*)(Sd + dv * 128 + dk) = o2;
            }
    }
}

__device__ void qk_prep_item(const Params& p, int l, int item) {
    const int t = tid_opaque(), tok = t >> 2, sub = t & 3;
    const int row = item * 64 + tok;
    const bool lat = row < NTOK;
    const int tseq = row & 8191, pr = tseq >> 6, pc = tseq & 63;
    for (int hv = sub; hv < 10; hv += 4) {
        bf16_t* ptr = p.P + (size_t)row * PC + (hv < 8 ? C_GQ + hv * 64 : C_GK + (hv - 8) * 64);
        const float* nw = hv < 8 ? p.q_norm_w + l * 64 : p.k_norm_w + l * 64;
        float x[64];
        float ss = 0.f;
#pragma unroll
        for (int i = 0; i < 8; ++i) {
            const u32x4 u = ldg16(ptr + i * 8);
#pragma unroll
            for (int e = 0; e < 4; ++e) { x[i * 8 + 2 * e] = lo16(u[e]); x[i * 8 + 2 * e + 1] = hi16(u[e]); }
        }
#pragma unroll
        for (int d = 0; d < 64; ++d) ss += x[d] * x[d];
        const float rstd = rsqrtf(ss * (1.f / 64.f) + EPSN);
#pragma unroll
        for (int d = 0; d < 64; ++d) x[d] = x[d] * rstd * nw[d];
        if (lat) {
#pragma unroll
            for (int i = 0; i < 16; ++i) {
                const float cr = p.rope[(pr * 16 + i) * 2], sr = p.rope[(pr * 16 + i) * 2 + 1];
                const float cc = p.rope[(pc * 16 + i) * 2], sc = p.rope[(pc * 16 + i) * 2 + 1];
                const float a = x[i], b2 = x[16 + i], a2 = x[32 + i], b3 = x[48 + i];
                x[i] = a * cr - b2 * sr; x[16 + i] = b2 * cr + a * sr;
                x[32 + i] = a2 * cc - b3 * sc; x[48 + i] = b3 * cc + a2 * sc;
            }
        }
#pragma unroll
        for (int i = 0; i < 8; ++i) {
            u32x4 u;
#pragma unroll
            for (int e = 0; e < 4; ++e) u[e] = pk2(x[i * 8 + 2 * e], x[i * 8 + 2 * e + 1]);
            *(u32x4*)(ptr + i * 8) = u;
        }
    }
    {
        const int b = lat ? (row >> 13) : ((row - NTOK) >> 8);
        const int key = lat ? tseq : 8192 + ((row - NTOK) & 255);
        const bf16_t* vp = p.P + (size_t)row * PC + C_GV + sub * 32;
        bf16_t* dst = VG(p) + ((size_t)(b * 2 + (sub >> 1)) * 64 + (sub & 1) * 32) * 8448 + key;
#pragma unroll
        for (int i = 0; i < 4; ++i) {
            const u32x4 u = ldg16(vp + i * 8);
#pragma unroll
            for (int e = 0; e < 4; ++e) {
                dst[(size_t)(i * 8 + 2 * e) * 8448] = (bf16_t)(u[e] & 0xffffu);
                dst[(size_t)(i * 8 + 2 * e + 1) * 8448] = (bf16_t)(u[e] >> 16);
            }
        }
    }
}

__device__ void phase_b(const Params& p, int l, unsigned char* lds) {
    const int total = 1056 + 528;
    for (int item = blockIdx.x; item < total; item += gridDim.x) {
        if (item < 1056) { const int cidx = item % 66, bh = item / 66; ret_state_item(p, l, bh >> 2, bh & 3, cidx, lds);
#if PROBE == 7 || PROBE == 10
            ret_state_item(p, l, bh >> 2, bh & 3, cidx, lds);
#endif
        }
        else qk_prep_item(p, l, item - 1056);
    }
}

__device__ void phase_c(const Params& p, int l, bool dostore = true) {
    const int t = tid_opaque();
    for (int item = blockIdx.x; item < 256; item += gridDim.x) {
        const int part = item & 7, dbh = item >> 3, dir = dbh >> 4, h = dbh & 3;
        const float lg = -__expf(p.ret_log_decay[l * 8 + dir * 4 + h]) * LOG2E;
        const float gc = ex2(lg * 128.f);
        bf16_t* base = p.SU + (size_t)dbh * 66 * 16384 + part * 2048 + t * 8;
        float s[8];
#pragma unroll
        for (int e = 0; e < 8; ++e) s[e] = 0.f;
        for (int st0 = 0; st0 < 66; st0 += 11) {
            u32x4 u[11];
#pragma unroll
            for (int q = 0; q < 11; ++q) {
                const int st = st0 + q;
                const int n = dir == 0 ? (st < 2 ? 64 + st : st - 2) : (st < 2 ? 65 - st : 65 - st);
                u[q] = *(const u32x4*)(base + (size_t)n * 16384);
            }
#pragma unroll
            for (int q = 0; q < 11; ++q) {
                const int st = st0 + q;
                const int n = dir == 0 ? (st < 2 ? 64 + st : st - 2) : (st < 2 ? 65 - st : 65 - st);
                u32x4 o;
#pragma unroll
                for (int e = 0; e < 4; ++e) o[e] = pk2(s[2 * e], s[2 * e + 1]);
                if (dostore) *(u32x4*)(base + (size_t)n * 16384) = o;
#pragma unroll
                for (int e = 0; e < 4; ++e) { s[2 * e] = gc * s[2 * e] + lo16(u[q][e]); s[2 * e + 1] = gc * s[2 * e + 1] + hi16(u[q][e]); }
            }
        }
    }
}

template <int MODE>
__device__ void attn_item(const Params& p, int l, int b, int i1, int i2, int i3, unsigned char* lds, bool dostore = true) {
    constexpr int NQB = (MODE == 2) ? 2 : 4, NHQ = NQB / 2;
    const int t = tid_opaque(), lane = t & 63, w = t >> 6, g = lane >> 4, c = lane & 15;
    bf16_t* Ks = (bf16_t*)lds;
    bf16_t* Vt = Ks + 2 * 64 * 72;
    u32x4* Qs = (u32x4*)(lds + 36864) + w * 512;
    float* rpbs = (float*)(lds + 36864 + 32768);
    int qbase, qstep, qcol, kcol, vcol, gcol, ntiles;
    int R0 = 0, c0 = 0, start = 0, bstart = 0, hh = 0;
    if (MODE == 0 || MODE == 1) {
        const int kvh = i1, qt = i2, head = kvh * 4 + w;
        qbase = (MODE == 0 ? b * 8192 : NTOK + b * 256) + qt * 64; qstep = 16;
        qcol = C_GQ + head * 64; kcol = C_GK + kvh * 64; vcol = C_GV + kvh * 64; gcol = C_GG + head * 64;
        ntiles = MODE == 0 ? 132 : 4;
    } else if (MODE == 2) {
        hh = i1; R0 = i2 * 8; c0 = i3 * 16;
        start = min(max(R0 - 4, 0), 112); bstart = min(max(c0 - 8, 0), 32);
        qbase = b * 8192 + (R0 + w * 2) * 64 + c0; qstep = 64;
        qcol = C_NQ + hh * 64; kcol = C_NK + hh * 64; vcol = C_NV + hh * 64; gcol = C_NG + hh * 64;
        ntiles = 12;
    } else {
        hh = i1;
        qbase = NTOK + b * 256 + w * 64; qstep = 16;
        qcol = C_NQ + hh * 64; kcol = C_NK + hh * 64; vcol = C_NV + hh * 64; gcol = C_NG + hh * 64;
        ntiles = 4;
    }
    const float scale = 0.125f * LOG2E;
    f32x4 o[NQB][4];
    float mrun[NQB], lsum[NQB];
#pragma unroll
    for (int qb = 0; qb < NQB; ++qb) {
        mrun[qb] = -INFINITY; lsum[qb] = 0.f;
#pragma unroll
        for (int d = 0; d < 4; ++d) o[qb][d] = (f32x4){0.f, 0.f, 0.f, 0.f};
    }
    const int kkey = t >> 3, kch = (t & 7) * 8;
    const int vkey = t & 63, vch = (t >> 6);
    u32x4 kr[2], vr[2];
    auto load_tile = [&](int tt) {
        int base, rstep;
        if (MODE == 0) { base = tt < 128 ? b * 8192 + tt * 64 : NTOK + b * 256 + (tt - 128) * 64; rstep = 32; }
        else if (MODE == 2) {
            if (tt < 4) { base = NTOK + b * 256 + tt * 64; rstep = 32; }
            else { base = b * 8192 + (start + 2 * (tt - 4)) * 64 + bstart; rstep = 64; }
        } else { base = NTOK + b * 256 + tt * 64; rstep = 32; }
#pragma unroll
        for (int i = 0; i < 2; ++i) {
            const int key = kkey + 32 * i;
            kr[i] = ldg16(p.P + (size_t)(base + (key >> 5) * rstep + (key & 31)) * PC + kcol + kch);
            if (MODE <= 1) vr[i] = ldg16(VG(p) + ((size_t)(b * 2 + i1) * 64 + kkey + 32 * i) * 8448 + (MODE == 0 ? tt * 64 : 8192 + tt * 64) + kch);
            else vr[i] = ldg16(p.P + (size_t)(base + (vkey >> 5) * rstep + (vkey & 31)) * PC + vcol + (vch + 4 * i) * 8);
        }
    };
    auto store_tile = [&](int buf) {
        bf16_t* ks_ = Ks + buf * 64 * 72; bf16_t* vt_ = Vt + buf * 64 * 72;
#pragma unroll
        for (int i = 0; i < 2; ++i) {
            *(u32x4*)(ks_ + (kkey + 32 * i) * 72 + kch) = kr[i];
            if (MODE <= 1) { *(u32x4*)(vt_ + (kkey + 32 * i) * 72 + kch) = vr[i]; continue; }
#pragma unroll
            for (int e = 0; e < 4; ++e) {
                const int d = (vch + 4 * i) * 8 + 2 * e;
                vt_[d * 72 + vkey] = (bf16_t)(vr[i][e] & 0xffffu);
                vt_[(d + 1) * 72 + vkey] = (bf16_t)(vr[i][e] >> 16);
            }
        }
    };
    load_tile(0);
    __syncthreads();
#pragma unroll
    for (int qb = 0; qb < NQB; ++qb)
#pragma unroll
        for (int ks = 0; ks < 2; ++ks) Qs[(qb * 2 + ks) * 64 + lane] = ldg16(p.P + (size_t)(qbase + qb * qstep + c) * PC + qcol + ks * 32 + g * 8);
    if (MODE == 2) for (int idx = t; idx < 465; idx += 256) rpbs[idx] = p.na_rpb[((size_t)l * 8 + hh) * 465 + idx] * LOG2E;
    store_tile(0);
    __syncthreads();
    const int wlo = min(max(R0 + w * 2 - 4, 0), 120), whi = min(max(R0 + w * 2 + 1 - 4, 0), 120) + 7;
    int colterm[8];
    if (MODE == 2) {
        const int qc = c0 + c, cs = min(max(qc - 8, 0), 48);
#pragma unroll
        for (int j = 0; j < 8; ++j) {
            const int kc = bstart + (j >> 2) * 16 + g * 4 + (j & 3);
            colterm[j] = ((unsigned)(kc - cs) < 16u) ? (kc - qc + 15) : -1;
        }
    }
    for (int tt = 0; tt < ntiles; ++tt) {
        const int cur = tt & 1;
        if (tt + 1 < ntiles) load_tile(tt + 1);
        bool skip = false;
        int krow0 = 0;
        if (MODE == 2 && tt >= 4) { krow0 = start + 2 * (tt - 4); skip = (krow0 + 1 < wlo) || (krow0 > whi); }
        if (!skip) {
            const bf16_t* ks_ = Ks + cur * 64 * 72; const bf16_t* vt_ = Vt + cur * 64 * 72;
            f32x4 s[NQB][4];
#pragma unroll
            for (int qq = 0; qq < NQB; ++qq)
#pragma unroll
                for (int kb = 0; kb < 4; ++kb) s[qq][kb] = (f32x4){0.f, 0.f, 0.f, 0.f};
#pragma unroll
            for (int ks = 0; ks < 2; ++ks) {
                bf16x8 qv[NQB];
#pragma unroll
                for (int qq = 0; qq < NQB; ++qq) qv[qq] = as_bf(Qs[(qq * 2 + ks) * 64 + lane]);
#pragma unroll
                for (int kb = 0; kb < 4; ++kb) {
                    const bf16x8 kf = *(const bf16x8*)(ks_ + (kb * 16 + c) * 72 + ks * 32 + g * 8);
#pragma unroll
                    for (int qq = 0; qq < NQB; ++qq) s[qq][kb] = mfma16(kf, qv[qq], s[qq][kb]);
                }
            }
            __builtin_amdgcn_sched_barrier(0);
            bf16x8 pf[NQB][2];
#pragma unroll
            for (int qq = 0; qq < NQB; ++qq) {
                const int qb = qq;
                if (MODE == 2 && tt >= 4) {
                    const int qrow = R0 + w * 2 + qb;
                    const int rs = min(max(qrow - 4, 0), 120);
#pragma unroll
                    for (int kb = 0; kb < 4; ++kb) {
                        const int krow = krow0 + (kb >> 1);
                        const bool rowok = (unsigned)(krow - rs) < 8u;
                        const int ridx = (krow - qrow + 7) * 31;
#pragma unroll
                        for (int r = 0; r < 4; ++r) {
                            const int ct = colterm[(kb & 1) * 4 + r];
                            const bool valid = rowok && ct >= 0;
                            const float bias = rpbs[valid ? ridx + ct : 0];
                            s[qq][kb][r] = valid ? s[qq][kb][r] * scale + bias : -INFINITY;
                        }
                    }
                }
                const bool raw = !(MODE == 2 && tt >= 4);
                float tmax = fmaxf(fmaxf(s[qq][0][0], s[qq][0][1]), fmaxf(s[qq][0][2], s[qq][0][3]));
#pragma unroll
                for (int kb = 1; kb < 4; ++kb) tmax = fmaxf(tmax, fmaxf(fmaxf(s[qq][kb][0], s[qq][kb][1]), fmaxf(s[qq][kb][2], s[qq][kb][3])));
                tmax = fmaxf(tmax, __shfl_xor(tmax, 16)); tmax = fmaxf(tmax, __shfl_xor(tmax, 32));
                const float mn = fmaxf(mrun[qb], raw ? tmax * scale : tmax);
                const float alpha = ex2(mrun[qb] - mn);
                mrun[qb] = mn;
                float psum = 0.f;
#pragma unroll
                for (int kb = 0; kb < 4; ++kb)
#pragma unroll
                    for (int r = 0; r < 4; ++r) { const float pv = raw ? ex2(__builtin_fmaf(s[qq][kb][r], scale, -mn)) : ex2(s[qq][kb][r] - mn); s[qq][kb][r] = pv; psum += pv; }
                lsum[qb] = lsum[qb] * alpha + psum;
                if (__builtin_amdgcn_ballot_w64(alpha != 1.f) != 0ull) {
#pragma unroll
                    for (int d = 0; d < 4; ++d) o[qb][d] = o[qb][d] * alpha;
                }
#pragma unroll
                for (int kk = 0; kk < 2; ++kk) {
                    u32x4 u;
                    u[0] = pk2(s[qq][2 * kk][0], s[qq][2 * kk][1]); u[1] = pk2(s[qq][2 * kk][2], s[qq][2 * kk][3]);
                    u[2] = pk2(s[qq][2 * kk + 1][0], s[qq][2 * kk + 1][1]); u[3] = pk2(s[qq][2 * kk + 1][2], s[qq][2 * kk + 1][3]);
                    pf[qq][kk] = as_bf(u);
                }
            }
            __builtin_amdgcn_sched_barrier(0);
#pragma unroll
            for (int kk = 0; kk < 2; ++kk)
#pragma unroll
                for (int d = 0; d < 4; ++d) {
                    const u32x2 vlo = *(const u32x2*)(vt_ + (d * 16 + c) * 72 + kk * 32 + g * 4);
                    const u32x2 vhi = *(const u32x2*)(vt_ + (d * 16 + c) * 72 + kk * 32 + 16 + g * 4);
                    u32x4 vv; vv[0] = vlo[0]; vv[1] = vlo[1]; vv[2] = vhi[0]; vv[3] = vhi[1];
                    const bf16x8 vf = as_bf(vv);
#pragma unroll
                    for (int qq = 0; qq < NQB; ++qq) o[qq][d] = mfma16(vf, pf[qq][kk], o[qq][d]);
                }
        }
        if (tt + 1 < ntiles) store_tile(cur ^ 1);
        __syncthreads();
    }
    if (dostore)
#pragma unroll
    for (int qb = 0; qb < NQB; ++qb) {
        float ls = lsum[qb];
        ls += __shfl_xor(ls, 16); ls += __shfl_xor(ls, 32);
        const float inv = __builtin_amdgcn_rcpf(ls);
        bf16_t* rowp = p.P + (size_t)(qbase + qb * qstep + c) * PC;
#pragma unroll
        for (int d = 0; d < 4; ++d) {
            const int dd = d * 16 + g * 4;
            const u32x2 gt = *(const u32x2*)(rowp + gcol + dd);
            const float v0 = o[qb][d][0] * inv * silu_f(lo16(gt[0])), v1 = o[qb][d][1] * inv * silu_f(hi16(gt[0]));
            const float v2 = o[qb][d][2] * inv * silu_f(lo16(gt[1])), v3 = o[qb][d][3] * inv * silu_f(hi16(gt[1]));
            u32x2 o2; o2.x = pk2(v0, v1); o2.y = pk2(v2, v3);
            *(u32x2*)(rowp + qcol + dd) = o2;
        }
    }
}

typedef float f32x16 __attribute__((ext_vector_type(16)));
__device__ __forceinline__ f32x16 mfma32(bf16x8 a, bf16x8 b, f32x16 c) { return __builtin_amdgcn_mfma_f32_32x32x16_bf16(a, b, c, 0, 0, 0); }

template <int MODE>
__device__ void attn_item32(const Params& p, int l, int b, int i1, int i2, unsigned char* lds, bool dostore = true) {
    const int t = tid_opaque(), lane = t & 63, w = t >> 6, h = lane >> 5, c = lane & 31;
    bf16_t* Ks = (bf16_t*)lds;
    bf16_t* Vt = Ks + 2 * 64 * 72;
    u32x4* Qs = (u32x4*)(lds + 36864) + w * 512;
    int qbase, qcol, kcol, vcol, gcol, ntiles;
    if (MODE == 0 || MODE == 1) {
        const int kvh = i1, qt = i2, head = kvh * 4 + w;
        qbase = (MODE == 0 ? b * 8192 : NTOK + b * 256) + qt * 64;
        qcol = C_GQ + head * 64; kcol = C_GK + kvh * 64; vcol = C_GV + kvh * 64; gcol = C_GG + head * 64;
        ntiles = MODE == 0 ? 132 : 4;
    } else {
        const int hh = i1;
        qbase = NTOK + b * 256 + w * 64;
        qcol = C_NQ + hh * 64; kcol = C_NK + hh * 64; vcol = C_NV + hh * 64; gcol = C_NG + hh * 64;
        ntiles = 4;
    }
    const float scale = 0.125f * LOG2E;
    f32x16 o[2][2];
    float mrun[2], lsum[2];
#pragma unroll
    for (int qb = 0; qb < 2; ++qb) {
        mrun[qb] = -INFINITY; lsum[qb] = 0.f;
#pragma unroll
        for (int d = 0; d < 2; ++d)
#pragma unroll
            for (int r = 0; r < 16; ++r) o[qb][d][r] = 0.f;
    }
    const int kkey = t >> 3, kch = (t & 7) * 8;
    const int vkey = t & 63, vch = (t >> 6);
    u32x4 kr[2], vr[2];
    auto load_tile = [&](int tt) {
        const int base = MODE == 0 ? (tt < 128 ? b * 8192 + tt * 64 : NTOK + b * 256 + (tt - 128) * 64) : NTOK + b * 256 + tt * 64;
#pragma unroll
        for (int i = 0; i < 2; ++i) {
            kr[i] = ldg16(p.P + (size_t)(base + kkey + 32 * i) * PC + kcol + kch);
            if (MODE <= 1) vr[i] = ldg16(VG(p) + ((size_t)(b * 2 + i1) * 64 + kkey + 32 * i) * 8448 + (MODE == 0 ? tt * 64 : 8192 + tt * 64) + kch);
            else vr[i] = ldg16(p.P + (size_t)(base + vkey) * PC + vcol + (vch + 4 * i) * 8);
        }
    };
    auto store_tile = [&](int buf) {
        bf16_t* ks_ = Ks + buf * 64 * 72; bf16_t* vt_ = Vt + buf * 64 * 72;
#pragma unroll
        for (int i = 0; i < 2; ++i) {
            *(u32x4*)(ks_ + (kkey + 32 * i) * 72 + kch) = kr[i];
            if (MODE <= 1) { *(u32x4*)(vt_ + (kkey + 32 * i) * 72 + kch) = vr[i]; continue; }
#pragma unroll
            for (int e = 0; e < 4; ++e) {
                const int d = (vch + 4 * i) * 8 + 2 * e;
                vt_[d * 72 + vkey] = (bf16_t)(vr[i][e] & 0xffffu);
                vt_[(d + 1) * 72 + vkey] = (bf16_t)(vr[i][e] >> 16);
            }
        }
    };
    load_tile(0);
    __syncthreads();
#pragma unroll
    for (int qb = 0; qb < 2; ++qb)
#pragma unroll
        for (int ks = 0; ks < 4; ++ks) Qs[(qb * 4 + ks) * 64 + lane] = ldg16(p.P + (size_t)(qbase + qb * 32 + c) * PC + qcol + ks * 16 + h * 8);
    store_tile(0);
    __syncthreads();
    for (int tt = 0; tt < ntiles; ++tt) {
        const int cur = tt & 1;
        if (tt + 1 < ntiles) load_tile(tt + 1);
        const bf16_t* ks_ = Ks + cur * 64 * 72; const bf16_t* vt_ = Vt + cur * 64 * 72;
        f32x16 s[2][2];
#pragma unroll
        for (int qb = 0; qb < 2; ++qb)
#pragma unroll
            for (int kb = 0; kb < 2; ++kb)
#pragma unroll
                for (int r = 0; r < 16; ++r) s[qb][kb][r] = 0.f;
#pragma unroll
        for (int ks = 0; ks < 4; ++ks) {
            const bf16x8 q0 = as_bf(Qs[ks * 64 + lane]), q1 = as_bf(Qs[(4 + ks) * 64 + lane]);
#pragma unroll
            for (int kb = 0; kb < 2; ++kb) {
                const bf16x8 kf = *(const bf16x8*)(ks_ + (kb * 32 + c) * 72 + ks * 16 + h * 8);
                s[0][kb] = mfma32(kf, q0, s[0][kb]);
                s[1][kb] = mfma32(kf, q1, s[1][kb]);
            }
        }
        bf16x8 pf[2][4];
#pragma unroll
        for (int qb = 0; qb < 2; ++qb) {
            float tmax = s[qb][0][0];
#pragma unroll
            for (int kb = 0; kb < 2; ++kb)
#pragma unroll
                for (int r = 0; r < 16; r += 4) tmax = fmaxf(tmax, fmaxf(fmaxf(s[qb][kb][r], s[qb][kb][r + 1]), fmaxf(s[qb][kb][r + 2], s[qb][kb][r + 3])));
            tmax = fmaxf(tmax, __shfl_xor(tmax, 32));
            const float mn = fmaxf(mrun[qb], tmax * scale);
            const float alpha = ex2(mrun[qb] - mn);
            mrun[qb] = mn;
            float psum = 0.f;
#pragma unroll
            for (int kb = 0; kb < 2; ++kb)
#pragma unroll
                for (int r = 0; r < 16; ++r) { const float pv = ex2(__builtin_fmaf(s[qb][kb][r], scale, -mn)); s[qb][kb][r] = pv; psum += pv; }
            lsum[qb] = lsum[qb] * alpha + psum;
            if (__builtin_amdgcn_ballot_w64(alpha != 1.f) != 0ull) {
#pragma unroll
                for (int d = 0; d < 2; ++d)
#pragma unroll
                    for (int r = 0; r < 16; ++r) o[qb][d][r] *= alpha;
            }
#pragma unroll
            for (int kb = 0; kb < 2; ++kb)
#pragma unroll
                for (int st = 0; st < 2; ++st) {
                    u32x4 u;
#pragma unroll
                    for (int e = 0; e < 4; ++e) u[e] = pk2(s[qb][kb][8 * st + 2 * e], s[qb][kb][8 * st + 2 * e + 1]);
                    pf[qb][kb * 2 + st] = as_bf(u);
                }
        }
#pragma unroll
        for (int kk = 0; kk < 4; ++kk)
#pragma unroll
            for (int d = 0; d < 2; ++d) {
                const u32x2 vlo = *(const u32x2*)(vt_ + (d * 32 + c) * 72 + kk * 16 + h * 4);
                const u32x2 vhi = *(const u32x2*)(vt_ + (d * 32 + c) * 72 + kk * 16 + 8 + h * 4);
                u32x4 vv; vv[0] = vlo[0]; vv[1] = vlo[1]; vv[2] = vhi[0]; vv[3] = vhi[1];
                const bf16x8 vf = as_bf(vv);
                o[0][d] = mfma32(vf, pf[0][kk], o[0][d]);
                o[1][d] = mfma32(vf, pf[1][kk], o[1][d]);
            }
        if (tt + 1 < ntiles) store_tile(cur ^ 1);
        __syncthreads();
    }
    if (dostore)
#pragma unroll
    for (int qb = 0; qb < 2; ++qb) {
        float ls = lsum[qb];
        ls += __shfl_xor(ls, 32);
        const float inv = __builtin_amdgcn_rcpf(ls);
        bf16_t* rowp = p.P + (size_t)(qbase + qb * 32 + c) * PC;
#pragma unroll
        for (int d = 0; d < 2; ++d)
#pragma unroll
            for (int rg = 0; rg < 4; ++rg) {
                const int dd = d * 32 + rg * 8 + h * 4;
                const u32x2 gt = *(const u32x2*)(rowp + gcol + dd);
                const float v0 = o[qb][d][rg * 4 + 0] * inv * silu_f(lo16(gt[0])), v1 = o[qb][d][rg * 4 + 1] * inv * silu_f(hi16(gt[0]));
                const float v2 = o[qb][d][rg * 4 + 2] * inv * silu_f(lo16(gt[1])), v3 = o[qb][d][rg * 4 + 3] * inv * silu_f(hi16(gt[1]));
                u32x2 o2; o2.x = pk2(v0, v1); o2.y = pk2(v2, v3);
                *(u32x2*)(rowp + qcol + dd) = o2;
            }
    }
}

__device__ __forceinline__ bf16x8 scale_frag(bf16x8 f, float sc) {
    u32x4 u = as_u(f), r;
#pragma unroll
    for (int e = 0; e < 4; ++e) r[e] = pk2(lo16(u[e]) * sc, hi16(u[e]) * sc);
    return as_bf(r);
}

__device__ void ret_item(const Params& p, int l, int b, int h, int cidx, int hf, unsigned char* lds, bool dostore = true) {
    const int t = tid_opaque(), lane = t & 63, w = t >> 6, g = lane >> 4, c = lane & 15;
    bf16_t* B0 = (bf16_t*)lds;
    bf16_t* B1 = B0 + 128 * 136;
    const float lgf = -__expf(p.ret_log_decay[l * 8 + h]) * LOG2E, lgb = -__expf(p.ret_log_decay[l * 8 + 4 + h]) * LOG2E;
    const float ksc = 0.08838834764831845f;
    const int rowbase = chunk_row(b, cidx);
    const int ti = hf * 64 + w * 16 + c;
    bf16x8 qf[4];
#pragma unroll
    for (int ks = 0; ks < 4; ++ks) qf[ks] = as_bf(ldg16(p.P + (size_t)(rowbase + ti) * PC + C_RQ + h * 128 + ks * 32 + g * 8));
    __syncthreads();
#pragma unroll
    for (int i = 0; i < 8; ++i) {
        const int cc = t + 256 * i;
        { const int r = cc >> 4, ch = cc & 15; *(u32x4*)(B0 + r * 136 + ch * 8) = ldg16(p.P + (size_t)(rowbase + r) * PC + C_RK + h * 128 + ch * 8); }
        { const int tok = cc & 127, ch = cc >> 7;
          const u32x4 vv = ldg16(p.P + (size_t)(rowbase + tok) * PC + C_RV + h * 128 + ch * 8);
#pragma unroll
          for (int e = 0; e < 4; ++e) { B1[(ch * 8 + 2 * e) * 136 + tok] = (bf16_t)(vv[e] & 0xffffu); B1[(ch * 8 + 2 * e + 1) * 136 + tok] = (bf16_t)(vv[e] >> 16); } }
    }
    __syncthreads();
    bf16x8 pf[4];
    {
        f32x4 s[8];
#pragma unroll
        for (int kb = 0; kb < 8; ++kb) s[kb] = (f32x4){0.f, 0.f, 0.f, 0.f};
#pragma unroll
        for (int ks = 0; ks < 4; ++ks)
#pragma unroll
            for (int kb = 0; kb < 8; ++kb) {
                const bf16x8 kf = *(const bf16x8*)(B0 + (kb * 16 + c) * 136 + ks * 32 + g * 8);
                s[kb] = mfma16(kf, qf[ks], s[kb]);
            }
#pragma unroll
        for (int kb = 0; kb < 8; ++kb)
#pragma unroll
            for (int r = 0; r < 4; ++r) {
                const int j = kb * 16 + g * 4 + r, d = ti - j;
                const float wgt = d > 0 ? ex2(lgf * (float)d) : (d < 0 ? ex2(lgb * (float)(-d)) : 2.f);
                s[kb][r] *= wgt * ksc;
            }
#pragma unroll
        for (int kk = 0; kk < 4; ++kk) {
            u32x4 u;
            u[0] = pk2(s[2 * kk][0], s[2 * kk][1]); u[1] = pk2(s[2 * kk][2], s[2 * kk][3]);
            u[2] = pk2(s[2 * kk + 1][0], s[2 * kk + 1][1]); u[3] = pk2(s[2 * kk + 1][2], s[2 * kk + 1][3]);
            pf[kk] = as_bf(u);
        }
    }
    f32x4 o[8];
#pragma unroll
    for (int d = 0; d < 8; ++d) o[d] = (f32x4){0.f, 0.f, 0.f, 0.f};
#pragma unroll
    for (int kk = 0; kk < 4; ++kk)
#pragma unroll
        for (int d = 0; d < 8; ++d) {
            const u32x2 vlo = *(const u32x2*)(B1 + (d * 16 + c) * 136 + kk * 32 + g * 4);
            const u32x2 vhi = *(const u32x2*)(B1 + (d * 16 + c) * 136 + kk * 32 + 16 + g * 4);
            u32x4 vv; vv[0] = vlo[0]; vv[1] = vlo[1]; vv[2] = vhi[0]; vv[3] = vhi[1];
            o[d] = mfma16(as_bf(vv), pf[kk], o[d]);
        }
    __syncthreads();
    {
        const bf16_t* Sf = p.SU + ((size_t)((0 * 4 + b) * 4 + h) * 66 + cidx) * 16384;
        const bf16_t* Sb = p.SU + ((size_t)((1 * 4 + b) * 4 + h) * 66 + cidx) * 16384;
#pragma unroll
        for (int i = 0; i < 8; ++i) {
            const int cc = t + 256 * i, r = cc >> 4, ch = cc & 15;
            *(u32x4*)(B0 + r * 136 + ch * 8) = ldg16(Sf + r * 128 + ch * 8);
            *(u32x4*)(B1 + r * 136 + ch * 8) = ldg16(Sb + r * 128 + ch * 8);
        }
    }
    __syncthreads();
#pragma unroll
    for (int dir = 0; dir < 2; ++dir) {
        const bf16_t* Bd = dir ? B1 : B0;
        const float xi = dir == 0 ? ex2(lgf * (float)(ti + 1)) : ex2(lgb * (float)(128 - ti));
        bf16x8 qs[4];
#pragma unroll
        for (int ks = 0; ks < 4; ++ks) qs[ks] = scale_frag(qf[ks], xi);
#pragma unroll
        for (int ks = 0; ks < 4; ++ks)
#pragma unroll
            for (int d = 0; d < 8; ++d) {
                const bf16x8 sf = *(const bf16x8*)(Bd + (d * 16 + c) * 136 + ks * 32 + g * 8);
                o[d] = mfma16(sf, qs[ks], o[d]);
            }
    }
    if (dostore) {
        float sum = 0.f;
#pragma unroll
        for (int d = 0; d < 8; ++d) sum += (o[d][0] + o[d][1]) + (o[d][2] + o[d][3]);
        sum += __shfl_xor(sum, 16); sum += __shfl_xor(sum, 32);
        const float mu = sum * (1.f / 128.f);
        float var = 0.f;
#pragma unroll
        for (int d = 0; d < 8; ++d)
#pragma unroll
            for (int r = 0; r < 4; ++r) { const float dd = o[d][r] - mu; var += dd * dd; }
        var += __shfl_xor(var, 16); var += __shfl_xor(var, 32);
        const float rstd = rsqrtf(var * (1.f / 128.f) + EPSN);
        bf16_t* rowp = p.P + (size_t)(rowbase + ti) * PC;
#pragma unroll
        for (int d = 0; d < 8; ++d) {
            const int dv = d * 16 + g * 4;
            const f32x4 gn = *(const f32x4*)(p.ret_gn_w + l * 512 + h * 128 + dv);
            const u32x2 gt = *(const u32x2*)(rowp + C_RG + h * 128 + dv);
            const float v0 = (o[d][0] - mu) * rstd * gn[0] * silu_f(lo16(gt[0])), v1 = (o[d][1] - mu) * rstd * gn[1] * silu_f(hi16(gt[0]));
            const float v2 = (o[d][2] - mu) * rstd * gn[2] * silu_f(lo16(gt[1])), v3 = (o[d][3] - mu) * rstd * gn[3] * silu_f(hi16(gt[1]));
            u32x2 o2; o2.x = pk2(v0, v1); o2.y = pk2(v2, v3);
            *(u32x2*)(rowp + C_RQ + h * 128 + dv) = o2;
        }
    }
}

__device__ void phase_d(const Params& p, int l, unsigned char* lds) {
    const bool need_ctx = l < 3;
    const int G = gridDim.x, bid = blockIdx.x;
#pragma unroll 1
    for (int it = bid; it < 1024; it += G) {
#if PROBE == 2
        attn_item32<0>(p, l, it >> 8, (it >> 7) & 1, it & 127, lds, p.out == nullptr);
#endif
        attn_item32<0>(p, l, it >> 8, (it >> 7) & 1, it & 127, lds);
    }
    __syncthreads();
#pragma unroll 1
    for (int it = bid; it < 2048; it += G) {
#if PROBE == 3
        attn_item<2>(p, l, it >> 9, (it >> 6) & 7, (it >> 2) & 15, it & 3, lds, p.out == nullptr);
#endif
        attn_item<2>(p, l, it >> 9, (it >> 6) & 7, (it >> 2) & 15, it & 3, lds);
    }
    __syncthreads();
    {
        const int nch = need_ctx ? 66 : 64, n_ret = nch * 32;
#pragma unroll 1
        for (int it = G - 1 - bid; it < n_ret; it += G) {
            const int hf = it & 1, it2 = it >> 1;
            const int cidx = it2 % nch, bh = it2 / nch;
#if PROBE == 4
            ret_item(p, l, bh >> 2, bh & 3, cidx, hf, lds, p.out == nullptr);
#endif
            ret_item(p, l, bh >> 2, bh & 3, cidx, hf, lds);
        }
    }
    __syncthreads();
    if (need_ctx) {
#pragma unroll 1
        for (int it = G - 1 - bid; it < 32; it += G) attn_item32<1>(p, l, it >> 3, (it >> 2) & 1, it & 3, lds);
        __syncthreads();
#pragma unroll 1
        for (int it = G - 1 - bid - 32; it < 32; it += G) { if (it >= 0) attn_item32<3>(p, l, it >> 3, it & 7, 0, lds); }
    }
}

template <int NI>
__device__ void phase_e1_t(const Params& p, int l, unsigned char* lds, int mtlo, int mthi, bool rev) {
    const int t = tid_opaque(), lane = t & 63, w = t >> 6, wm = w >> 1, wn = w & 1;
    constexpr int NT = 32 / NI, NW = NI * 32;
    const int total = (mthi - mtlo) * NT;
    for (int item = rev ? (int)(gridDim.x - 1 - blockIdx.x) : (int)blockIdx.x; item < total; item += gridDim.x) {
        const int mt = mtlo + item / NT, nt = item % NT;
        u32x2 macc[NI][4];
#pragma unroll
        for (int a = 0; a < NI; ++a)
#pragma unroll
            for (int b = 0; b < 4; ++b) macc[a][b] = (u32x2){0u, 0u};
#pragma unroll 1
        for (int br = 0; br < 3; ++br) {
            u32x2 sg[NI][4];
            {
                f32x4 gacc[NI][4];
#pragma unroll
                for (int a = 0; a < NI; ++a)
#pragma unroll
                    for (int b = 0; b < 4; ++b) gacc[a][b] = (f32x4){0.f, 0.f, 0.f, 0.f};
                gemm_core<NI>(gacc, p.HX + (size_t)mt * 128 * DM, DM, p.Wt + WT_IN + (size_t)(PC + br * 1024 + nt * NW) * DM, DM, DM, lds);
#pragma unroll
                for (int a = 0; a < NI; ++a)
#pragma unroll
                    for (int b = 0; b < 4; ++b) { sg[a][b].x = pk2(sigm_f(gacc[a][b][0]), sigm_f(gacc[a][b][1])); sg[a][b].y = pk2(sigm_f(gacc[a][b][2]), sigm_f(gacc[a][b][3])); }
            }
            f32x4 pacc[NI][4];
#pragma unroll
            for (int a = 0; a < NI; ++a)
#pragma unroll
                for (int b = 0; b < 4; ++b) pacc[a][b] = (f32x4){0.f, 0.f, 0.f, 0.f};
            const int xcol = br == 0 ? C_RQ : (br == 1 ? C_NQ : C_GQ);
            const int woff = br == 0 ? WT_RET : (br == 1 ? WT_NA : WT_GQA);
            gemm_core<NI>(pacc, p.P + (size_t)mt * 128 * PC + xcol, PC, p.Wt + woff + (size_t)nt * NW * 512, 512, 512, lds);
#pragma unroll
            for (int a = 0; a < NI; ++a)
#pragma unroll
                for (int b = 0; b < 4; ++b) {
                    const float m0 = lo16(macc[a][b].x) + lo16(sg[a][b].x) * pacc[a][b][0], m1 = hi16(macc[a][b].x) + hi16(sg[a][b].x) * pacc[a][b][1];
                    const float m2 = lo16(macc[a][b].y) + lo16(sg[a][b].y) * pacc[a][b][2], m3 = hi16(macc[a][b].y) + hi16(sg[a][b].y) * pacc[a][b][3];
                    macc[a][b].x = pk2(m0, m1); macc[a][b].y = pk2(m2, m3);
                }
        }
#pragma unroll
        for (int ni = 0; ni < NI; ++ni)
#pragma unroll
            for (int mi = 0; mi < 4; ++mi) {
                const int n = nt * NW + wn * (NI * 16) + ni * 16 + (lane >> 4) * 4, m = mt * 128 + wm * 64 + mi * 16 + (lane & 15);
                *(u32x2*)(p.P + (size_t)m * PC + C_M + n) = macc[ni][mi];
            }
    }
}

__device__ void phase_e1(const Params& p, int l, unsigned char* lds) {
    phase_e1_t<4>(p, l, lds, 0, 256, false);
    if (l < 3) phase_e1_t<1>(p, l, lds, 256, 264, true);
}

template <int NI>
__device__ void phase_e2_t(const Params& p, int l, unsigned char* lds, int mtlo, int mthi, bool rev, bool dostore) {
    const int t = tid_opaque(), lane = t & 63, w = t >> 6, wm = w >> 1, wn = w & 1;
    constexpr int NT = 32 / NI, NW = NI * 32;
    const int total = (mthi - mtlo) * NT;
    const float* xsrc = l == 0 ? p.x : p.out;
    const float* ysrc = l == 0 ? p.ctx : p.y;
    for (int item = rev ? (int)(gridDim.x - 1 - blockIdx.x) : (int)blockIdx.x; item < total; item += gridDim.x) {
        const int mt = mtlo + item / NT, nt = item % NT;
        f32x4 acc[NI][4];
#pragma unroll
        for (int a = 0; a < NI; ++a)
#pragma unroll
            for (int b = 0; b < 4; ++b) acc[a][b] = (f32x4){0.f, 0.f, 0.f, 0.f};
        gemm_core<NI>(acc, p.P + (size_t)mt * 128 * PC + C_M, PC, p.Wt + WT_OUT + (size_t)nt * NW * DM, DM, DM, lds);
#pragma unroll
        for (int mi = 0; mi < 4; ++mi) {
            const int m = mt * 128 + wm * 64 + mi * 16 + (lane & 15);
            const bool lat = m < NTOK;
            const int bb = lat ? (m >> 13) : 4;
            const float* src = lat ? xsrc + (size_t)m * DM : ysrc + (size_t)(m - NTOK) * DM;
            float* dst = lat ? p.out + (size_t)m * DM : p.y + (size_t)(m - NTOK) * DM;
            const float* gate = p.mod + (size_t)(l * 5 + bb) * 3072 + 2048;
#pragma unroll
            for (int ni = 0; ni < NI; ++ni) {
                const int n = nt * NW + wn * (NI * 16) + ni * 16 + (lane >> 4) * 4;
                const f32x4 xo = *(const f32x4*)(src + n), gv = *(const f32x4*)(gate + n);
                if (dostore) *(f32x4*)(dst + n) = xo + gv * acc[ni][mi];
            }
        }
    }
}

__device__ void phase_e2(const Params& p, int l, unsigned char* lds, bool dostore = true) {
    phase_e2_t<4>(p, l, lds, 0, 256, false, dostore);
    if (l < 3) phase_e2_t<1>(p, l, lds, 256, 264, true, dostore);
}

__device__ void phase_e3(const Params& p, int l, unsigned char* lds) {
    norm_rows(p, l + 1, p.out, p.y);
    if (l < 3)
        for (int item = blockIdx.x; item < NCONV_ITEMS; item += gridDim.x) convert_item(p, l + 1, item, lds);
}


#ifdef DIAG
__device__ void scan_bf16(const bf16_t* ptr, size_t n, unsigned* flag, unsigned bit) {
    const size_t nch = n / 8;
    bool bad = false;
    for (size_t i = (size_t)blockIdx.x * 256 + threadIdx.x; i < nch; i += (size_t)gridDim.x * 256) {
        const u32x4 u = *(const u32x4*)(ptr + i * 8);
#pragma unroll
        for (int e = 0; e < 4; ++e) { if ((u[e] & 0x7F80u) == 0x7F80u) bad = true; if ((u[e] & 0x7F800000u) == 0x7F800000u) bad = true; }
    }
    if (bad) atomicOr(flag, bit);
}
__device__ void scan_f32(const float* ptr, size_t n, unsigned* flag, unsigned bit) {
    bool bad = false;
    for (size_t i = (size_t)blockIdx.x * 256 + threadIdx.x; i < n; i += (size_t)gridDim.x * 256) {
        if ((__float_as_uint(ptr[i]) & 0x7F800000u) == 0x7F800000u) bad = true;
    }
    if (bad) atomicOr(flag, bit);
}
#endif
__device__ __forceinline__ void run_phase(const Params& p, int ph, int l, unsigned char* lds) {
    switch (ph) {
        case 0: phase_p0(p, lds);
#if PROBE == 7
            phase_p0(p, lds);
#endif
            break;
        case 1: norm_rows(p, 0, p.x, p.ctx); break;
        case 2: phase_a(p, l, lds);
#if PROBE == 1
            phase_a(p, l, lds);
#endif
            break;
        case 3: phase_b(p, l, lds); break;
        case 4:
#if PROBE == 7 || PROBE == 8
            phase_c(p, l, p.out == nullptr);
#endif
            phase_c(p, l); break;
        case 5: phase_d(p, l, lds); break;
        case 6: phase_e1(p, l, lds);
#if PROBE == 5
            phase_e1(p, l, lds);
#endif
            break;
        case 7:
#if PROBE == 7 || PROBE == 9
            phase_e2(p, l, lds, p.out == nullptr);
#endif
            phase_e2(p, l, lds); break;
        default: phase_e3(p, l, lds);
#if PROBE == 6
            phase_e3(p, l, lds);
#endif
            break;
    }
}

#if MULTI_LAUNCH
__global__ void __launch_bounds__(256, 2) phase_kernel(Params p, int ph, int l) {
    __shared__ __attribute__((aligned(16))) unsigned char lds[LDS_BYTES];
    run_phase(p, ph, l, lds);
}
#else
__device__ __forceinline__ void fast_grid_barrier(unsigned* bar, unsigned k) {
    asm volatile("s_waitcnt vmcnt(0) lgkmcnt(0)" ::: "memory");
    __syncthreads();
    if (threadIdx.x == 0) {
        const unsigned grp = blockIdx.x & 7u, members = (gridDim.x - grp + 7u) >> 3;
        __builtin_amdgcn_fence(__ATOMIC_RELEASE, "agent");
        const unsigned old = __hip_atomic_fetch_add(bar + grp * 32, 1u, __ATOMIC_RELAXED, __HIP_MEMORY_SCOPE_AGENT);
        if (old + 1u == k * members) {
            __hip_atomic_fetch_add(bar + 256, 1u, __ATOMIC_RELAXED, __HIP_MEMORY_SCOPE_AGENT);
            while (__hip_atomic_load(bar + 256, __ATOMIC_RELAXED, __HIP_MEMORY_SCOPE_AGENT) < k * 8u) __builtin_amdgcn_s_sleep(1);
            __hip_atomic_store(bar + 288 + grp * 32, k, __ATOMIC_RELAXED, __HIP_MEMORY_SCOPE_AGENT);
        } else {
            while (__hip_atomic_load(bar + 288 + grp * 32, __ATOMIC_RELAXED, __HIP_MEMORY_SCOPE_AGENT) < k) __builtin_amdgcn_s_sleep(1);
        }
        __builtin_amdgcn_fence(__ATOMIC_ACQUIRE, "agent");
    }
    __syncthreads();
}
#define GSYNC() do { asm volatile("s_waitcnt vmcnt(0) lgkmcnt(0)" ::: "memory"); grid.sync(); } while (0)
__global__ void __launch_bounds__(256, 2) mega_kernel(Params p) {
    __shared__ __attribute__((aligned(16))) unsigned char lds[LDS_BYTES];
    cg::grid_group grid = cg::this_grid();
#ifdef DIAG
    unsigned* flag = (unsigned*)(p.rope + 4096);
    if (blockIdx.x == 0 && threadIdx.x == 0) *flag = 0u;
    int l0 = 0; asm volatile("" : "+s"(l0));
#pragma unroll 1
    for (int ph = 0; ph <= DIAG_LAST; ++ph) {
        run_phase(p, ph, l0, lds); GSYNC();
        if (ph == 0) { scan_f32(p.mod, 4 * 5 * 3072, flag, 1u); scan_f32(p.rope, 4096, flag, 1u); scan_bf16(p.Wt, WT_TOTAL, flag, 1u); }
        else if (ph == 1) scan_bf16(p.HX, (size_t)NROWS * DM, flag, 1u);
        else if (ph == 4) scan_bf16(p.SU, (size_t)2 * 4 * 4 * 66 * 16384, flag, 8u);
        else {
            scan_bf16(p.P, (size_t)NROWS * PC, flag, ph == 2 ? 2u : ph == 3 ? 4u : ph == 5 ? 16u : 32u);
            if (ph == 3) scan_bf16(p.SU, (size_t)2 * 4 * 4 * 66 * 16384, flag, 4u);
        }
        GSYNC();
    }
    {
#if DIAG_LAST == 2
        unsigned* cnt = flag + 1;
        if (blockIdx.x == 0 && threadIdx.x == 0) { for (int i = 0; i < 8; ++i) cnt[i] = 0u; *flag = 0u; }
        GSYNC();
        {
            bool huge = false;
            const size_t nch = (size_t)NROWS * DM / 8;
            for (size_t i = (size_t)blockIdx.x * 256 + threadIdx.x; i < nch; i += (size_t)gridDim.x * 256) {
                const u32x4 u = *(const u32x4*)(p.HX + i * 8);
                for (int e = 0; e < 4; ++e) { if (fabsf(lo16(u[e])) > 1e4f || fabsf(hi16(u[e])) > 1e4f) huge = true; }
            }
            const size_t nch2 = (size_t)8448 * DM / 8;
            for (size_t i = (size_t)blockIdx.x * 256 + threadIdx.x; i < nch2; i += (size_t)gridDim.x * 256) {
                const u32x4 u = *(const u32x4*)(p.Wt + i * 8);
                for (int e = 0; e < 4; ++e) { if (fabsf(lo16(u[e])) > 1e4f || fabsf(hi16(u[e])) > 1e4f) huge = true; }
            }
            if (huge) atomicAdd(cnt + 4, 1u);
        }
        if (blockIdx.x < 4) {
            const int mts[4] = {0, 0, 1, 3}, nts[4] = {0, 1, 0, 5};
            const int mt = mts[blockIdx.x], nt = nts[blockIdx.x];
            unsigned bad = 0;
            for (int j = 0; j < 64; ++j) {
                const int e = threadIdx.x + 256 * j, m = mt * 128 + (e >> 7), n = nt * 128 + (e & 127);
                float d = 0.f;
                for (int k = 0; k < 1024; ++k) d += bf2f(p.HX[(size_t)m * DM + k]) * bf2f(p.Wt[WT_IN + (size_t)n * DM + k]);
                const float pv = bf2f(p.P[(size_t)m * PC + n]);
                if (!(fabsf(d - pv) <= 0.05f + 0.05f * fabsf(d))) ++bad;
            }
            if (bad) atomicAdd(cnt + blockIdx.x, bad);
        }
        GSYNC();
        if (blockIdx.x == 0 && threadIdx.x == 0) {
            unsigned f = 0;
            if (cnt[0] > 0u) f |= 1u;
            if (cnt[0] > 8192u) f |= 2u;
            if (cnt[1] > 0u) f |= 4u;
            if (cnt[2] > 0u) f |= 8u;
            if (cnt[3] > 0u) f |= 16u;
            if (cnt[4] > 0u) f |= 32u;
            *flag = f;
        }
        GSYNC();
#endif
        const float code = (10.f + (float)(*flag)) * 100.f;
        for (size_t i = (size_t)blockIdx.x * 256 + threadIdx.x; i < (size_t)NTOK * DM; i += (size_t)gridDim.x * 256) p.out[i] = i == 0 ? code : 0.f;
    }
#else
#ifdef TIMING
#define tsum ((unsigned long long*)(p.rope + 4096 + 16))
    int tidx = 0;
#define TSTAMP(ph) do { if (blockIdx.x == 0) { int z_ = tid_opaque(); if (z_ == 0) tsum[tidx + z_] = __builtin_amdgcn_s_memrealtime(); } ++tidx; } while (0)
    TSTAMP(0);
#else
#define TSTAMP(ph) do { } while (0)
#endif
    unsigned bk = 0;
    run_phase(p, 0, 0, lds); GSYNC(); TSTAMP(0);
    run_phase(p, 1, 0, lds); fast_grid_barrier(p.bar, ++bk); TSTAMP(1);
    for (int l = 0; l < 4; ++l) {
#pragma unroll 1
        for (int ph = 2; ph <= 8; ++ph) {
            run_phase(p, ph, l, lds);
#ifdef TIMING
            GSYNC(); TSTAMP(ph);
#else
            if (!(l == 3 && ph == 8)) fast_grid_barrier(p.bar, ++bk);
#endif
        }
    }
#ifdef TIMING
    {
        float f0, f1, f2 = 0.f, f3 = 0.f, f4 = 0.f, f5 = 0.f, f6 = 0.f, f7 = 0.f, f8 = 0.f;
        f0 = (float)(tsum[1] - tsum[0]); f1 = (float)(tsum[2] - tsum[1]);
        for (int l = 0; l < 4; ++l) {
            const unsigned long long* tb = tsum + 2 + l * 7;
            f2 += (float)(tb[1] - tb[0]); f3 += (float)(tb[2] - tb[1]); f4 += (float)(tb[3] - tb[2]); f5 += (float)(tb[4] - tb[3]);
            f6 += (float)(tb[5] - tb[4]); f7 += (float)(tb[6] - tb[5]); f8 += (float)(tb[7] - tb[6]);
        }
        const float tot = f0 + f1 + f2 + f3 + f4 + f5 + f6 + f7 + f8;
#if TIMING == 0
        const float a1 = f5, a2 = f2;
#elif TIMING == 1
        const float a1 = f6, a2 = f7;
#elif TIMING == 2
        const float a1 = f3 + f4, a2 = f8 + f0 + f1;
#else
        const float a1 = f8 + f0 + f1, a2 = f3;
#endif
        const float v1 = 200.f + 16.f * rintf(50.f * a1 / tot), v2 = 10.f + 1.8f * rintf(50.f * a2 / tot);
        for (size_t i = (size_t)blockIdx.x * 256 + threadIdx.x; i < (size_t)NTOK * DM; i += (size_t)gridDim.x * 256)
            p.out[i] = i == 0 ? v1 : (i <= 1048576 ? v2 : 0.f);
    }
#endif
#endif
}
#endif

extern "C" void kernel_launch(void* const* d_in, const int* in_sizes, int n_in, void* d_out, int out_size, void* d_ws, size_t ws_size, hipStream_t stream) {
    Params p{};
    p.x = (const float*)d_in[0]; p.c = (const float*)d_in[1]; p.ctx = (const float*)d_in[2]; p.c_ctx = (const float*)d_in[3];
    p.ada_w = (const float*)d_in[4]; p.ada_b = (const float*)d_in[5]; p.norm_w = (const float*)d_in[6]; p.w_in = (const float*)d_in[7];
    p.ret_log_decay = (const float*)d_in[8]; p.ret_gn_w = (const float*)d_in[9]; p.na_rpb = (const float*)d_in[10];
    p.q_norm_w = (const float*)d_in[11]; p.k_norm_w = (const float*)d_in[12]; p.w_ret_o = (const float*)d_in[13];
    p.w_na_o = (const float*)d_in[14]; p.w_gqa_o = (const float*)d_in[15]; p.w_out = (const float*)d_in[16]; p.final_norm_w = (const float*)d_in[17];
    p.out = (float*)d_out;
    unsigned char* ws = (unsigned char*)d_ws;
    size_t off = 0;
    p.P = (bf16_t*)(ws + off); off += (size_t)NROWS * PC * 2;
    p.HX = (bf16_t*)(ws + off); off += (size_t)NROWS * DM * 2;
    p.Wt = (bf16_t*)(ws + off); off += (size_t)WT_TOTAL * 2;
    p.SU = (bf16_t*)(ws + off); off += (size_t)2 * 4 * 4 * 66 * 16384 * 2;
    p.y = (float*)(ws + off); off += (size_t)1024 * 1024 * 4;
    p.mod = (float*)(ws + off); off += (size_t)4 * 5 * 3072 * 4;
    p.rope = (float*)(ws + off); off += (size_t)128 * 16 * 2 * 4 + 256;
    p.bar = (unsigned*)(ws + off); off += 4096;
    off += (size_t)4 * 2 * 64 * 8448 * 2;
    if (off > ws_size) { fprintf(stderr, "workspace too small: need %zu have %zu\n", off, ws_size); return; }
#if MULTI_LAUNCH
    const int grid = 512;
    phase_kernel<<<grid, 256, 0, stream>>>(p, 0, 0);
    phase_kernel<<<grid, 256, 0, stream>>>(p, 1, 0);
    for (int l = 0; l < 4; ++l)
        for (int ph = 2; ph <= 8; ++ph) phase_kernel<<<grid, 256, 0, stream>>>(p, ph, l);
#else
    static int grid_blocks = 0;
    if (!grid_blocks) {
        int dev = 0, cus = 0, per_cu = 0;
        hipGetDevice(&dev);
        hipDeviceGetAttribute(&cus, hipDeviceAttributeMultiprocessorCount, dev);
        hipOccupancyMaxActiveBlocksPerMultiprocessor(&per_cu, mega_kernel, 256, 0);
        if (per_cu > 2) per_cu = 2;
        grid_blocks = cus * per_cu;
    }
    hipMemsetAsync(p.bar, 0, 4096, stream);
    void* args[] = {&p};
    hipError_t e = hipLaunchCooperativeKernel((void*)mega_kernel, dim3(grid_blocks), dim3(256), args, 0, stream);
    if (e != hipSuccess) fprintf(stderr, "cooperative launch failed: %s (grid %d)\n", hipGetErrorString(e), grid_blocks);
#endif
}
```

```cpp
#include <hip/hip_runtime.h>
#include <hip/hip_cooperative_groups.h>
#include <cstdio>
#include <cstdint>
namespace cg = cooperative_groups;

#ifndef PROBE
#define PROBE 0
#endif
#ifndef MULTI_LAUNCH
#define MULTI_LAUNCH 0
#endif

typedef unsigned short bf16_t;
typedef short bf16x8 __attribute__((ext_vector_type(8)));
typedef float f32x4 __attribute__((ext_vector_type(4)));
typedef unsigned u32x4 __attribute__((ext_vector_type(4)));
typedef unsigned u32x2 __attribute__((ext_vector_type(2)));

#define DM 1024
#define NTOK 32768
#define NROWS 33792
#define PC 5376
#define INC 8448
#define LOG2E 1.4426950408889634f
#define EPSN 1e-6f
#define LDS_BYTES 73728

#define C_RQ 0
#define C_RK 512
#define C_RV 1024
#define C_RG 1536
#define C_NQ 2048
#define C_NK 2560
#define C_NV 3072
#define C_NG 3584
#define C_GQ 4096
#define C_GK 4608
#define C_GV 4736
#define C_GG 4864
#define C_M  512

#define WT_IN 0
#define WT_RET (8448 * 1024)
#define WT_NA (WT_RET + 1024 * 512)
#define WT_GQA (WT_NA + 1024 * 512)
#define WT_OUT (WT_GQA + 1024 * 512)
#define WT_TOTAL (WT_OUT + 1024 * 1024)

#define VG(p) ((bf16_t*)((unsigned char*)(p).bar + 4096))
struct Params {
    const float *x, *c, *ctx, *c_ctx, *ada_w, *ada_b, *norm_w, *w_in, *ret_log_decay, *ret_gn_w, *na_rpb, *q_norm_w, *k_norm_w,
        *w_ret_o, *w_na_o, *w_gqa_o, *w_out, *final_norm_w;
    float* out;
    bf16_t* P;
    bf16_t* HX;
    bf16_t* Wt;
    bf16_t* SU;
    float* y;
    float* mod;
    float* rope;
    unsigned* bar;
};

__device__ __forceinline__ int tid_opaque() { int t = threadIdx.x; asm volatile("" : "+v"(t)); return t; }
__device__ __forceinline__ float bf2f(bf16_t v) { return __uint_as_float(((unsigned)v) << 16); }
typedef __bf16 bf16x2_t __attribute__((ext_vector_type(2)));
typedef float f32x2_t __attribute__((ext_vector_type(2)));
__device__ __forceinline__ unsigned pk2(float lo, float hi) {
    f32x2_t v = {lo, hi};
    union { bf16x2_t b; unsigned u; } x; x.b = __builtin_convertvector(v, bf16x2_t); return x.u;
}
__device__ __forceinline__ bf16_t f2bf(float f) { return (bf16_t)(pk2(f, 0.f) & 0xffffu); }
__device__ __forceinline__ float lo16(unsigned u) { return __uint_as_float(u << 16); }
__device__ __forceinline__ float hi16(unsigned u) { return __uint_as_float(u & 0xffff0000u); }
__device__ __forceinline__ float ex2(float x) { return __builtin_amdgcn_exp2f(x); }
__device__ __forceinline__ float silu_f(float x) { return x * __builtin_amdgcn_rcpf(1.f + ex2(-x * LOG2E)); }
__device__ __forceinline__ float sigm_f(float x) { return __builtin_amdgcn_rcpf(1.f + ex2(-x * LOG2E)); }
__device__ __forceinline__ f32x4 mfma16(bf16x8 a, bf16x8 b, f32x4 c) { return __builtin_amdgcn_mfma_f32_16x16x32_bf16(a, b, c, 0, 0, 0); }
__device__ __forceinline__ bf16x8 as_bf(u32x4 u) { union { u32x4 a; bf16x8 b; } x; x.a = u; return x.b; }
__device__ __forceinline__ u32x4 as_u(bf16x8 u) { union { u32x4 a; bf16x8 b; } x; x.b = u; return x.a; }
__device__ __forceinline__ u32x4 ldg16(const bf16_t* p) { return *(const u32x4*)p; }

template <int NI>
__device__ __forceinline__ void gemm_core(f32x4 (&acc)[NI][4], const bf16_t* __restrict__ X, int ldx, const bf16_t* __restrict__ W, int ldw, int K, unsigned char* lds) {
    const int t = tid_opaque(), lane = t & 63, w = t >> 6, wm = w >> 1, wn = w & 1;
    bf16_t* Xs = (bf16_t*)lds;
    bf16_t* Ws = Xs + 2 * 128 * 72;
    const int sr = t >> 3, sc = (t & 7) * 8;
    const bf16_t* xg = X + (size_t)sr * ldx + sc;
    const bf16_t* wg = W + (size_t)sr * ldw + sc;
    u32x4 xr[4], wr[NI];
#pragma unroll
    for (int i = 0; i < 4; ++i) xr[i] = ldg16(xg + (size_t)i * 32 * ldx);
#pragma unroll
    for (int i = 0; i < NI; ++i) wr[i] = ldg16(wg + (size_t)i * 32 * ldw);
    __syncthreads();
#pragma unroll
    for (int i = 0; i < 4; ++i) *(u32x4*)(Xs + (sr + i * 32) * 72 + sc) = xr[i];
#pragma unroll
    for (int i = 0; i < NI; ++i) *(u32x4*)(Ws + (sr + i * 32) * 72 + sc) = wr[i];
    __syncthreads();
    const int nk = K >> 6;
    for (int kt = 0; kt < nk; ++kt) {
        const int cur = kt & 1;
        if (kt + 1 < nk) {
            const int ko = (kt + 1) * 64;
#pragma unroll
            for (int i = 0; i < 4; ++i) xr[i] = ldg16(xg + (size_t)i * 32 * ldx + ko);
#pragma unroll
            for (int i = 0; i < NI; ++i) wr[i] = ldg16(wg + (size_t)i * 32 * ldw + ko);
        }
        __builtin_amdgcn_sched_barrier(0);
        const bf16_t* xs = Xs + cur * 128 * 72 + (wm * 64 + (lane & 15)) * 72 + (lane >> 4) * 8;
        const bf16_t* ws = Ws + cur * 128 * 72 + (wn * (NI * 16) + (lane & 15)) * 72 + (lane >> 4) * 8;
#pragma unroll
        for (int ks = 0; ks < 2; ++ks) {
            bf16x8 xf[4], wf[NI];
#pragma unroll
            for (int i = 0; i < 4; ++i) xf[i] = *(const bf16x8*)(xs + i * 16 * 72 + ks * 32);
#pragma unroll
            for (int i = 0; i < NI; ++i) wf[i] = *(const bf16x8*)(ws + i * 16 * 72 + ks * 32);
#pragma unroll
            for (int ni = 0; ni < NI; ++ni)
#pragma unroll
                for (int mi = 0; mi < 4; ++mi) acc[ni][mi] = mfma16(wf[ni], xf[mi], acc[ni][mi]);
        }
        if (kt + 1 < nk) {
            const int nx = cur ^ 1;
#pragma unroll
            for (int i = 0; i < 4; ++i) *(u32x4*)(Xs + nx * 128 * 72 + (sr + i * 32) * 72 + sc) = xr[i];
#pragma unroll
            for (int i = 0; i < NI; ++i) *(u32x4*)(Ws + nx * 128 * 72 + (sr + i * 32) * 72 + sc) = wr[i];
        }
        __syncthreads();
    }
}

__device__ __forceinline__ void gemm_big(f32x4 (&acc)[4][8], const bf16_t* __restrict__ X, int ldx, const bf16_t* __restrict__ W, int ldw, int K, unsigned char* lds) {
    const int t = tid_opaque(), lane = t & 63, w = t >> 6, wm = w >> 1, wn = w & 1;
    bf16_t* Xs = (bf16_t*)lds;
    bf16_t* Ws = Xs + 2 * 256 * 40;
    const int sr = t >> 2, sc = (t & 3) * 8;
    const bf16_t* xg = X + (size_t)sr * ldx + sc;
    const bf16_t* wg = W + (size_t)sr * ldw + sc;
    u32x4 ra[6], rb[6];
#define GB_LOAD(r, ko) do { _Pragma("unroll") for (int i = 0; i < 4; ++i) r[i] = ldg16(xg + (size_t)i * 64 * ldx + (ko)); _Pragma("unroll") for (int i = 0; i < 2; ++i) r[4 + i] = ldg16(wg + (size_t)i * 64 * ldw + (ko)); } while (0)
#define GB_ST1(r, st, i) do { if ((i) < 4) *(u32x4*)(Xs + (st) * 256 * 40 + (sr + (i) * 64) * 40 + sc) = r[i]; else *(u32x4*)(Ws + (st) * 128 * 40 + (sr + ((i) - 4) * 64) * 40 + sc) = r[i]; } while (0)
#define GB_STEP(st, r, dostore) do { \
        const bf16_t* xs = Xs + (st) * 256 * 40 + (wm * 128 + (lane & 15)) * 40 + (lane >> 4) * 8; \
        const bf16_t* ws = Ws + (st) * 128 * 40 + (wn * 64 + (lane & 15)) * 40 + (lane >> 4) * 8; \
        bf16x8 wf[4]; \
        _Pragma("unroll") for (int i = 0; i < 4; ++i) wf[i] = *(const bf16x8*)(ws + i * 16 * 40); \
        _Pragma("unroll") for (int mi = 0; mi < 8; ++mi) { \
            const bf16x8 xf = *(const bf16x8*)(xs + mi * 16 * 40); \
            _Pragma("unroll") for (int ni = 0; ni < 4; ++ni) acc[ni][mi] = mfma16(wf[ni], xf, acc[ni][mi]); \
            if ((dostore) && mi >= 1 && mi <= 6) GB_ST1(r, (st) ^ 1, mi - 1); } } while (0)
    GB_LOAD(ra, 0);
    GB_LOAD(rb, 32);
    __syncthreads();
#pragma unroll
    for (int i = 0; i < 6; ++i) GB_ST1(ra, 0, i);
    __syncthreads();
    const int nk = K >> 5;
    for (int kt = 0; kt < nk; kt += 2) {
        if (kt + 2 < nk) GB_LOAD(ra, (kt + 2) * 32);
        GB_STEP(0, rb, true);
        __syncthreads();
        if (kt + 3 < nk) GB_LOAD(rb, (kt + 3) * 32);
        GB_STEP(1, ra, kt + 2 < nk);
        __syncthreads();
    }
#undef GB_LOAD
#undef GB_ST1
#undef GB_STEP
}

__device__ void adaln_item(const Params& p, int item, unsigned char* lds) {
    const int t = tid_opaque(), lane = t & 63, w = t >> 6;
    const int l = item / 48, cgp = item % 48, j = cgp * 64 + lane;
    float* cs = (float*)lds;
    float* red = (float*)(lds + 20480);
    __syncthreads();
    for (int idx = t; idx < 5120; idx += 256) {
        const int bb = idx >> 10, k = idx & 1023;
        const float v = bb < 4 ? p.c[bb * 1024 + k] : p.c_ctx[k];
        cs[idx] = silu_f(v);
    }
    __syncthreads();
    float a0 = 0.f, a1 = 0.f, a2 = 0.f, a3 = 0.f, a4 = 0.f;
    const float* aw = p.ada_w + ((size_t)l * 1024 + w * 256) * 3072 + j;
    for (int k = 0; k < 256; ++k) {
        const float wv = aw[(size_t)k * 3072];
        const int kk = w * 256 + k;
        a0 += cs[kk] * wv; a1 += cs[1024 + kk] * wv; a2 += cs[2048 + kk] * wv; a3 += cs[3072 + kk] * wv; a4 += cs[4096 + kk] * wv;
    }
    red[(w * 5 + 0) * 64 + lane] = a0; red[(w * 5 + 1) * 64 + lane] = a1; red[(w * 5 + 2) * 64 + lane] = a2;
    red[(w * 5 + 3) * 64 + lane] = a3; red[(w * 5 + 4) * 64 + lane] = a4;
    __syncthreads();
    for (int idx = t; idx < 320; idx += 256) {
        const int bb = idx >> 6, ln = idx & 63;
        float v = p.ada_b[l * 3072 + cgp * 64 + ln];
#pragma unroll
        for (int ww = 0; ww < 4; ++ww) v += red[(ww * 5 + bb) * 64 + ln];
        p.mod[(l * 5 + bb) * 3072 + cgp * 64 + ln] = v;
    }
}

__device__ void transpose_tile(const float* __restrict__ src, int N, bf16_t* __restrict__ dst, int K, int k0, int n0, unsigned char* lds) {
    const int t = tid_opaque();
    bf16_t* T = (bf16_t*)lds;
    __syncthreads();
#pragma unroll
    for (int i = 0; i < 4; ++i) {
        const int k = (t >> 4) + 16 * i, n4 = (t & 15) * 4;
        const f32x4 v = *(const f32x4*)(src + (size_t)(k0 + k) * N + n0 + n4);
        T[(n4 + 0) * 72 + k] = f2bf(v[0]); T[(n4 + 1) * 72 + k] = f2bf(v[1]); T[(n4 + 2) * 72 + k] = f2bf(v[2]); T[(n4 + 3) * 72 + k] = f2bf(v[3]);
    }
    __syncthreads();
#pragma unroll
    for (int i = 0; i < 2; ++i) {
        const int cidx = t + 256 * i, n = cidx >> 3, kc = cidx & 7;
        *(u32x4*)(dst + (size_t)(n0 + n) * K + k0 + kc * 8) = *(const u32x4*)(T + n * 72 + kc * 8);
    }
}

#define NCONV_ITEMS (2112 + 3 * 128 + 256)
__device__ void convert_item(const Params& p, int l, int item, unsigned char* lds) {
    if (item < 2112) {
        const int kt = item / 132, nt = item % 132;
        transpose_tile(p.w_in + (size_t)l * 1024 * INC, INC, p.Wt + WT_IN, 1024, kt * 64, nt * 64, lds);
    } else if (item < 2112 + 384) {
        const int it = item - 2112, which = it / 128, r = it % 128, kt = r / 16, nt = r % 16;
        const float* src = (which == 0 ? p.w_ret_o : which == 1 ? p.w_na_o : p.w_gqa_o) + (size_t)l * 512 * 1024;
        bf16_t* dst = p.Wt + (which == 0 ? WT_RET : which == 1 ? WT_NA : WT_GQA);
        transpose_tile(src, 1024, dst, 512, kt * 64, nt * 64, lds);
    } else {
        const int it = item - 2112 - 384, kt = it / 16, nt = it % 16;
        transpose_tile(p.w_out + (size_t)l * 1024 * 1024, 1024, p.Wt + WT_OUT, 1024, kt * 64, nt * 64, lds);
    }
}

__device__ void rope_table(const Params& p) {
    for (int idx = tid_opaque(); idx < 2048; idx += 256) {
        const int pos = idx >> 4, i = idx & 15;
        const float f = ex2(-(float)i * (13.287712379549449f / 16.f));
        const float ang = (float)pos * f;
        float rev = ang * 0.15915494309189535f;
        rev = rev - rintf(rev);
        p.rope[idx * 2 + 0] = __builtin_amdgcn_cosf(rev);
        p.rope[idx * 2 + 1] = __builtin_amdgcn_sinf(rev);
    }
}

__device__ void phase_p0(const Params& p, unsigned char* lds) {
    const int total = 192 + NCONV_ITEMS + 1;
    for (int item = blockIdx.x; item < total; item += gridDim.x) {
        if (item < 192) adaln_item(p, item, lds);
        else if (item < 192 + NCONV_ITEMS) convert_item(p, 0, item - 192, lds);
        else rope_table(p);
    }
}

__device__ void norm_rows(const Params& p, int lnext, const float* xsrc, const float* ysrc) {
    const int t = tid_opaque(), lane = t & 63, w = t >> 6;
    const int nrows = lnext < 4 ? NROWS : NTOK;
    for (int row = blockIdx.x * 4 + w; row < nrows; row += gridDim.x * 4) {
        const float* src = row < NTOK ? xsrc + (size_t)row * DM : ysrc + (size_t)(row - NTOK) * DM;
        f32x4 v[4];
        float ss = 0.f;
#pragma unroll
        for (int i = 0; i < 4; ++i) { v[i] = *(const f32x4*)(src + i * 256 + lane * 4); ss += v[i][0] * v[i][0] + v[i][1] * v[i][1] + v[i][2] * v[i][2] + v[i][3] * v[i][3]; }
#pragma unroll
        for (int o = 32; o >= 1; o >>= 1) ss += __shfl_xor(ss, o);
        const float rstd = rsqrtf(ss * (1.f / 1024.f) + EPSN);
        if (lnext < 4) {
            const int bb = row < NTOK ? (row >> 13) : 4;
            const float* md = p.mod + (size_t)(lnext * 5 + bb) * 3072;
            const float* nw = p.norm_w + lnext * 1024;
#pragma unroll
            for (int i = 0; i < 4; ++i) {
                const int col = i * 256 + lane * 4;
                const f32x4 nwv = *(const f32x4*)(nw + col), sh = *(const f32x4*)(md + col), scl = *(const f32x4*)(md + 1024 + col);
                f32x4 h = v[i] * rstd * nwv * (scl + 1.f) + sh;
                u32x2 o2; o2.x = pk2(h[0], h[1]); o2.y = pk2(h[2], h[3]);
                *(u32x2*)(p.HX + (size_t)row * DM + col) = o2;
            }
        } else {
#pragma unroll
            for (int i = 0; i < 4; ++i) {
                const int col = i * 256 + lane * 4;
                const f32x4 nwv = *(const f32x4*)(p.final_norm_w + col);
                f32x4 ov = v[i] * rstd * nwv;
#ifdef SANITIZE
                for (int e = 0; e < 4; ++e) if (!(fabsf(ov[e]) < 1e30f)) ov[e] = 1000.f;
#endif
                *(f32x4*)(p.out + (size_t)row * DM + col) = ov;
            }
        }
    }
}

__device__ void phase_a(const Params& p, int l, unsigned char* lds) {
    const int t = tid_opaque(), lane = t & 63, w = t >> 6, wm = w >> 1, wn = w & 1;
    const int total = 132 * 42;
    const bool xmap = (gridDim.x & 7) == 0;
    const int per = xmap ? (total + 7) / 8 : total;
    const int lo = xmap ? (int)(blockIdx.x & 7) * per : 0, hi = min(lo + per, total);
    const int step = xmap ? (int)(gridDim.x >> 3) : (int)gridDim.x;
    for (int idx = lo + (xmap ? (int)(blockIdx.x >> 3) : (int)blockIdx.x); idx < hi; idx += step) {
        const int nb = idx / 924, rem = idx - nb * 924;
        const int mt = rem / 7, nt = nb * 7 + (rem - mt * 7);
        f32x4 acc[4][8];
#pragma unroll
        for (int a = 0; a < 4; ++a)
#pragma unroll
            for (int b = 0; b < 8; ++b) acc[a][b] = (f32x4){0.f, 0.f, 0.f, 0.f};
        gemm_big(acc, p.HX + (size_t)mt * 256 * DM, DM, p.Wt + WT_IN + (size_t)nt * 128 * DM, DM, DM, lds);
#pragma unroll
        for (int ni = 0; ni < 4; ++ni)
#pragma unroll
            for (int mi = 0; mi < 8; ++mi) {
                const int n = nt * 128 + wn * 64 + ni * 16 + (lane >> 4) * 4, m = mt * 256 + wm * 128 + mi * 16 + (lane & 15);
                u32x2 o2; o2.x = pk2(acc[ni][mi][0], acc[ni][mi][1]); o2.y = pk2(acc[ni][mi][2], acc[ni][mi][3]);
                *(u32x2*)(p.P + (size_t)m * PC + n) = o2;
            }
    }
}

__device__ __forceinline__ int chunk_row(int b, int cidx) { return cidx < 64 ? b * 8192 + cidx * 128 : NTOK + b * 256 + (cidx - 64) * 128; }

__device__ void ret_state_item(const Params& p, int l, int b, int h, int cidx, unsigned char* lds) {
    const int t = tid_opaque(), lane = t & 63, w = t >> 6, g = lane >> 4, c = lane & 15;
    bf16_t* Ktf = (bf16_t*)lds;
    bf16_t* Vt = Ktf + 128 * 72;
    const float lgf = -__expf(p.ret_log_decay[l * 8 + h]) * LOG2E, lgb = -__expf(p.ret_log_decay[l * 8 + 4 + h]) * LOG2E;
    const float ksc = 0.08838834764831845f;
    const int rowbase = chunk_row(b, cidx);
    for (int dir = 0; dir < 2; ++dir) {
        f32x4 acc[2][8];
#pragma unroll
        for (int i = 0; i < 2; ++i)
#pragma unroll
            for (int d = 0; d < 8; ++d) acc[i][d] = (f32x4){0.f, 0.f, 0.f, 0.f};
        const float lg = dir ? lgb : lgf;
#pragma unroll 1
        for (int half = 0; half < 2; ++half) {
            __syncthreads();
#pragma unroll
            for (int i = 0; i < 4; ++i) {
                const int cc = t + 256 * i, tok = cc & 63, dch = cc >> 6, j = half * 64 + tok;
                const float wgt = ex2(lg * (float)(dir ? j : 127 - j)) * ksc;
                const bf16_t* rp = p.P + (size_t)(rowbase + j) * PC + h * 128 + dch * 8;
                const u32x4 kv = ldg16(rp + C_RK), vv = ldg16(rp + C_RV);
#pragma unroll
                for (int e = 0; e < 4; ++e) {
                    const int r0 = (dch * 8 + 2 * e) * 72 + tok, r1 = r0 + 72;
                    Ktf[r0] = f2bf(lo16(kv[e]) * wgt); Ktf[r1] = f2bf(hi16(kv[e]) * wgt);
                    Vt[r0] = (bf16_t)(vv[e] & 0xffffu); Vt[r1] = (bf16_t)(vv[e] >> 16);
                }
            }
            __syncthreads();
#pragma unroll
            for (int ks = 0; ks < 2; ++ks) {
                bf16x8 kf[2];
#pragma unroll
                for (int i = 0; i < 2; ++i) kf[i] = *(const bf16x8*)(Ktf + (w * 32 + i * 16 + c) * 72 + ks * 32 + g * 8);
#pragma unroll
                for (int d = 0; d < 8; ++d) {
                    const bf16x8 vf = *(const bf16x8*)(Vt + (d * 16 + c) * 72 + ks * 32 + g * 8);
#pragma unroll
                    for (int i = 0; i < 2; ++i) acc[i][d] = mfma16(kf[i], vf, acc[i][d]);
                }
            }
        }
        bf16_t* Sd = p.SU + ((size_t)((dir * 4 + b) * 4 + h) * 66 + cidx) * 16384;
#pragma unroll
        for (int i = 0; i < 2; ++i)
#pragma unroll
            for (int d = 0; d < 8; ++d) {
                const int dk = w * 32 + i * 16 + g * 4, dv = d * 16 + c;
                u32x2 o2; o2.x = pk2(acc[i][d][0], acc[i][d][1]); o2.y = pk2(acc[i][d][2], acc[i][d][3]);
                *(u32x2*)(Sd + dv * 128 + dk) = o2;
            }
    }
}

__device__ void qk_prep_item(const Params& p, int l, int item) {
    const int t = tid_opaque(), tok = t >> 2, sub = t & 3;
    const int row = item * 64 + tok;
    const bool lat = row < NTOK;
    const int tseq = row & 8191, pr = tseq >> 6, pc = tseq & 63;
    for (int hv = sub; hv < 10; hv += 4) {
        bf16_t* ptr = p.P + (size_t)row * PC + (hv < 8 ? C_GQ + hv * 64 : C_GK + (hv - 8) * 64);
        const float* nw = hv < 8 ? p.q_norm_w + l * 64 : p.k_norm_w + l * 64;
        float x[64];
        float ss = 0.f;
#pragma unroll
        for (int i = 0; i < 8; ++i) {
            const u32x4 u = ldg16(ptr + i * 8);
#pragma unroll
            for (int e = 0; e < 4; ++e) { x[i * 8 + 2 * e] = lo16(u[e]); x[i * 8 + 2 * e + 1] = hi16(u[e]); }
        }
#pragma unroll
        for (int d = 0; d < 64; ++d) ss += x[d] * x[d];
        const float rstd = rsqrtf(ss * (1.f / 64.f) + EPSN);
#pragma unroll
        for (int d = 0; d < 64; ++d) x[d] = x[d] * rstd * nw[d];
        if (lat) {
#pragma unroll
            for (int i = 0; i < 16; ++i) {
                const float cr = p.rope[(pr * 16 + i) * 2], sr = p.rope[(pr * 16 + i) * 2 + 1];
                const float cc = p.rope[(pc * 16 + i) * 2], sc = p.rope[(pc * 16 + i) * 2 + 1];
                const float a = x[i], b2 = x[16 + i], a2 = x[32 + i], b3 = x[48 + i];
                x[i] = a * cr - b2 * sr; x[16 + i] = b2 * cr + a * sr;
                x[32 + i] = a2 * cc - b3 * sc; x[48 + i] = b3 * cc + a2 * sc;
            }
        }
#pragma unroll
        for (int i = 0; i < 8; ++i) {
            u32x4 u;
#pragma unroll
            for (int e = 0; e < 4; ++e) u[e] = pk2(x[i * 8 + 2 * e], x[i * 8 + 2 * e + 1]);
            *(u32x4*)(ptr + i * 8) = u;
        }
    }
    {
        const int b = lat ? (row >> 13) : ((row - NTOK) >> 8);
        const int key = lat ? tseq : 8192 + ((row - NTOK) & 255);
        const bf16_t* vp = p.P + (size_t)row * PC + C_GV + sub * 32;
        bf16_t* dst = VG(p) + ((size_t)(b * 2 + (sub >> 1)) * 64 + (sub & 1) * 32) * 8448 + key;
#pragma unroll
        for (int i = 0; i < 4; ++i) {
            const u32x4 u = ldg16(vp + i * 8);
#pragma unroll
            for (int e = 0; e < 4; ++e) {
                dst[(size_t)(i * 8 + 2 * e) * 8448] = (bf16_t)(u[e] & 0xffffu);
                dst[(size_t)(i * 8 + 2 * e + 1) * 8448] = (bf16_t)(u[e] >> 16);
            }
        }
    }
}

__device__ void phase_b(const Params& p, int l, unsigned char* lds) {
    const int total = 1056 + 528;
    for (int item = blockIdx.x; item < total; item += gridDim.x) {
        if (item < 1056) { const int cidx = item % 66, bh = item / 66; ret_state_item(p, l, bh >> 2, bh & 3, cidx, lds);
#if PROBE == 7 || PROBE == 10
            ret_state_item(p, l, bh >> 2, bh & 3, cidx, lds);
#endif
        }
        else qk_prep_item(p, l, item - 1056);
    }
}

__device__ void phase_c(const Params& p, int l, bool dostore = true) {
    const int t = tid_opaque();
    for (int item = blockIdx.x; item < 256; item += gridDim.x) {
        const int part = item & 7, dbh = item >> 3, dir = dbh >> 4, h = dbh & 3;
        const float lg = -__expf(p.ret_log_decay[l * 8 + dir * 4 + h]) * LOG2E;
        const float gc = ex2(lg * 128.f);
        bf16_t* base = p.SU + (size_t)dbh * 66 * 16384 + part * 2048 + t * 8;
        float s[8];
#pragma unroll
        for (int e = 0; e < 8; ++e) s[e] = 0.f;
        for (int st0 = 0; st0 < 66; st0 += 11) {
            u32x4 u[11];
#pragma unroll
            for (int q = 0; q < 11; ++q) {
                const int st = st0 + q;
                const int n = dir == 0 ? (st < 2 ? 64 + st : st - 2) : (st < 2 ? 65 - st : 65 - st);
                u[q] = *(const u32x4*)(base + (size_t)n * 16384);
            }
#pragma unroll
            for (int q = 0; q < 11; ++q) {
                const int st = st0 + q;
                const int n = dir == 0 ? (st < 2 ? 64 + st : st - 2) : (st < 2 ? 65 - st : 65 - st);
                u32x4 o;
#pragma unroll
                for (int e = 0; e < 4; ++e) o[e] = pk2(s[2 * e], s[2 * e + 1]);
                if (dostore) *(u32x4*)(base + (size_t)n * 16384) = o;
#pragma unroll
                for (int e = 0; e < 4; ++e) { s[2 * e] = gc * s[2 * e] + lo16(u[q][e]); s[2 * e + 1] = gc * s[2 * e + 1] + hi16(u[q][e]); }
            }
        }
    }
}

template <int MODE>
__device__ void attn_item(const Params& p, int l, int b, int i1, int i2, int i3, unsigned char* lds, bool dostore = true) {
    constexpr int NQB = (MODE == 2) ? 2 : 4, NHQ = NQB / 2;
    const int t = tid_opaque(), lane = t & 63, w = t >> 6, g = lane >> 4, c = lane & 15;
    bf16_t* Ks = (bf16_t*)lds;
    bf16_t* Vt = Ks + 2 * 64 * 72;
    u32x4* Qs = (u32x4*)(lds + 36864) + w * 512;
    float* rpbs = (float*)(lds + 36864 + 32768);
    int qbase, qstep, qcol, kcol, vcol, gcol, ntiles;
    int R0 = 0, c0 = 0, start = 0, bstart = 0, hh = 0;
    if (MODE == 0 || MODE == 1) {
        const int kvh = i1, qt = i2, head = kvh * 4 + w;
        qbase = (MODE == 0 ? b * 8192 : NTOK + b * 256) + qt * 64; qstep = 16;
        qcol = C_GQ + head * 64; kcol = C_GK + kvh * 64; vcol = C_GV + kvh * 64; gcol = C_GG + head * 64;
        ntiles = MODE == 0 ? 132 : 4;
    } else if (MODE == 2) {
        hh = i1; R0 = i2 * 8; c0 = i3 * 16;
        start = min(max(R0 - 4, 0), 112); bstart = min(max(c0 - 8, 0), 32);
        qbase = b * 8192 + (R0 + w * 2) * 64 + c0; qstep = 64;
        qcol = C_NQ + hh * 64; kcol = C_NK + hh * 64; vcol = C_NV + hh * 64; gcol = C_NG + hh * 64;
        ntiles = 12;
    } else {
        hh = i1;
        qbase = NTOK + b * 256 + w * 64; qstep = 16;
        qcol = C_NQ + hh * 64; kcol = C_NK + hh * 64; vcol = C_NV + hh * 64; gcol = C_NG + hh * 64;
        ntiles = 4;
    }
    const float scale = 0.125f * LOG2E;
    f32x4 o[NQB][4];
    float mrun[NQB], lsum[NQB];
#pragma unroll
    for (int qb = 0; qb < NQB; ++qb) {
        mrun[qb] = -INFINITY; lsum[qb] = 0.f;
#pragma unroll
        for (int d = 0; d < 4; ++d) o[qb][d] = (f32x4){0.f, 0.f, 0.f, 0.f};
    }
    const int kkey = t >> 3, kch = (t & 7) * 8;
    const int vkey = t & 63, vch = (t >> 6);
    u32x4 kr[2], vr[2];
    auto load_tile = [&](int tt) {
        int base, rstep;
        if (MODE == 0) { base = tt < 128 ? b * 8192 + tt * 64 : NTOK + b * 256 + (tt - 128) * 64; rstep = 32; }
        else if (MODE == 2) {
            if (tt < 4) { base = NTOK + b * 256 + tt * 64; rstep = 32; }
            else { base = b * 8192 + (start + 2 * (tt - 4)) * 64 + bstart; rstep = 64; }
        } else { base = NTOK + b * 256 + tt * 64; rstep = 32; }
#pragma unroll
        for (int i = 0; i < 2; ++i) {
            const int key = kkey + 32 * i;
            kr[i] = ldg16(p.P + (size_t)(base + (key >> 5) * rstep + (key & 31)) * PC + kcol + kch);
            if (MODE <= 1) vr[i] = ldg16(VG(p) + ((size_t)(b * 2 + i1) * 64 + kkey + 32 * i) * 8448 + (MODE == 0 ? tt * 64 : 8192 + tt * 64) + kch);
            else vr[i] = ldg16(p.P + (size_t)(base + (vkey >> 5) * rstep + (vkey & 31)) * PC + vcol + (vch + 4 * i) * 8);
        }
    };
    auto store_tile = [&](int buf) {
        bf16_t* ks_ = Ks + buf * 64 * 72; bf16_t* vt_ = Vt + buf * 64 * 72;
#pragma unroll
        for (int i = 0; i < 2; ++i) {
            *(u32x4*)(ks_ + (kkey + 32 * i) * 72 + kch) = kr[i];
            if (MODE <= 1) { *(u32x4*)(vt_ + (kkey + 32 * i) * 72 + kch) = vr[i]; continue; }
#pragma unroll
            for (int e = 0; e < 4; ++e) {
                const int d = (vch + 4 * i) * 8 + 2 * e;
                vt_[d * 72 + vkey] = (bf16_t)(vr[i][e] & 0xffffu);
                vt_[(d + 1) * 72 + vkey] = (bf16_t)(vr[i][e] >> 16);
            }
        }
    };
    load_tile(0);
    __syncthreads();
#pragma unroll
    for (int qb = 0; qb < NQB; ++qb)
#pragma unroll
        for (int ks = 0; ks < 2; ++ks) Qs[(qb * 2 + ks) * 64 + lane] = ldg16(p.P + (size_t)(qbase + qb * qstep + c) * PC + qcol + ks * 32 + g * 8);
    if (MODE == 2) for (int idx = t; idx < 465; idx += 256) rpbs[idx] = p.na_rpb[((size_t)l * 8 + hh) * 465 + idx] * LOG2E;
    store_tile(0);
    __syncthreads();
    const int wlo = min(max(R0 + w * 2 - 4, 0), 120), whi = min(max(R0 + w * 2 + 1 - 4, 0), 120) + 7;
    int colterm[8];
    if (MODE == 2) {
        const int qc = c0 + c, cs = min(max(qc - 8, 0), 48);
#pragma unroll
        for (int j = 0; j < 8; ++j) {
            const int kc = bstart + (j >> 2) * 16 + g * 4 + (j & 3);
            colterm[j] = ((unsigned)(kc - cs) < 16u) ? (kc - qc + 15) : -1;
        }
    }
    for (int tt = 0; tt < ntiles; ++tt) {
        const int cur = tt & 1;
        if (tt + 1 < ntiles) load_tile(tt + 1);
        bool skip = false;
        int krow0 = 0;
        if (MODE == 2 && tt >= 4) { krow0 = start + 2 * (tt - 4); skip = (krow0 + 1 < wlo) || (krow0 > whi); }
        if (!skip) {
            const bf16_t* ks_ = Ks + cur * 64 * 72; const bf16_t* vt_ = Vt + cur * 64 * 72;
            f32x4 s[NQB][4];
#pragma unroll
            for (int qq = 0; qq < NQB; ++qq)
#pragma unroll
                for (int kb = 0; kb < 4; ++kb) s[qq][kb] = (f32x4){0.f, 0.f, 0.f, 0.f};
#pragma unroll
            for (int ks = 0; ks < 2; ++ks) {
                bf16x8 qv[NQB];
#pragma unroll
                for (int qq = 0; qq < NQB; ++qq) qv[qq] = as_bf(Qs[(qq * 2 + ks) * 64 + lane]);
#pragma unroll
                for (int kb = 0; kb < 4; ++kb) {
                    const bf16x8 kf = *(const bf16x8*)(ks_ + (kb * 16 + c) * 72 + ks * 32 + g * 8);
#pragma unroll
                    for (int qq = 0; qq < NQB; ++qq) s[qq][kb] = mfma16(kf, qv[qq], s[qq][kb]);
                }
            }
            __builtin_amdgcn_sched_barrier(0);
            bf16x8 pf[NQB][2];
#pragma unroll
            for (int qq = 0; qq < NQB; ++qq) {
                const int qb = qq;
                if (MODE == 2 && tt >= 4) {
                    const int qrow = R0 + w * 2 + qb;
                    const int rs = min(max(qrow - 4, 0), 120);
#pragma unroll
                    for (int kb = 0; kb < 4; ++kb) {
                        const int krow = krow0 + (kb >> 1);
                        const bool rowok = (unsigned)(krow - rs) < 8u;
                        const int ridx = (krow - qrow + 7) * 31;
#pragma unroll
                        for (int r = 0; r < 4; ++r) {
                            const int ct = colterm[(kb & 1) * 4 + r];
                            const bool valid = rowok && ct >= 0;
                            const float bias = rpbs[valid ? ridx + ct : 0];
                            s[qq][kb][r] = valid ? s[qq][kb][r] * scale + bias : -INFINITY;
                        }
                    }
                }
                const bool raw = !(MODE == 2 && tt >= 4);
                float tmax = fmaxf(fmaxf(s[qq][0][0], s[qq][0][1]), fmaxf(s[qq][0][2], s[qq][0][3]));
#pragma unroll
                for (int kb = 1; kb < 4; ++kb) tmax = fmaxf(tmax, fmaxf(fmaxf(s[qq][kb][0], s[qq][kb][1]), fmaxf(s[qq][kb][2], s[qq][kb][3])));
                tmax = fmaxf(tmax, __shfl_xor(tmax, 16)); tmax = fmaxf(tmax, __shfl_xor(tmax, 32));
                const float mn = fmaxf(mrun[qb], raw ? tmax * scale : tmax);
                const float alpha = ex2(mrun[qb] - mn);
                mrun[qb] = mn;
                float psum = 0.f;
#pragma unroll
                for (int kb = 0; kb < 4; ++kb)
#pragma unroll
                    for (int r = 0; r < 4; ++r) { const float pv = raw ? ex2(__builtin_fmaf(s[qq][kb][r], scale, -mn)) : ex2(s[qq][kb][r] - mn); s[qq][kb][r] = pv; psum += pv; }
                lsum[qb] = lsum[qb] * alpha + psum;
                if (__builtin_amdgcn_ballot_w64(alpha != 1.f) != 0ull) {
#pragma unroll
                    for (int d = 0; d < 4; ++d) o[qb][d] = o[qb][d] * alpha;
                }
#pragma unroll
                for (int kk = 0; kk < 2; ++kk) {
                    u32x4 u;
                    u[0] = pk2(s[qq][2 * kk][0], s[qq][2 * kk][1]); u[1] = pk2(s[qq][2 * kk][2], s[qq][2 * kk][3]);
                    u[2] = pk2(s[qq][2 * kk + 1][0], s[qq][2 * kk + 1][1]); u[3] = pk2(s[qq][2 * kk + 1][2], s[qq][2 * kk + 1][3]);
                    pf[qq][kk] = as_bf(u);
                }
            }
            __builtin_amdgcn_sched_barrier(0);
#pragma unroll
            for (int kk = 0; kk < 2; ++kk)
#pragma unroll
                for (int d = 0; d < 4; ++d) {
                    const u32x2 vlo = *(const u32x2*)(vt_ + (d * 16 + c) * 72 + kk * 32 + g * 4);
                    const u32x2 vhi = *(const u32x2*)(vt_ + (d * 16 + c) * 72 + kk * 32 + 16 + g * 4);
                    u32x4 vv; vv[0] = vlo[0]; vv[1] = vlo[1]; vv[2] = vhi[0]; vv[3] = vhi[1];
                    const bf16x8 vf = as_bf(vv);
#pragma unroll
                    for (int qq = 0; qq < NQB; ++qq) o[qq][d] = mfma16(vf, pf[qq][kk], o[qq][d]);
                }
        }
        if (tt + 1 < ntiles) store_tile(cur ^ 1);
        __syncthreads();
    }
    if (dostore)
#pragma unroll
    for (int qb = 0; qb < NQB; ++qb) {
        float ls = lsum[qb];
        ls += __shfl_xor(ls, 16); ls += __shfl_xor(ls, 32);
        const float inv = __builtin_amdgcn_rcpf(ls);
        bf16_t* rowp = p.P + (size_t)(qbase + qb * qstep + c) * PC;
#pragma unroll
        for (int d = 0; d < 4; ++d) {
            const int dd = d * 16 + g * 4;
            const u32x2 gt = *(const u32x2*)(rowp + gcol + dd);
            const float v0 = o[qb][d][0] * inv * silu_f(lo16(gt[0])), v1 = o[qb][d][1] * inv * silu_f(hi16(gt[0]));
            const float v2 = o[qb][d][2] * inv * silu_f(lo16(gt[1])), v3 = o[qb][d][3] * inv * silu_f(hi16(gt[1]));
            u32x2 o2; o2.x = pk2(v0, v1); o2.y = pk2(v2, v3);
            *(u32x2*)(rowp + qcol + dd) = o2;
        }
    }
}

typedef float f32x16 __attribute__((ext_vector_type(16)));
__device__ __forceinline__ f32x16 mfma32(bf16x8 a, bf16x8 b, f32x16 c) { return __builtin_amdgcn_mfma_f32_32x32x16_bf16(a, b, c, 0, 0, 0); }

template <int MODE>
__device__ void attn_item32(const Params& p, int l, int b, int i1, int i2, unsigned char* lds, bool dostore = true) {
    const int t = tid_opaque(), lane = t & 63, w = t >> 6, h = lane >> 5, c = lane & 31;
    bf16_t* Ks = (bf16_t*)lds;
    bf16_t* Vt = Ks + 2 * 64 * 72;
    u32x4* Qs = (u32x4*)(lds + 36864) + w * 512;
    int qbase, qcol, kcol, vcol, gcol, ntiles;
    if (MODE == 0 || MODE == 1) {
        const int kvh = i1, qt = i2, head = kvh * 4 + w;
        qbase = (MODE == 0 ? b * 8192 : NTOK + b * 256) + qt * 64;
        qcol = C_GQ + head * 64; kcol = C_GK + kvh * 64; vcol = C_GV + kvh * 64; gcol = C_GG + head * 64;
        ntiles = MODE == 0 ? 132 : 4;
    } else {
        const int hh = i1;
        qbase = NTOK + b * 256 + w * 64;
        qcol = C_NQ + hh * 64; kcol = C_NK + hh * 64; vcol = C_NV + hh * 64; gcol = C_NG + hh * 64;
        ntiles = 4;
    }
    const float scale = 0.125f * LOG2E;
    f32x16 o[2][2];
    float mrun[2], lsum[2];
#pragma unroll
    for (int qb = 0; qb < 2; ++qb) {
        mrun[qb] = -INFINITY; lsum[qb] = 0.f;
#pragma unroll
        for (int d = 0; d < 2; ++d)
#pragma unroll
            for (int r = 0; r < 16; ++r) o[qb][d][r] = 0.f;
    }
    const int kkey = t >> 3, kch = (t & 7) * 8;
    const int vkey = t & 63, vch = (t >> 6);
    u32x4 kr[2], vr[2];
    auto load_tile = [&](int tt) {
        const int base = MODE == 0 ? (tt < 128 ? b * 8192 + tt * 64 : NTOK + b * 256 + (tt - 128) * 64) : NTOK + b * 256 + tt * 64;
#pragma unroll
        for (int i = 0; i < 2; ++i) {
            kr[i] = ldg16(p.P + (size_t)(base + kkey + 32 * i) * PC + kcol + kch);
            if (MODE <= 1) vr[i] = ldg16(VG(p) + ((size_t)(b * 2 + i1) * 64 + kkey + 32 * i) * 8448 + (MODE == 0 ? tt * 64 : 8192 + tt * 64) + kch);
            else vr[i] = ldg16(p.P + (size_t)(base + vkey) * PC + vcol + (vch + 4 * i) * 8);
        }
    };
    auto store_tile = [&](int buf) {
        bf16_t* ks_ = Ks + buf * 64 * 72; bf16_t* vt_ = Vt + buf * 64 * 72;
#pragma unroll
        for (int i = 0; i < 2; ++i) {
            *(u32x4*)(ks_ + (kkey + 32 * i) * 72 + kch) = kr[i];
            if (MODE <= 1) { *(u32x4*)(vt_ + (kkey + 32 * i) * 72 + kch) = vr[i]; continue; }
#pragma unroll
            for (int e = 0; e < 4; ++e) {
                const int d = (vch + 4 * i) * 8 + 2 * e;
                vt_[d * 72 + vkey] = (bf16_t)(vr[i][e] & 0xffffu);
                vt_[(d + 1) * 72 + vkey] = (bf16_t)(vr[i][e] >> 16);
            }
        }
    };
    load_tile(0);
    __syncthreads();
#pragma unroll
    for (int qb = 0; qb < 2; ++qb)
#pragma unroll
        for (int ks = 0; ks < 4; ++ks) Qs[(qb * 4 + ks) * 64 + lane] = ldg16(p.P + (size_t)(qbase + qb * 32 + c) * PC + qcol + ks * 16 + h * 8);
    store_tile(0);
    __syncthreads();
    for (int tt = 0; tt < ntiles; ++tt) {
        const int cur = tt & 1;
        if (tt + 1 < ntiles) load_tile(tt + 1);
        const bf16_t* ks_ = Ks + cur * 64 * 72; const bf16_t* vt_ = Vt + cur * 64 * 72;
        f32x16 s[2][2];
#pragma unroll
        for (int qb = 0; qb < 2; ++qb)
#pragma unroll
            for (int kb = 0; kb < 2; ++kb)
#pragma unroll
                for (int r = 0; r < 16; ++r) s[qb][kb][r] = 0.f;
#pragma unroll
        for (int ks = 0; ks < 4; ++ks) {
            const bf16x8 q0 = as_bf(Qs[ks * 64 + lane]), q1 = as_bf(Qs[(4 + ks) * 64 + lane]);
#pragma unroll
            for (int kb = 0; kb < 2; ++kb) {
                const bf16x8 kf = *(const bf16x8*)(ks_ + (kb * 32 + c) * 72 + ks * 16 + h * 8);
                s[0][kb] = mfma32(kf, q0, s[0][kb]);
                s[1][kb] = mfma32(kf, q1, s[1][kb]);
            }
        }
        bf16x8 pf[2][4];
#pragma unroll
        for (int qb = 0; qb < 2; ++qb) {
            float tmax = s[qb][0][0];
#pragma unroll
            for (int kb = 0; kb < 2; ++kb)
#pragma unroll
                for (int r = 0; r < 16; r += 4) tmax = fmaxf(tmax, fmaxf(fmaxf(s[qb][kb][r], s[qb][kb][r + 1]), fmaxf(s[qb][kb][r + 2], s[qb][kb][r + 3])));
            tmax = fmaxf(tmax, __shfl_xor(tmax, 32));
            const float mn = fmaxf(mrun[qb], tmax * scale);
            const float alpha = ex2(mrun[qb] - mn);
            mrun[qb] = mn;
            float psum = 0.f;
#pragma unroll
            for (int kb = 0; kb < 2; ++kb)
#pragma unroll
                for (int r = 0; r < 16; ++r) { const float pv = ex2(__builtin_fmaf(s[qb][kb][r], scale, -mn)); s[qb][kb][r] = pv; psum += pv; }
            lsum[qb] = lsum[qb] * alpha + psum;
            if (__builtin_amdgcn_ballot_w64(alpha != 1.f) != 0ull) {
#pragma unroll
                for (int d = 0; d < 2; ++d)
#pragma unroll
                    for (int r = 0; r < 16; ++r) o[qb][d][r] *= alpha;
            }
#pragma unroll
            for (int kb = 0; kb < 2; ++kb)
#pragma unroll
                for (int st = 0; st < 2; ++st) {
                    u32x4 u;
#pragma unroll
                    for (int e = 0; e < 4; ++e) u[e] = pk2(s[qb][kb][8 * st + 2 * e], s[qb][kb][8 * st + 2 * e + 1]);
                    pf[qb][kb * 2 + st] = as_bf(u);
                }
        }
#pragma unroll
        for (int kk = 0; kk < 4; ++kk)
#pragma unroll
            for (int d = 0; d < 2; ++d) {
                const u32x2 vlo = *(const u32x2*)(vt_ + (d * 32 + c) * 72 + kk * 16 + h * 4);
                const u32x2 vhi = *(const u32x2*)(vt_ + (d * 32 + c) * 72 + kk * 16 + 8 + h * 4);
                u32x4 vv; vv[0] = vlo[0]; vv[1] = vlo[1]; vv[2] = vhi[0]; vv[3] = vhi[1];
                const bf16x8 vf = as_bf(vv);
                o[0][d] = mfma32(vf, pf[0][kk], o[0][d]);
                o[1][d] = mfma32(vf, pf[1][kk], o[1][d]);
            }
        if (tt + 1 < ntiles) store_tile(cur ^ 1);
        __syncthreads();
    }
    if (dostore)
#pragma unroll
    for (int qb = 0; qb < 2; ++qb) {
        float ls = lsum[qb];
        ls += __shfl_xor(ls, 32);
        const float inv = __builtin_amdgcn_rcpf(ls);
        bf16_t* rowp = p.P + (size_t)(qbase + qb * 32 + c) * PC;
#pragma unroll
        for (int d = 0; d < 2; ++d)
#pragma unroll
            for (int rg = 0; rg < 4; ++rg) {
                const int dd = d * 32 + rg * 8 + h * 4;
                const u32x2 gt = *(const u32x2*)(rowp + gcol + dd);
                const float v0 = o[qb][d][rg * 4 + 0] * inv * silu_f(lo16(gt[0])), v1 = o[qb][d][rg * 4 + 1] * inv * silu_f(hi16(gt[0]));
                const float v2 = o[qb][d][rg * 4 + 2] * inv * silu_f(lo16(gt[1])), v3 = o[qb][d][rg * 4 + 3] * inv * silu_f(hi16(gt[1]));
                u32x2 o2; o2.x = pk2(v0, v1); o2.y = pk2(v2, v3);
                *(u32x2*)(rowp + qcol + dd) = o2;
            }
    }
}

__device__ __forceinline__ bf16x8 scale_frag(bf16x8 f, float sc) {
    u32x4 u = as_u(f), r;
#pragma unroll
    for (int e = 0; e < 4; ++e) r[e] = pk2(lo16(u[e]) * sc, hi16(u[e]) * sc);
    return as_bf(r);
}

__device__ void ret_item(const Params& p, int l, int b, int h, int cidx, int hf, unsigned char* lds, bool dostore = true) {
    const int t = tid_opaque(), lane = t & 63, w = t >> 6, g = lane >> 4, c = lane & 15;
    bf16_t* B0 = (bf16_t*)lds;
    bf16_t* B1 = B0 + 128 * 136;
    const float lgf = -__expf(p.ret_log_decay[l * 8 + h]) * LOG2E, lgb = -__expf(p.ret_log_decay[l * 8 + 4 + h]) * LOG2E;
    const float ksc = 0.08838834764831845f;
    const int rowbase = chunk_row(b, cidx);
    const int ti = hf * 64 + w * 16 + c;
    bf16x8 qf[4];
#pragma unroll
    for (int ks = 0; ks < 4; ++ks) qf[ks] = as_bf(ldg16(p.P + (size_t)(rowbase + ti) * PC + C_RQ + h * 128 + ks * 32 + g * 8));
    __syncthreads();
#pragma unroll
    for (int i = 0; i < 8; ++i) {
        const int cc = t + 256 * i;
        { const int r = cc >> 4, ch = cc & 15; *(u32x4*)(B0 + r * 136 + ch * 8) = ldg16(p.P + (size_t)(rowbase + r) * PC + C_RK + h * 128 + ch * 8); }
        { const int tok = cc & 127, ch = cc >> 7;
          const u32x4 vv = ldg16(p.P + (size_t)(rowbase + tok) * PC + C_RV + h * 128 + ch * 8);
#pragma unroll
          for (int e = 0; e < 4; ++e) { B1[(ch * 8 + 2 * e) * 136 + tok] = (bf16_t)(vv[e] & 0xffffu); B1[(ch * 8 + 2 * e + 1) * 136 + tok] = (bf16_t)(vv[e] >> 16); } }
    }
    __syncthreads();
    bf16x8 pf[4];
    {
        f32x4 s[8];
#pragma unroll
        for (int kb = 0; kb < 8; ++kb) s[kb] = (f32x4){0.f, 0.f, 0.f, 0.f};
#pragma unroll
        for (int ks = 0; ks < 4; ++ks)
#pragma unroll
            for (int kb = 0; kb < 8; ++kb) {
                const bf16x8 kf = *(const bf16x8*)(B0 + (kb * 16 + c) * 136 + ks * 32 + g * 8);
                s[kb] = mfma16(kf, qf[ks], s[kb]);
            }
#pragma unroll
        for (int kb = 0; kb < 8; ++kb)
#pragma unroll
            for (int r = 0; r < 4; ++r) {
                const int j = kb * 16 + g * 4 + r, d = ti - j;
                const float wgt = d > 0 ? ex2(lgf * (float)d) : (d < 0 ? ex2(lgb * (float)(-d)) : 2.f);
                s[kb][r] *= wgt * ksc;
            }
#pragma unroll
        for (int kk = 0; kk < 4; ++kk) {
            u32x4 u;
            u[0] = pk2(s[2 * kk][0], s[2 * kk][1]); u[1] = pk2(s[2 * kk][2], s[2 * kk][3]);
            u[2] = pk2(s[2 * kk + 1][0], s[2 * kk + 1][1]); u[3] = pk2(s[2 * kk + 1][2], s[2 * kk + 1][3]);
            pf[kk] = as_bf(u);
        }
    }
    f32x4 o[8];
#pragma unroll
    for (int d = 0; d < 8; ++d) o[d] = (f32x4){0.f, 0.f, 0.f, 0.f};
#pragma unroll
    for (int kk = 0; kk < 4; ++kk)
#pragma unroll
        for (int d = 0; d < 8; ++d) {
            const u32x2 vlo = *(const u32x2*)(B1 + (d * 16 + c) * 136 + kk * 32 + g * 4);
            const u32x2 vhi = *(const u32x2*)(B1 + (d * 16 + c) * 136 + kk * 32 + 16 + g * 4);
            u32x4 vv; vv[0] = vlo[0]; vv[1] = vlo[1]; vv[2] = vhi[0]; vv[3] = vhi[1];
            o[d] = mfma16(as_bf(vv), pf[kk], o[d]);
        }
    __syncthreads();
    {
        const bf16_t* Sf = p.SU + ((size_t)((0 * 4 + b) * 4 + h) * 66 + cidx) * 16384;
        const bf16_t* Sb = p.SU + ((size_t)((1 * 4 + b) * 4 + h) * 66 + cidx) * 16384;
#pragma unroll
        for (int i = 0; i < 8; ++i) {
            const int cc = t + 256 * i, r = cc >> 4, ch = cc & 15;
            *(u32x4*)(B0 + r * 136 + ch * 8) = ldg16(Sf + r * 128 + ch * 8);
            *(u32x4*)(B1 + r * 136 + ch * 8) = ldg16(Sb + r * 128 + ch * 8);
        }
    }
    __syncthreads();
#pragma unroll
    for (int dir = 0; dir < 2; ++dir) {
        const bf16_t* Bd = dir ? B1 : B0;
        const float xi = dir == 0 ? ex2(lgf * (float)(ti + 1)) : ex2(lgb * (float)(128 - ti));
        bf16x8 qs[4];
#pragma unroll
        for (int ks = 0; ks < 4; ++ks) qs[ks] = scale_frag(qf[ks], xi);
#pragma unroll
        for (int ks = 0; ks < 4; ++ks)
#pragma unroll
            for (int d = 0; d < 8; ++d) {
                const bf16x8 sf = *(const bf16x8*)(Bd + (d * 16 + c) * 136 + ks * 32 + g * 8);
                o[d] = mfma16(sf, qs[ks], o[d]);
            }
    }
    if (dostore) {
        float sum = 0.f;
#pragma unroll
        for (int d = 0; d < 8; ++d) sum += (o[d][0] + o[d][1]) + (o[d][2] + o[d][3]);
        sum += __shfl_xor(sum, 16); sum += __shfl_xor(sum, 32);
        const float mu = sum * (1.f / 128.f);
        float var = 0.f;
#pragma unroll
        for (int d = 0; d < 8; ++d)
#pragma unroll
            for (int r = 0; r < 4; ++r) { const float dd = o[d][r] - mu; var += dd * dd; }
        var += __shfl_xor(var, 16); var += __shfl_xor(var, 32);
        const float rstd = rsqrtf(var * (1.f / 128.f) + EPSN);
        bf16_t* rowp = p.P + (size_t)(rowbase + ti) * PC;
#pragma unroll
        for (int d = 0; d < 8; ++d) {
            const int dv = d * 16 + g * 4;
            const f32x4 gn = *(const f32x4*)(p.ret_gn_w + l * 512 + h * 128 + dv);
            const u32x2 gt = *(const u32x2*)(rowp + C_RG + h * 128 + dv);
            const float v0 = (o[d][0] - mu) * rstd * gn[0] * silu_f(lo16(gt[0])), v1 = (o[d][1] - mu) * rstd * gn[1] * silu_f(hi16(gt[0]));
            const float v2 = (o[d][2] - mu) * rstd * gn[2] * silu_f(lo16(gt[1])), v3 = (o[d][3] - mu) * rstd * gn[3] * silu_f(hi16(gt[1]));
            u32x2 o2; o2.x = pk2(v0, v1); o2.y = pk2(v2, v3);
            *(u32x2*)(rowp + C_RQ + h * 128 + dv) = o2;
        }
    }
}

__device__ void phase_d(const Params& p, int l, unsigned char* lds) {
    const bool need_ctx = l < 3;
    const int G = gridDim.x, bid = blockIdx.x;
    const bool small_first = bid >= (G >> 1);
#pragma unroll 1
    for (int stage = 0; stage < 3; ++stage) {
        const int kind = small_first ? (stage + 1) % 3 : stage;
        if (kind == 0) {
#pragma unroll 1
            for (int it = bid; it < 1024; it += G) {
#if PROBE == 2
                attn_item32<0>(p, l, it >> 8, (it >> 7) & 1, it & 127, lds, p.out == nullptr);
#endif
                attn_item32<0>(p, l, it >> 8, (it >> 7) & 1, it & 127, lds);
            }
        } else if (kind == 1) {
#pragma unroll 1
            for (int it = bid; it < 2048; it += G) {
#if PROBE == 3
                attn_item<2>(p, l, it >> 9, (it >> 6) & 7, (it >> 2) & 15, it & 3, lds, p.out == nullptr);
#endif
                attn_item<2>(p, l, it >> 9, (it >> 6) & 7, (it >> 2) & 15, it & 3, lds);
            }
        } else {
            const int nch = need_ctx ? 66 : 64, n_ret = nch * 32;
#pragma unroll 1
            for (int it = G - 1 - bid; it < n_ret; it += G) {
                const int hf = it & 1, it2 = it >> 1;
                const int cidx = it2 % nch, bh = it2 / nch;
#if PROBE == 4
                ret_item(p, l, bh >> 2, bh & 3, cidx, hf, lds, p.out == nullptr);
#endif
                ret_item(p, l, bh >> 2, bh & 3, cidx, hf, lds);
            }
        }
        __syncthreads();
    }
    if (need_ctx) {
#pragma unroll 1
        for (int it = G - 1 - bid; it < 32; it += G) attn_item32<1>(p, l, it >> 3, (it >> 2) & 1, it & 3, lds);
        __syncthreads();
#pragma unroll 1
        for (int it = G - 1 - bid - 32; it < 32; it += G) { if (it >= 0) attn_item32<3>(p, l, it >> 3, it & 7, 0, lds); }
    }
}

__device__ void phase_e1(const Params& p, int l, unsigned char* lds) {
    const int t = tid_opaque(), lane = t & 63, w = t >> 6, wm = w >> 1, wn = w & 1;
    const int nmt = l < 3 ? 264 : 256;
    const int total = nmt * 8;
    for (int item = blockIdx.x; item < total; item += gridDim.x) {
        const int mt = item >> 3, nt = item & 7;
        u32x2 macc[4][4];
#pragma unroll
        for (int a = 0; a < 4; ++a)
#pragma unroll
            for (int b = 0; b < 4; ++b) macc[a][b] = (u32x2){0u, 0u};
#pragma unroll 1
        for (int br = 0; br < 3; ++br) {
            u32x2 sg[4][4];
            {
                f32x4 gacc[4][4];
#pragma unroll
                for (int a = 0; a < 4; ++a)
#pragma unroll
                    for (int b = 0; b < 4; ++b) gacc[a][b] = (f32x4){0.f, 0.f, 0.f, 0.f};
                gemm_core<4>(gacc, p.HX + (size_t)mt * 128 * DM, DM, p.Wt + WT_IN + (size_t)(PC + br * 1024 + nt * 128) * DM, DM, DM, lds);
#pragma unroll
                for (int a = 0; a < 4; ++a)
#pragma unroll
                    for (int b = 0; b < 4; ++b) { sg[a][b].x = pk2(sigm_f(gacc[a][b][0]), sigm_f(gacc[a][b][1])); sg[a][b].y = pk2(sigm_f(gacc[a][b][2]), sigm_f(gacc[a][b][3])); }
            }
            f32x4 pacc[4][4];
#pragma unroll
            for (int a = 0; a < 4; ++a)
#pragma unroll
                for (int b = 0; b < 4; ++b) pacc[a][b] = (f32x4){0.f, 0.f, 0.f, 0.f};
            const int xcol = br == 0 ? C_RQ : (br == 1 ? C_NQ : C_GQ);
            const int woff = br == 0 ? WT_RET : (br == 1 ? WT_NA : WT_GQA);
            gemm_core<4>(pacc, p.P + (size_t)mt * 128 * PC + xcol, PC, p.Wt + woff + (size_t)nt * 128 * 512, 512, 512, lds);
#pragma unroll
            for (int a = 0; a < 4; ++a)
#pragma unroll
                for (int b = 0; b < 4; ++b) {
                    const float m0 = lo16(macc[a][b].x) + lo16(sg[a][b].x) * pacc[a][b][0], m1 = hi16(macc[a][b].x) + hi16(sg[a][b].x) * pacc[a][b][1];
                    const float m2 = lo16(macc[a][b].y) + lo16(sg[a][b].y) * pacc[a][b][2], m3 = hi16(macc[a][b].y) + hi16(sg[a][b].y) * pacc[a][b][3];
                    macc[a][b].x = pk2(m0, m1); macc[a][b].y = pk2(m2, m3);
                }
        }
#pragma unroll
        for (int ni = 0; ni < 4; ++ni)
#pragma unroll
            for (int mi = 0; mi < 4; ++mi) {
                const int n = nt * 128 + wn * 64 + ni * 16 + (lane >> 4) * 4, m = mt * 128 + wm * 64 + mi * 16 + (lane & 15);
                *(u32x2*)(p.P + (size_t)m * PC + C_M + n) = macc[ni][mi];
            }
    }
}

__device__ void phase_e2(const Params& p, int l, unsigned char* lds, bool dostore = true) {
    const int t = tid_opaque(), lane = t & 63, w = t >> 6, wm = w >> 1, wn = w & 1;
    const int nmt = l < 3 ? 264 : 256;
    const int total = nmt * 8;
    const float* xsrc = l == 0 ? p.x : p.out;
    const float* ysrc = l == 0 ? p.ctx : p.y;
    for (int item = blockIdx.x; item < total; item += gridDim.x) {
        const int mt = item >> 3, nt = item & 7;
        f32x4 acc[4][4];
#pragma unroll
        for (int a = 0; a < 4; ++a)
#pragma unroll
            for (int b = 0; b < 4; ++b) acc[a][b] = (f32x4){0.f, 0.f, 0.f, 0.f};
        gemm_core<4>(acc, p.P + (size_t)mt * 128 * PC + C_M, PC, p.Wt + WT_OUT + (size_t)nt * 128 * DM, DM, DM, lds);
#pragma unroll
        for (int mi = 0; mi < 4; ++mi) {
            const int m = mt * 128 + wm * 64 + mi * 16 + (lane & 15);
            const bool lat = m < NTOK;
            const int bb = lat ? (m >> 13) : 4;
            const float* src = lat ? xsrc + (size_t)m * DM : ysrc + (size_t)(m - NTOK) * DM;
            float* dst = lat ? p.out + (size_t)m * DM : p.y + (size_t)(m - NTOK) * DM;
            const float* gate = p.mod + (size_t)(l * 5 + bb) * 3072 + 2048;
#pragma unroll
            for (int ni = 0; ni < 4; ++ni) {
                const int n = nt * 128 + wn * 64 + ni * 16 + (lane >> 4) * 4;
                const f32x4 xo = *(const f32x4*)(src + n), gv = *(const f32x4*)(gate + n);
                if (dostore) *(f32x4*)(dst + n) = xo + gv * acc[ni][mi];
            }
        }
    }
}

__device__ void phase_e3(const Params& p, int l, unsigned char* lds) {
    norm_rows(p, l + 1, p.out, p.y);
    if (l < 3)
        for (int item = blockIdx.x; item < NCONV_ITEMS; item += gridDim.x) convert_item(p, l + 1, item, lds);
}


#ifdef DIAG
__device__ void scan_bf16(const bf16_t* ptr, size_t n, unsigned* flag, unsigned bit) {
    const size_t nch = n / 8;
    bool bad = false;
    for (size_t i = (size_t)blockIdx.x * 256 + threadIdx.x; i < nch; i += (size_t)gridDim.x * 256) {
        const u32x4 u = *(const u32x4*)(ptr + i * 8);
#pragma unroll
        for (int e = 0; e < 4; ++e) { if ((u[e] & 0x7F80u) == 0x7F80u) bad = true; if ((u[e] & 0x7F800000u) == 0x7F800000u) bad = true; }
    }
    if (bad) atomicOr(flag, bit);
}
__device__ void scan_f32(const float* ptr, size_t n, unsigned* flag, unsigned bit) {
    bool bad = false;
    for (size_t i = (size_t)blockIdx.x * 256 + threadIdx.x; i < n; i += (size_t)gridDim.x * 256) {
        if ((__float_as_uint(ptr[i]) & 0x7F800000u) == 0x7F800000u) bad = true;
    }
    if (bad) atomicOr(flag, bit);
}
#endif
__device__ __forceinline__ void run_phase(const Params& p, int ph, int l, unsigned char* lds) {
    switch (ph) {
        case 0: phase_p0(p, lds);
#if PROBE == 7
            phase_p0(p, lds);
#endif
            break;
        case 1: norm_rows(p, 0, p.x, p.ctx); break;
        case 2: phase_a(p, l, lds);
#if PROBE == 1
            phase_a(p, l, lds);
#endif
            break;
        case 3: phase_b(p, l, lds); break;
        case 4:
#if PROBE == 7 || PROBE == 8
            phase_c(p, l, p.out == nullptr);
#endif
            phase_c(p, l); break;
        case 5: phase_d(p, l, lds); break;
        case 6: phase_e1(p, l, lds);
#if PROBE == 5
            phase_e1(p, l, lds);
#endif
            break;
        case 7:
#if PROBE == 7 || PROBE == 9
            phase_e2(p, l, lds, p.out == nullptr);
#endif
            phase_e2(p, l, lds); break;
        default: phase_e3(p, l, lds);
#if PROBE == 6
            phase_e3(p, l, lds);
#endif
            break;
    }
}

#if MULTI_LAUNCH
__global__ void __launch_bounds__(256, 2) phase_kernel(Params p, int ph, int l) {
    __shared__ __attribute__((aligned(16))) unsigned char lds[LDS_BYTES];
    run_phase(p, ph, l, lds);
}
#else
__device__ __forceinline__ void fast_grid_barrier(unsigned* bar, unsigned k) {
    asm volatile("s_waitcnt vmcnt(0) lgkmcnt(0)" ::: "memory");
    __syncthreads();
    if (threadIdx.x == 0) {
        const unsigned grp = blockIdx.x & 7u, members = (gridDim.x - grp + 7u) >> 3;
        __builtin_amdgcn_fence(__ATOMIC_RELEASE, "agent");
        const unsigned old = __hip_atomic_fetch_add(bar + grp * 32, 1u, __ATOMIC_RELAXED, __HIP_MEMORY_SCOPE_AGENT);
        if (old + 1u == k * members) {
            __hip_atomic_fetch_add(bar + 256, 1u, __ATOMIC_RELAXED, __HIP_MEMORY_SCOPE_AGENT);
            while (__hip_atomic_load(bar + 256, __ATOMIC_RELAXED, __HIP_MEMORY_SCOPE_AGENT) < k * 8u) __builtin_amdgcn_s_sleep(1);
            __hip_atomic_store(bar + 288 + grp * 32, k, __ATOMIC_RELAXED, __HIP_MEMORY_SCOPE_AGENT);
        } else {
            while (__hip_atomic_load(bar + 288 + grp * 32, __ATOMIC_RELAXED, __HIP_MEMORY_SCOPE_AGENT) < k) __builtin_amdgcn_s_sleep(1);
        }
        __builtin_amdgcn_fence(__ATOMIC_ACQUIRE, "agent");
    }
    __syncthreads();
}
#define GSYNC() do { asm volatile("s_waitcnt vmcnt(0) lgkmcnt(0)" ::: "memory"); grid.sync(); } while (0)
__global__ void __launch_bounds__(256, 2) mega_kernel(Params p) {
    __shared__ __attribute__((aligned(16))) unsigned char lds[LDS_BYTES];
    cg::grid_group grid = cg::this_grid();
#ifdef DIAG
    unsigned* flag = (unsigned*)(p.rope + 4096);
    if (blockIdx.x == 0 && threadIdx.x == 0) *flag = 0u;
    int l0 = 0; asm volatile("" : "+s"(l0));
#pragma unroll 1
    for (int ph = 0; ph <= DIAG_LAST; ++ph) {
        run_phase(p, ph, l0, lds); GSYNC();
        if (ph == 0) { scan_f32(p.mod, 4 * 5 * 3072, flag, 1u); scan_f32(p.rope, 4096, flag, 1u); scan_bf16(p.Wt, WT_TOTAL, flag, 1u); }
        else if (ph == 1) scan_bf16(p.HX, (size_t)NROWS * DM, flag, 1u);
        else if (ph == 4) scan_bf16(p.SU, (size_t)2 * 4 * 4 * 66 * 16384, flag, 8u);
        else {
            scan_bf16(p.P, (size_t)NROWS * PC, flag, ph == 2 ? 2u : ph == 3 ? 4u : ph == 5 ? 16u : 32u);
            if (ph == 3) scan_bf16(p.SU, (size_t)2 * 4 * 4 * 66 * 16384, flag, 4u);
        }
        GSYNC();
    }
    {
#if DIAG_LAST == 2
        unsigned* cnt = flag + 1;
        if (blockIdx.x == 0 && threadIdx.x == 0) { for (int i = 0; i < 8; ++i) cnt[i] = 0u; *flag = 0u; }
        GSYNC();
        {
            bool huge = false;
            const size_t nch = (size_t)NROWS * DM / 8;
            for (size_t i = (size_t)blockIdx.x * 256 + threadIdx.x; i < nch; i += (size_t)gridDim.x * 256) {
                const u32x4 u = *(const u32x4*)(p.HX + i * 8);
                for (int e = 0; e < 4; ++e) { if (fabsf(lo16(u[e])) > 1e4f || fabsf(hi16(u[e])) > 1e4f) huge = true; }
            }
            const size_t nch2 = (size_t)8448 * DM / 8;
            for (size_t i = (size_t)blockIdx.x * 256 + threadIdx.x; i < nch2; i += (size_t)gridDim.x * 256) {
                const u32x4 u = *(const u32x4*)(p.Wt + i * 8);
                for (int e = 0; e < 4; ++e) { if (fabsf(lo16(u[e])) > 1e4f || fabsf(hi16(u[e])) > 1e4f) huge = true; }
            }
            if (huge) atomicAdd(cnt + 4, 1u);
        }
        if (blockIdx.x < 4) {
            const int mts[4] = {0, 0, 1, 3}, nts[4] = {0, 1, 0, 5};
            const int mt = mts[blockIdx.x], nt = nts[blockIdx.x];
            unsigned bad = 0;
            for (int j = 0; j < 64; ++j) {
                const int e = threadIdx.x + 256 * j, m = mt * 128 + (e >> 7), n = nt * 128 + (e & 127);
                float d = 0.f;
                for (int k = 0; k < 1024; ++k) d += bf2f(p.HX[(size_t)m * DM + k]) * bf2f(p.Wt[WT_IN + (size_t)n * DM + k]);
                const float pv = bf2f(p.P[(size_t)m * PC + n]);
                if (!(fabsf(d - pv) <= 0.05f + 0.05f * fabsf(d))) ++bad;
            }
            if (bad) atomicAdd(cnt + blockIdx.x, bad);
        }
        GSYNC();
        if (blockIdx.x == 0 && threadIdx.x == 0) {
            unsigned f = 0;
            if (cnt[0] > 0u) f |= 1u;
            if (cnt[0] > 8192u) f |= 2u;
            if (cnt[1] > 0u) f |= 4u;
            if (cnt[2] > 0u) f |= 8u;
            if (cnt[3] > 0u) f |= 16u;
            if (cnt[4] > 0u) f |= 32u;
            *flag = f;
        }
        GSYNC();
#endif
        const float code = (10.f + (float)(*flag)) * 100.f;
        for (size_t i = (size_t)blockIdx.x * 256 + threadIdx.x; i < (size_t)NTOK * DM; i += (size_t)gridDim.x * 256) p.out[i] = i == 0 ? code : 0.f;
    }
#else
#ifdef TIMING
#define tsum ((unsigned long long*)(p.rope + 4096 + 16))
    int tidx = 0;
#define TSTAMP(ph) do { if (blockIdx.x == 0) { int z_ = tid_opaque(); if (z_ == 0) tsum[tidx + z_] = __builtin_amdgcn_s_memrealtime(); } ++tidx; } while (0)
    TSTAMP(0);
#else
#define TSTAMP(ph) do { } while (0)
#endif
    unsigned bk = 0;
    run_phase(p, 0, 0, lds); GSYNC(); TSTAMP(0);
    run_phase(p, 1, 0, lds); fast_grid_barrier(p.bar, ++bk); TSTAMP(1);
    for (int l = 0; l < 4; ++l) {
#pragma unroll 1
        for (int ph = 2; ph <= 8; ++ph) {
            run_phase(p, ph, l, lds);
#ifdef TIMING
            GSYNC(); TSTAMP(ph);
#else
            if (!(l == 3 && ph == 8)) fast_grid_barrier(p.bar, ++bk);
#endif
        }
    }
#ifdef TIMING
    {
        float f0, f1, f2 = 0.f, f3 = 0.f, f4 = 0.f, f5 = 0.f, f6 = 0.f, f7 = 0.f, f8 = 0.f;
        f0 = (float)(tsum[1] - tsum[0]); f1 = (float)(tsum[2] - tsum[1]);
        for (int l = 0; l < 4; ++l) {
            const unsigned long long* tb = tsum + 2 + l * 7;
            f2 += (float)(tb[1] - tb[0]); f3 += (float)(tb[2] - tb[1]); f4 += (float)(tb[3] - tb[2]); f5 += (float)(tb[4] - tb[3]);
            f6 += (float)(tb[5] - tb[4]); f7 += (float)(tb[6] - tb[5]); f8 += (float)(tb[7] - tb[6]);
        }
        const float tot = f0 + f1 + f2 + f3 + f4 + f5 + f6 + f7 + f8;
#if TIMING == 0
        const float a1 = f5, a2 = f2;
#elif TIMING == 1
        const float a1 = f6, a2 = f7;
#elif TIMING == 2
        const float a1 = f3 + f4, a2 = f8 + f0 + f1;
#else
        const float a1 = f8 + f0 + f1, a2 = f3;
#endif
        const float v1 = 200.f + 16.f * rintf(50.f * a1 / tot), v2 = 10.f + 1.8f * rintf(50.f * a2 / tot);
        for (size_t i = (size_t)blockIdx.x * 256 + threadIdx.x; i < (size_t)NTOK * DM; i += (size_t)gridDim.x * 256)
            p.out[i] = i == 0 ? v1 : (i <= 1048576 ? v2 : 0.f);
    }
#endif
#endif
}
#endif

extern "C" void kernel_launch(void* const* d_in, const int* in_sizes, int n_in, void* d_out, int out_size, void* d_ws, size_t ws_size, hipStream_t stream) {
    Params p{};
    p.x = (const float*)d_in[0]; p.c = (const float*)d_in[1]; p.ctx = (const float*)d_in[2]; p.c_ctx = (const float*)d_in[3];
    p.ada_w = (const float*)d_in[4]; p.ada_b = (const float*)d_in[5]; p.norm_w = (const float*)d_in[6]; p.w_in = (const float*)d_in[7];
    p.ret_log_decay = (const float*)d_in[8]; p.ret_gn_w = (const float*)d_in[9]; p.na_rpb = (const float*)d_in[10];
    p.q_norm_w = (const float*)d_in[11]; p.k_norm_w = (const float*)d_in[12]; p.w_ret_o = (const float*)d_in[13];
    p.w_na_o = (const float*)d_in[14]; p.w_gqa_o = (const float*)d_in[15]; p.w_out = (const float*)d_in[16]; p.final_norm_w = (const float*)d_in[17];
    p.out = (float*)d_out;
    unsigned char* ws = (unsigned char*)d_ws;
    size_t off = 0;
    p.P = (bf16_t*)(ws + off); off += (size_t)NROWS * PC * 2;
    p.HX = (bf16_t*)(ws + off); off += (size_t)NROWS * DM * 2;
    p.Wt = (bf16_t*)(ws + off); off += (size_t)WT_TOTAL * 2;
    p.SU = (bf16_t*)(ws + off); off += (size_t)2 * 4 * 4 * 66 * 16384 * 2;
    p.y = (float*)(ws + off); off += (size_t)1024 * 1024 * 4;
    p.mod = (float*)(ws + off); off += (size_t)4 * 5 * 3072 * 4;
    p.rope = (float*)(ws + off); off += (size_t)128 * 16 * 2 * 4 + 256;
    p.bar = (unsigned*)(ws + off); off += 4096;
    off += (size_t)4 * 2 * 64 * 8448 * 2;
    if (off > ws_size) { fprintf(stderr, "workspace too small: need %zu have %zu\n", off, ws_size); return; }
#if MULTI_LAUNCH
    const int grid = 512;
    phase_kernel<<<grid, 256, 0, stream>>>(p, 0, 0);
    phase_kernel<<<grid, 256, 0, stream>>>(p, 1, 0);
    for (int l = 0; l < 4; ++l)
        for (int ph = 2; ph <= 8; ++ph) phase_kernel<<<grid, 256, 0, stream>>>(p, ph, l);
#else
    static int grid_blocks = 0;
    if (!grid_blocks) {
        int dev = 0, cus = 0, per_cu = 0;
        hipGetDevice(&dev);
        hipDeviceGetAttribute(&cus, hipDeviceAttributeMultiprocessorCount, dev);
        hipOccupancyMaxActiveBlocksPerMultiprocessor(&per_cu, mega_kernel, 256, 0);
        if (per_cu > 2) per_cu = 2;
        grid_blocks = cus * per_cu;
    }
    hipMemsetAsync(p.bar, 0, 4096, stream);
    void* args[] = {&p};
    hipError_t e = hipLaunchCooperativeKernel((void*)mega_kernel, dim3(grid_blocks), dim3(256), args, 0, stream);
    if (e != hipSuccess) fprintf(stderr, "cooperative launch failed: %s (grid %d)\n", hipGetErrorString(e), grid_blocks);
#endif
}
```

```cpp
#include <hip/hip_runtime.h>
#include <hip/hip_cooperative_groups.h>
#include <cstdio>
#include <cstdint>
namespace cg = cooperative_groups;


typedef unsigned short bf16_t;
typedef short bf16x8 __attribute__((ext_vector_type(8)));
typedef float f32x4 __attribute__((ext_vector_type(4)));
typedef unsigned u32x4 __attribute__((ext_vector_type(4)));
typedef unsigned u32x2 __attribute__((ext_vector_type(2)));

#define DM 1024
#define NTOK 32768
#define NROWS 33792
#define PC 5376
#define INC 8448
#define LOG2E 1.4426950408889634f
#define EPSN 1e-6f
#define LDS_BYTES 73728

#define C_RQ 0
#define C_RK 512
#define C_RV 1024
#define C_RG 1536
#define C_NQ 2048
#define C_NK 2560
#define C_NV 3072
#define C_NG 3584
#define C_GQ 4096
#define C_GK 4608
#define C_GV 4736
#define C_GG 4864
#define C_M  512

#define WT_IN 0
#define WT_RET (8448 * 1024)
#define WT_NA (WT_RET + 1024 * 512)
#define WT_GQA (WT_NA + 1024 * 512)
#define WT_OUT (WT_GQA + 1024 * 512)
#define WT_TOTAL (WT_OUT + 1024 * 1024)

#define VG(p) ((bf16_t*)((unsigned char*)(p).bar + 4096))
struct Params {
    const float *x, *c, *ctx, *c_ctx, *ada_w, *ada_b, *norm_w, *w_in, *ret_log_decay, *ret_gn_w, *na_rpb, *q_norm_w, *k_norm_w,
        *w_ret_o, *w_na_o, *w_gqa_o, *w_out, *final_norm_w;
    float* out;
    bf16_t* P;
    bf16_t* HX;
    bf16_t* Wt;
    bf16_t* SU;
    float* y;
    float* mod;
    float* rope;
    unsigned* bar;
};

__device__ __forceinline__ int tid_opaque() { int t = threadIdx.x; asm volatile("" : "+v"(t)); return t; }
__device__ __forceinline__ float bf2f(bf16_t v) { return __uint_as_float(((unsigned)v) << 16); }
typedef __bf16 bf16x2_t __attribute__((ext_vector_type(2)));
typedef float f32x2_t __attribute__((ext_vector_type(2)));
__device__ __forceinline__ unsigned pk2(float lo, float hi) {
    f32x2_t v = {lo, hi};
    union { bf16x2_t b; unsigned u; } x; x.b = __builtin_convertvector(v, bf16x2_t); return x.u;
}
__device__ __forceinline__ bf16_t f2bf(float f) { return (bf16_t)(pk2(f, 0.f) & 0xffffu); }
__device__ __forceinline__ float lo16(unsigned u) { return __uint_as_float(u << 16); }
__device__ __forceinline__ float hi16(unsigned u) { return __uint_as_float(u & 0xffff0000u); }
__device__ __forceinline__ float ex2(float x) { return __builtin_amdgcn_exp2f(x); }
__device__ __forceinline__ float silu_f(float x) { return x * __builtin_amdgcn_rcpf(1.f + ex2(-x * LOG2E)); }
__device__ __forceinline__ float sigm_f(float x) { return __builtin_amdgcn_rcpf(1.f + ex2(-x * LOG2E)); }
__device__ __forceinline__ f32x4 mfma16(bf16x8 a, bf16x8 b, f32x4 c) { return __builtin_amdgcn_mfma_f32_16x16x32_bf16(a, b, c, 0, 0, 0); }
__device__ __forceinline__ bf16x8 as_bf(u32x4 u) { union { u32x4 a; bf16x8 b; } x; x.a = u; return x.b; }
__device__ __forceinline__ u32x4 as_u(bf16x8 u) { union { u32x4 a; bf16x8 b; } x; x.b = u; return x.a; }
__device__ __forceinline__ u32x4 ldg16(const bf16_t* p) { return *(const u32x4*)p; }

template <int NI>
__device__ __forceinline__ void gemm_core(f32x4 (&acc)[NI][4], const bf16_t* __restrict__ X, int ldx, const bf16_t* __restrict__ W, int ldw, int K, unsigned char* lds) {
    const int t = tid_opaque(), lane = t & 63, w = t >> 6, wm = w >> 1, wn = w & 1;
    bf16_t* Xs = (bf16_t*)lds;
    bf16_t* Ws = Xs + 2 * 128 * 72;
    const int sr = t >> 3, sc = (t & 7) * 8;
    const bf16_t* xg = X + (size_t)sr * ldx + sc;
    const bf16_t* wg = W + (size_t)sr * ldw + sc;
    u32x4 xr[4], wr[NI];
#pragma unroll
    for (int i = 0; i < 4; ++i) xr[i] = ldg16(xg + (size_t)i * 32 * ldx);
#pragma unroll
    for (int i = 0; i < NI; ++i) wr[i] = ldg16(wg + (size_t)i * 32 * ldw);
    __syncthreads();
#pragma unroll
    for (int i = 0; i < 4; ++i) *(u32x4*)(Xs + (sr + i * 32) * 72 + sc) = xr[i];
#pragma unroll
    for (int i = 0; i < NI; ++i) *(u32x4*)(Ws + (sr + i * 32) * 72 + sc) = wr[i];
    __syncthreads();
    const int nk = K >> 6;
    for (int kt = 0; kt < nk; ++kt) {
        const int cur = kt & 1;
        if (kt + 1 < nk) {
            const int ko = (kt + 1) * 64;
#pragma unroll
            for (int i = 0; i < 4; ++i) xr[i] = ldg16(xg + (size_t)i * 32 * ldx + ko);
#pragma unroll
            for (int i = 0; i < NI; ++i) wr[i] = ldg16(wg + (size_t)i * 32 * ldw + ko);
        }
        __builtin_amdgcn_sched_barrier(0);
        const bf16_t* xs = Xs + cur * 128 * 72 + (wm * 64 + (lane & 15)) * 72 + (lane >> 4) * 8;
        const bf16_t* ws = Ws + cur * 128 * 72 + (wn * (NI * 16) + (lane & 15)) * 72 + (lane >> 4) * 8;
#pragma unroll
        for (int ks = 0; ks < 2; ++ks) {
            bf16x8 xf[4], wf[NI];
#pragma unroll
            for (int i = 0; i < 4; ++i) xf[i] = *(const bf16x8*)(xs + i * 16 * 72 + ks * 32);
#pragma unroll
            for (int i = 0; i < NI; ++i) wf[i] = *(const bf16x8*)(ws + i * 16 * 72 + ks * 32);
#pragma unroll
            for (int ni = 0; ni < NI; ++ni)
#pragma unroll
                for (int mi = 0; mi < 4; ++mi) acc[ni][mi] = mfma16(wf[ni], xf[mi], acc[ni][mi]);
        }
        if (kt + 1 < nk) {
            const int nx = cur ^ 1;
#pragma unroll
            for (int i = 0; i < 4; ++i) *(u32x4*)(Xs + nx * 128 * 72 + (sr + i * 32) * 72 + sc) = xr[i];
#pragma unroll
            for (int i = 0; i < NI; ++i) *(u32x4*)(Ws + nx * 128 * 72 + (sr + i * 32) * 72 + sc) = wr[i];
        }
        __syncthreads();
    }
}

__device__ __forceinline__ void gemm_big(f32x4 (&acc)[4][8], const bf16_t* __restrict__ X, int ldx, const bf16_t* __restrict__ W, int ldw, int K, unsigned char* lds) {
    const int t = tid_opaque(), lane = t & 63, w = t >> 6, wm = w >> 1, wn = w & 1;
    bf16_t* Xs = (bf16_t*)lds;
    bf16_t* Ws = Xs + 2 * 256 * 40;
    const int sr = t >> 2, sc = (t & 3) * 8;
    const bf16_t* xg = X + (size_t)sr * ldx + sc;
    const bf16_t* wg = W + (size_t)sr * ldw + sc;
    u32x4 ra[6], rb[6];
#define GB_LOAD(r, ko) do { _Pragma("unroll") for (int i = 0; i < 4; ++i) r[i] = ldg16(xg + (size_t)i * 64 * ldx + (ko)); _Pragma("unroll") for (int i = 0; i < 2; ++i) r[4 + i] = ldg16(wg + (size_t)i * 64 * ldw + (ko)); } while (0)
#define GB_ST1(r, st, i) do { if ((i) < 4) *(u32x4*)(Xs + (st) * 256 * 40 + (sr + (i) * 64) * 40 + sc) = r[i]; else *(u32x4*)(Ws + (st) * 128 * 40 + (sr + ((i) - 4) * 64) * 40 + sc) = r[i]; } while (0)
#define GB_STEP(st, r, dostore) do { \
        const bf16_t* xs = Xs + (st) * 256 * 40 + (wm * 128 + (lane & 15)) * 40 + (lane >> 4) * 8; \
        const bf16_t* ws = Ws + (st) * 128 * 40 + (wn * 64 + (lane & 15)) * 40 + (lane >> 4) * 8; \
        bf16x8 wf[4]; \
        _Pragma("unroll") for (int i = 0; i < 4; ++i) wf[i] = *(const bf16x8*)(ws + i * 16 * 40); \
        _Pragma("unroll") for (int mi = 0; mi < 8; ++mi) { \
            const bf16x8 xf = *(const bf16x8*)(xs + mi * 16 * 40); \
            _Pragma("unroll") for (int ni = 0; ni < 4; ++ni) acc[ni][mi] = mfma16(wf[ni], xf, acc[ni][mi]); \
            if ((dostore) && mi >= 1 && mi <= 6) GB_ST1(r, (st) ^ 1, mi - 1); } } while (0)
    GB_LOAD(ra, 0);
    GB_LOAD(rb, 32);
    __syncthreads();
#pragma unroll
    for (int i = 0; i < 6; ++i) GB_ST1(ra, 0, i);
    __syncthreads();
    const int nk = K >> 5;
    for (int kt = 0; kt < nk; kt += 2) {
        if (kt + 2 < nk) GB_LOAD(ra, (kt + 2) * 32);
        GB_STEP(0, rb, true);
        __syncthreads();
        if (kt + 3 < nk) GB_LOAD(rb, (kt + 3) * 32);
        GB_STEP(1, ra, kt + 2 < nk);
        __syncthreads();
    }
#undef GB_LOAD
#undef GB_ST1
#undef GB_STEP
}

__device__ void adaln_item(const Params& p, int item, unsigned char* lds) {
    const int t = tid_opaque(), lane = t & 63, w = t >> 6;
    const int l = item / 48, cgp = item % 48, j = cgp * 64 + lane;
    float* cs = (float*)lds;
    float* red = (float*)(lds + 20480);
    __syncthreads();
    for (int idx = t; idx < 5120; idx += 256) {
        const int bb = idx >> 10, k = idx & 1023;
        const float v = bb < 4 ? p.c[bb * 1024 + k] : p.c_ctx[k];
        cs[idx] = silu_f(v);
    }
    __syncthreads();
    float a0 = 0.f, a1 = 0.f, a2 = 0.f, a3 = 0.f, a4 = 0.f;
    const float* aw = p.ada_w + ((size_t)l * 1024 + w * 256) * 3072 + j;
    for (int k = 0; k < 256; ++k) {
        const float wv = aw[(size_t)k * 3072];
        const int kk = w * 256 + k;
        a0 += cs[kk] * wv; a1 += cs[1024 + kk] * wv; a2 += cs[2048 + kk] * wv; a3 += cs[3072 + kk] * wv; a4 += cs[4096 + kk] * wv;
    }
    red[(w * 5 + 0) * 64 + lane] = a0; red[(w * 5 + 1) * 64 + lane] = a1; red[(w * 5 + 2) * 64 + lane] = a2;
    red[(w * 5 + 3) * 64 + lane] = a3; red[(w * 5 + 4) * 64 + lane] = a4;
    __syncthreads();
    for (int idx = t; idx < 320; idx += 256) {
        const int bb = idx >> 6, ln = idx & 63;
        float v = p.ada_b[l * 3072 + cgp * 64 + ln];
#pragma unroll
        for (int ww = 0; ww < 4; ++ww) v += red[(ww * 5 + bb) * 64 + ln];
        p.mod[(l * 5 + bb) * 3072 + cgp * 64 + ln] = v;
    }
}

__device__ void transpose_tile(const float* __restrict__ src, int N, bf16_t* __restrict__ dst, int K, int k0, int n0, unsigned char* lds) {
    const int t = tid_opaque();
    bf16_t* T = (bf16_t*)lds;
    __syncthreads();
#pragma unroll
    for (int i = 0; i < 4; ++i) {
        const int k = (t >> 4) + 16 * i, n4 = (t & 15) * 4;
        const f32x4 v = *(const f32x4*)(src + (size_t)(k0 + k) * N + n0 + n4);
        T[(n4 + 0) * 72 + k] = f2bf(v[0]); T[(n4 + 1) * 72 + k] = f2bf(v[1]); T[(n4 + 2) * 72 + k] = f2bf(v[2]); T[(n4 + 3) * 72 + k] = f2bf(v[3]);
    }
    __syncthreads();
#pragma unroll
    for (int i = 0; i < 2; ++i) {
        const int cidx = t + 256 * i, n = cidx >> 3, kc = cidx & 7;
        *(u32x4*)(dst + (size_t)(n0 + n) * K + k0 + kc * 8) = *(const u32x4*)(T + n * 72 + kc * 8);
    }
}

#define NCONV_ITEMS (2112 + 3 * 128 + 256)
__device__ void convert_item(const Params& p, int l, int item, unsigned char* lds) {
    if (item < 2112) {
        const int kt = item / 132, nt = item % 132;
        transpose_tile(p.w_in + (size_t)l * 1024 * INC, INC, p.Wt + WT_IN, 1024, kt * 64, nt * 64, lds);
    } else if (item < 2112 + 384) {
        const int it = item - 2112, which = it / 128, r = it % 128, kt = r / 16, nt = r % 16;
        const float* src = (which == 0 ? p.w_ret_o : which == 1 ? p.w_na_o : p.w_gqa_o) + (size_t)l * 512 * 1024;
        bf16_t* dst = p.Wt + (which == 0 ? WT_RET : which == 1 ? WT_NA : WT_GQA);
        transpose_tile(src, 1024, dst, 512, kt * 64, nt * 64, lds);
    } else {
        const int it = item - 2112 - 384, kt = it / 16, nt = it % 16;
        transpose_tile(p.w_out + (size_t)l * 1024 * 1024, 1024, p.Wt + WT_OUT, 1024, kt * 64, nt * 64, lds);
    }
}

__device__ void rope_table(const Params& p) {
    for (int idx = tid_opaque(); idx < 2048; idx += 256) {
        const int pos = idx >> 4, i = idx & 15;
        const float f = ex2(-(float)i * (13.287712379549449f / 16.f));
        const float ang = (float)pos * f;
        float rev = ang * 0.15915494309189535f;
        rev = rev - rintf(rev);
        p.rope[idx * 2 + 0] = __builtin_amdgcn_cosf(rev);
        p.rope[idx * 2 + 1] = __builtin_amdgcn_sinf(rev);
    }
}

__device__ void phase_p0(const Params& p, unsigned char* lds) {
    const int total = 192 + NCONV_ITEMS + 1;
    for (int item = blockIdx.x; item < total; item += gridDim.x) {
        if (item < 192) adaln_item(p, item, lds);
        else if (item < 192 + NCONV_ITEMS) convert_item(p, 0, item - 192, lds);
        else rope_table(p);
    }
}

__device__ void norm_rows(const Params& p, int lnext, const float* xsrc, const float* ysrc) {
    const int t = tid_opaque(), lane = t & 63, w = t >> 6;
    const int nrows = lnext < 4 ? NROWS : NTOK;
    for (int row = blockIdx.x * 4 + w; row < nrows; row += gridDim.x * 4) {
        const float* src = row < NTOK ? xsrc + (size_t)row * DM : ysrc + (size_t)(row - NTOK) * DM;
        f32x4 v[4];
        float ss = 0.f;
#pragma unroll
        for (int i = 0; i < 4; ++i) { v[i] = *(const f32x4*)(src + i * 256 + lane * 4); ss += v[i][0] * v[i][0] + v[i][1] * v[i][1] + v[i][2] * v[i][2] + v[i][3] * v[i][3]; }
#pragma unroll
        for (int o = 32; o >= 1; o >>= 1) ss += __shfl_xor(ss, o);
        const float rstd = rsqrtf(ss * (1.f / 1024.f) + EPSN);
        if (lnext < 4) {
            const int bb = row < NTOK ? (row >> 13) : 4;
            const float* md = p.mod + (size_t)(lnext * 5 + bb) * 3072;
            const float* nw = p.norm_w + lnext * 1024;
#pragma unroll
            for (int i = 0; i < 4; ++i) {
                const int col = i * 256 + lane * 4;
                const f32x4 nwv = *(const f32x4*)(nw + col), sh = *(const f32x4*)(md + col), scl = *(const f32x4*)(md + 1024 + col);
                f32x4 h = v[i] * rstd * nwv * (scl + 1.f) + sh;
                u32x2 o2; o2.x = pk2(h[0], h[1]); o2.y = pk2(h[2], h[3]);
                *(u32x2*)(p.HX + (size_t)row * DM + col) = o2;
            }
        } else {
#pragma unroll
            for (int i = 0; i < 4; ++i) {
                const int col = i * 256 + lane * 4;
                const f32x4 nwv = *(const f32x4*)(p.final_norm_w + col);
                f32x4 ov = v[i] * rstd * nwv;
                *(f32x4*)(p.out + (size_t)row * DM + col) = ov;
            }
        }
    }
}

__device__ void phase_a(const Params& p, int l, unsigned char* lds) {
    const int t = tid_opaque(), lane = t & 63, w = t >> 6, wm = w >> 1, wn = w & 1;
    const int total = 132 * 42;
    const bool xmap = (gridDim.x & 7) == 0;
    const int per = xmap ? (total + 7) / 8 : total;
    const int lo = xmap ? (int)(blockIdx.x & 7) * per : 0, hi = min(lo + per, total);
    const int step = xmap ? (int)(gridDim.x >> 3) : (int)gridDim.x;
    for (int idx = lo + (xmap ? (int)(blockIdx.x >> 3) : (int)blockIdx.x); idx < hi; idx += step) {
        const int nb = idx / 924, rem = idx - nb * 924;
        const int mt = rem / 7, nt = nb * 7 + (rem - mt * 7);
        f32x4 acc[4][8];
#pragma unroll
        for (int a = 0; a < 4; ++a)
#pragma unroll
            for (int b = 0; b < 8; ++b) acc[a][b] = (f32x4){0.f, 0.f, 0.f, 0.f};
        gemm_big(acc, p.HX + (size_t)mt * 256 * DM, DM, p.Wt + WT_IN + (size_t)nt * 128 * DM, DM, DM, lds);
#pragma unroll
        for (int ni = 0; ni < 4; ++ni)
#pragma unroll
            for (int mi = 0; mi < 8; ++mi) {
                const int n = nt * 128 + wn * 64 + ni * 16 + (lane >> 4) * 4, m = mt * 256 + wm * 128 + mi * 16 + (lane & 15);
                u32x2 o2; o2.x = pk2(acc[ni][mi][0], acc[ni][mi][1]); o2.y = pk2(acc[ni][mi][2], acc[ni][mi][3]);
                *(u32x2*)(p.P + (size_t)m * PC + n) = o2;
            }
    }
}

__device__ __forceinline__ int chunk_row(int b, int cidx) { return cidx < 64 ? b * 8192 + cidx * 128 : NTOK + b * 256 + (cidx - 64) * 128; }

__device__ void ret_state_item(const Params& p, int l, int b, int h, int cidx, unsigned char* lds) {
    const int t = tid_opaque(), lane = t & 63, w = t >> 6, g = lane >> 4, c = lane & 15;
    bf16_t* Ktf = (bf16_t*)lds;
    bf16_t* Vt = Ktf + 128 * 72;
    const float lgf = -__expf(p.ret_log_decay[l * 8 + h]) * LOG2E, lgb = -__expf(p.ret_log_decay[l * 8 + 4 + h]) * LOG2E;
    const float ksc = 0.08838834764831845f;
    const int rowbase = chunk_row(b, cidx);
    for (int dir = 0; dir < 2; ++dir) {
        f32x4 acc[2][8];
#pragma unroll
        for (int i = 0; i < 2; ++i)
#pragma unroll
            for (int d = 0; d < 8; ++d) acc[i][d] = (f32x4){0.f, 0.f, 0.f, 0.f};
        const float lg = dir ? lgb : lgf;
#pragma unroll 1
        for (int half = 0; half < 2; ++half) {
            __syncthreads();
#pragma unroll
            for (int i = 0; i < 4; ++i) {
                const int cc = t + 256 * i, tok = cc & 63, dch = cc >> 6, j = half * 64 + tok;
                const float wgt = ex2(lg * (float)(dir ? j : 127 - j)) * ksc;
                const bf16_t* rp = p.P + (size_t)(rowbase + j) * PC + h * 128 + dch * 8;
                const u32x4 kv = ldg16(rp + C_RK), vv = ldg16(rp + C_RV);
#pragma unroll
                for (int e = 0; e < 4; ++e) {
                    const int r0 = (dch * 8 + 2 * e) * 72 + tok, r1 = r0 + 72;
                    Ktf[r0] = f2bf(lo16(kv[e]) * wgt); Ktf[r1] = f2bf(hi16(kv[e]) * wgt);
                    Vt[r0] = (bf16_t)(vv[e] & 0xffffu); Vt[r1] = (bf16_t)(vv[e] >> 16);
                }
            }
            __syncthreads();
#pragma unroll
            for (int ks = 0; ks < 2; ++ks) {
                bf16x8 kf[2];
#pragma unroll
                for (int i = 0; i < 2; ++i) kf[i] = *(const bf16x8*)(Ktf + (w * 32 + i * 16 + c) * 72 + ks * 32 + g * 8);
#pragma unroll
                for (int d = 0; d < 8; ++d) {
                    const bf16x8 vf = *(const bf16x8*)(Vt + (d * 16 + c) * 72 + ks * 32 + g * 8);
#pragma unroll
                    for (int i = 0; i < 2; ++i) acc[i][d] = mfma16(kf[i], vf, acc[i][d]);
                }
            }
        }
        bf16_t* Sd = p.SU + ((size_t)((dir * 4 + b) * 4 + h) * 66 + cidx) * 16384;
#pragma unroll
        for (int i = 0; i < 2; ++i)
#pragma unroll
            for (int d = 0; d < 8; ++d) {
                const int dk = w * 32 + i * 16 + g * 4, dv = d * 16 + c;
                u32x2 o2; o2.x = pk2(acc[i][d][0], acc[i][d][1]); o2.y = pk2(acc[i][d][2], acc[i][d][3]);
                *(u32x2*)(Sd + dv * 128 + dk) = o2;
            }
    }
}

__device__ void qk_prep_item(const Params& p, int l, int item) {
    const int t = tid_opaque(), tok = t >> 2, sub = t & 3;
    const int row = item * 64 + tok;
    const bool lat = row < NTOK;
    const int tseq = row & 8191, pr = tseq >> 6, pc = tseq & 63;
    for (int hv = sub; hv < 10; hv += 4) {
        bf16_t* ptr = p.P + (size_t)row * PC + (hv < 8 ? C_GQ + hv * 64 : C_GK + (hv - 8) * 64);
        const float* nw = hv < 8 ? p.q_norm_w + l * 64 : p.k_norm_w + l * 64;
        float x[64];
        float ss = 0.f;
#pragma unroll
        for (int i = 0; i < 8; ++i) {
            const u32x4 u = ldg16(ptr + i * 8);
#pragma unroll
            for (int e = 0; e < 4; ++e) { x[i * 8 + 2 * e] = lo16(u[e]); x[i * 8 + 2 * e + 1] = hi16(u[e]); }
        }
#pragma unroll
        for (int d = 0; d < 64; ++d) ss += x[d] * x[d];
        const float rstd = rsqrtf(ss * (1.f / 64.f) + EPSN);
#pragma unroll
        for (int d = 0; d < 64; ++d) x[d] = x[d] * rstd * nw[d];
        if (lat) {
#pragma unroll
            for (int i = 0; i < 16; ++i) {
                const float cr = p.rope[(pr * 16 + i) * 2], sr = p.rope[(pr * 16 + i) * 2 + 1];
                const float cc = p.rope[(pc * 16 + i) * 2], sc = p.rope[(pc * 16 + i) * 2 + 1];
                const float a = x[i], b2 = x[16 + i], a2 = x[32 + i], b3 = x[48 + i];
                x[i] = a * cr - b2 * sr; x[16 + i] = b2 * cr + a * sr;
                x[32 + i] = a2 * cc - b3 * sc; x[48 + i] = b3 * cc + a2 * sc;
            }
        }
#pragma unroll
        for (int i = 0; i < 8; ++i) {
            u32x4 u;
#pragma unroll
            for (int e = 0; e < 4; ++e) u[e] = pk2(x[i * 8 + 2 * e], x[i * 8 + 2 * e + 1]);
            *(u32x4*)(ptr + i * 8) = u;
        }
    }
    {
        const int b = lat ? (row >> 13) : ((row - NTOK) >> 8);
        const int key = lat ? tseq : 8192 + ((row - NTOK) & 255);
        const bf16_t* vp = p.P + (size_t)row * PC + C_GV + sub * 32;
        bf16_t* dst = VG(p) + ((size_t)(b * 2 + (sub >> 1)) * 64 + (sub & 1) * 32) * 8448 + key;
#pragma unroll
        for (int i = 0; i < 4; ++i) {
            const u32x4 u = ldg16(vp + i * 8);
#pragma unroll
            for (int e = 0; e < 4; ++e) {
                dst[(size_t)(i * 8 + 2 * e) * 8448] = (bf16_t)(u[e] & 0xffffu);
                dst[(size_t)(i * 8 + 2 * e + 1) * 8448] = (bf16_t)(u[e] >> 16);
            }
        }
    }
}

__device__ void phase_b(const Params& p, int l, unsigned char* lds) {
    const int total = 1056 + 528;
    for (int item = blockIdx.x; item < total; item += gridDim.x) {
        if (item < 1056) { const int cidx = item % 66, bh = item / 66; ret_state_item(p, l, bh >> 2, bh & 3, cidx, lds);
        }
        else qk_prep_item(p, l, item - 1056);
    }
}

__device__ void phase_c(const Params& p, int l, bool dostore = true) {
    const int t = tid_opaque();
    for (int item = blockIdx.x; item < 256; item += gridDim.x) {
        const int part = item & 7, dbh = item >> 3, dir = dbh >> 4, h = dbh & 3;
        const float lg = -__expf(p.ret_log_decay[l * 8 + dir * 4 + h]) * LOG2E;
        const float gc = ex2(lg * 128.f);
        bf16_t* base = p.SU + (size_t)dbh * 66 * 16384 + part * 2048 + t * 8;
        float s[8];
#pragma unroll
        for (int e = 0; e < 8; ++e) s[e] = 0.f;
        for (int st0 = 0; st0 < 66; st0 += 11) {
            u32x4 u[11];
#pragma unroll
            for (int q = 0; q < 11; ++q) {
                const int st = st0 + q;
                const int n = dir == 0 ? (st < 2 ? 64 + st : st - 2) : (st < 2 ? 65 - st : 65 - st);
                u[q] = *(const u32x4*)(base + (size_t)n * 16384);
            }
#pragma unroll
            for (int q = 0; q < 11; ++q) {
                const int st = st0 + q;
                const int n = dir == 0 ? (st < 2 ? 64 + st : st - 2) : (st < 2 ? 65 - st : 65 - st);
                u32x4 o;
#pragma unroll
                for (int e = 0; e < 4; ++e) o[e] = pk2(s[2 * e], s[2 * e + 1]);
                if (dostore) *(u32x4*)(base + (size_t)n * 16384) = o;
#pragma unroll
                for (int e = 0; e < 4; ++e) { s[2 * e] = gc * s[2 * e] + lo16(u[q][e]); s[2 * e + 1] = gc * s[2 * e + 1] + hi16(u[q][e]); }
            }
        }
    }
}

template <int MODE>
__device__ void attn_item(const Params& p, int l, int b, int i1, int i2, int i3, unsigned char* lds, bool dostore = true) {
    constexpr int NQB = (MODE == 2) ? 2 : 4, NHQ = NQB / 2;
    const int t = tid_opaque(), lane = t & 63, w = t >> 6, g = lane >> 4, c = lane & 15;
    bf16_t* Ks = (bf16_t*)lds;
    bf16_t* Vt = Ks + 2 * 64 * 72;
    u32x4* Qs = (u32x4*)(lds + 36864) + w * 512;
    float* rpbs = (float*)(lds + 36864 + 32768);
    int qbase, qstep, qcol, kcol, vcol, gcol, ntiles;
    int R0 = 0, c0 = 0, start = 0, bstart = 0, hh = 0;
    if (MODE == 0 || MODE == 1) {
        const int kvh = i1, qt = i2, head = kvh * 4 + w;
        qbase = (MODE == 0 ? b * 8192 : NTOK + b * 256) + qt * 64; qstep = 16;
        qcol = C_GQ + head * 64; kcol = C_GK + kvh * 64; vcol = C_GV + kvh * 64; gcol = C_GG + head * 64;
        ntiles = MODE == 0 ? 132 : 4;
    } else if (MODE == 2) {
        hh = i1; R0 = i2 * 8; c0 = i3 * 16;
        start = min(max(R0 - 4, 0), 112); bstart = min(max(c0 - 8, 0), 32);
        qbase = b * 8192 + (R0 + w * 2) * 64 + c0; qstep = 64;
        qcol = C_NQ + hh * 64; kcol = C_NK + hh * 64; vcol = C_NV + hh * 64; gcol = C_NG + hh * 64;
        ntiles = 12;
    } else {
        hh = i1;
        qbase = NTOK + b * 256 + w * 64; qstep = 16;
        qcol = C_NQ + hh * 64; kcol = C_NK + hh * 64; vcol = C_NV + hh * 64; gcol = C_NG + hh * 64;
        ntiles = 4;
    }
    const float scale = 0.125f * LOG2E;
    f32x4 o[NQB][4];
    float mrun[NQB], lsum[NQB];
#pragma unroll
    for (int qb = 0; qb < NQB; ++qb) {
        mrun[qb] = -INFINITY; lsum[qb] = 0.f;
#pragma unroll
        for (int d = 0; d < 4; ++d) o[qb][d] = (f32x4){0.f, 0.f, 0.f, 0.f};
    }
    const int kkey = t >> 3, kch = (t & 7) * 8;
    const int vkey = t & 63, vch = (t >> 6);
    u32x4 kr[2], vr[2];
    auto load_tile = [&](int tt) {
        int base, rstep;
        if (MODE == 0) { base = tt < 128 ? b * 8192 + tt * 64 : NTOK + b * 256 + (tt - 128) * 64; rstep = 32; }
        else if (MODE == 2) {
            if (tt < 4) { base = NTOK + b * 256 + tt * 64; rstep = 32; }
            else { base = b * 8192 + (start + 2 * (tt - 4)) * 64 + bstart; rstep = 64; }
        } else { base = NTOK + b * 256 + tt * 64; rstep = 32; }
#pragma unroll
        for (int i = 0; i < 2; ++i) {
            const int key = kkey + 32 * i;
            kr[i] = ldg16(p.P + (size_t)(base + (key >> 5) * rstep + (key & 31)) * PC + kcol + kch);
            if (MODE <= 1) vr[i] = ldg16(VG(p) + ((size_t)(b * 2 + i1) * 64 + kkey + 32 * i) * 8448 + (MODE == 0 ? tt * 64 : 8192 + tt * 64) + kch);
            else vr[i] = ldg16(p.P + (size_t)(base + (vkey >> 5) * rstep + (vkey & 31)) * PC + vcol + (vch + 4 * i) * 8);
        }
    };
    auto store_tile = [&](int buf) {
        bf16_t* ks_ = Ks + buf * 64 * 72; bf16_t* vt_ = Vt + buf * 64 * 72;
#pragma unroll
        for (int i = 0; i < 2; ++i) {
            *(u32x4*)(ks_ + (kkey + 32 * i) * 72 + kch) = kr[i];
            if (MODE <= 1) { *(u32x4*)(vt_ + (kkey + 32 * i) * 72 + kch) = vr[i]; continue; }
#pragma unroll
            for (int e = 0; e < 4; ++e) {
                const int d = (vch + 4 * i) * 8 + 2 * e;
                vt_[d * 72 + vkey] = (bf16_t)(vr[i][e] & 0xffffu);
                vt_[(d + 1) * 72 + vkey] = (bf16_t)(vr[i][e] >> 16);
            }
        }
    };
    load_tile(0);
    __syncthreads();
#pragma unroll
    for (int qb = 0; qb < NQB; ++qb)
#pragma unroll
        for (int ks = 0; ks < 2; ++ks) Qs[(qb * 2 + ks) * 64 + lane] = ldg16(p.P + (size_t)(qbase + qb * qstep + c) * PC + qcol + ks * 32 + g * 8);
    if (MODE == 2) for (int idx = t; idx < 465; idx += 256) rpbs[idx] = p.na_rpb[((size_t)l * 8 + hh) * 465 + idx] * LOG2E;
    store_tile(0);
    __syncthreads();
    const int wlo = min(max(R0 + w * 2 - 4, 0), 120), whi = min(max(R0 + w * 2 + 1 - 4, 0), 120) + 7;
    int colterm[8];
    if (MODE == 2) {
        const int qc = c0 + c, cs = min(max(qc - 8, 0), 48);
#pragma unroll
        for (int j = 0; j < 8; ++j) {
            const int kc = bstart + (j >> 2) * 16 + g * 4 + (j & 3);
            colterm[j] = ((unsigned)(kc - cs) < 16u) ? (kc - qc + 15) : -1;
        }
    }
    for (int tt = 0; tt < ntiles; ++tt) {
        const int cur = tt & 1;
        if (tt + 1 < ntiles) load_tile(tt + 1);
        bool skip = false;
        int krow0 = 0;
        if (MODE == 2 && tt >= 4) { krow0 = start + 2 * (tt - 4); skip = (krow0 + 1 < wlo) || (krow0 > whi); }
        if (!skip) {
            const bf16_t* ks_ = Ks + cur * 64 * 72; const bf16_t* vt_ = Vt + cur * 64 * 72;
            f32x4 s[NQB][4];
#pragma unroll
            for (int qq = 0; qq < NQB; ++qq)
#pragma unroll
                for (int kb = 0; kb < 4; ++kb) s[qq][kb] = (f32x4){0.f, 0.f, 0.f, 0.f};
#pragma unroll
            for (int ks = 0; ks < 2; ++ks) {
                bf16x8 qv[NQB];
#pragma unroll
                for (int qq = 0; qq < NQB; ++qq) qv[qq] = as_bf(Qs[(qq * 2 + ks) * 64 + lane]);
#pragma unroll
                for (int kb = 0; kb < 4; ++kb) {
                    const bf16x8 kf = *(const bf16x8*)(ks_ + (kb * 16 + c) * 72 + ks * 32 + g * 8);
#pragma unroll
                    for (int qq = 0; qq < NQB; ++qq) s[qq][kb] = mfma16(kf, qv[qq], s[qq][kb]);
                }
            }
            __builtin_amdgcn_sched_barrier(0);
            bf16x8 pf[NQB][2];
#pragma unroll
            for (int qq = 0; qq < NQB; ++qq) {
                const int qb = qq;
                if (MODE == 2 && tt >= 4) {
                    const int qrow = R0 + w * 2 + qb;
                    const int rs = min(max(qrow - 4, 0), 120);
#pragma unroll
                    for (int kb = 0; kb < 4; ++kb) {
                        const int krow = krow0 + (kb >> 1);
                        const bool rowok = (unsigned)(krow - rs) < 8u;
                        const int ridx = (krow - qrow + 7) * 31;
#pragma unroll
                        for (int r = 0; r < 4; ++r) {
                            const int ct = colterm[(kb & 1) * 4 + r];
                            const bool valid = rowok && ct >= 0;
                            const float bias = rpbs[valid ? ridx + ct : 0];
                            s[qq][kb][r] = valid ? s[qq][kb][r] * scale + bias : -INFINITY;
                        }
                    }
                }
                const bool raw = !(MODE == 2 && tt >= 4);
                float tmax = fmaxf(fmaxf(s[qq][0][0], s[qq][0][1]), fmaxf(s[qq][0][2], s[qq][0][3]));
#pragma unroll
                for (int kb = 1; kb < 4; ++kb) tmax = fmaxf(tmax, fmaxf(fmaxf(s[qq][kb][0], s[qq][kb][1]), fmaxf(s[qq][kb][2], s[qq][kb][3])));
                tmax = fmaxf(tmax, __shfl_xor(tmax, 16)); tmax = fmaxf(tmax, __shfl_xor(tmax, 32));
                const float mn = fmaxf(mrun[qb], raw ? tmax * scale : tmax);
                const float alpha = ex2(mrun[qb] - mn);
                mrun[qb] = mn;
                float psum = 0.f;
#pragma unroll
                for (int kb = 0; kb < 4; ++kb)
#pragma unroll
                    for (int r = 0; r < 4; ++r) { const float pv = raw ? ex2(__builtin_fmaf(s[qq][kb][r], scale, -mn)) : ex2(s[qq][kb][r] - mn); s[qq][kb][r] = pv; psum += pv; }
                lsum[qb] = lsum[qb] * alpha + psum;
                if (__builtin_amdgcn_ballot_w64(alpha != 1.f) != 0ull) {
#pragma unroll
                    for (int d = 0; d < 4; ++d) o[qb][d] = o[qb][d] * alpha;
                }
#pragma unroll
                for (int kk = 0; kk < 2; ++kk) {
                    u32x4 u;
                    u[0] = pk2(s[qq][2 * kk][0], s[qq][2 * kk][1]); u[1] = pk2(s[qq][2 * kk][2], s[qq][2 * kk][3]);
                    u[2] = pk2(s[qq][2 * kk + 1][0], s[qq][2 * kk + 1][1]); u[3] = pk2(s[qq][2 * kk + 1][2], s[qq][2 * kk + 1][3]);
                    pf[qq][kk] = as_bf(u);
                }
            }
            __builtin_amdgcn_sched_barrier(0);
#pragma unroll
            for (int kk = 0; kk < 2; ++kk)
#pragma unroll
                for (int d = 0; d < 4; ++d) {
                    const u32x2 vlo = *(const u32x2*)(vt_ + (d * 16 + c) * 72 + kk * 32 + g * 4);
                    const u32x2 vhi = *(const u32x2*)(vt_ + (d * 16 + c) * 72 + kk * 32 + 16 + g * 4);
                    u32x4 vv; vv[0] = vlo[0]; vv[1] = vlo[1]; vv[2] = vhi[0]; vv[3] = vhi[1];
                    const bf16x8 vf = as_bf(vv);
#pragma unroll
                    for (int qq = 0; qq < NQB; ++qq) o[qq][d] = mfma16(vf, pf[qq][kk], o[qq][d]);
                }
        }
        if (tt + 1 < ntiles) store_tile(cur ^ 1);
        __syncthreads();
    }
    if (dostore)
#pragma unroll
    for (int qb = 0; qb < NQB; ++qb) {
        float ls = lsum[qb];
        ls += __shfl_xor(ls, 16); ls += __shfl_xor(ls, 32);
        const float inv = __builtin_amdgcn_rcpf(ls);
        bf16_t* rowp = p.P + (size_t)(qbase + qb * qstep + c) * PC;
#pragma unroll
        for (int d = 0; d < 4; ++d) {
            const int dd = d * 16 + g * 4;
            const u32x2 gt = *(const u32x2*)(rowp + gcol + dd);
            const float v0 = o[qb][d][0] * inv * silu_f(lo16(gt[0])), v1 = o[qb][d][1] * inv * silu_f(hi16(gt[0]));
            const float v2 = o[qb][d][2] * inv * silu_f(lo16(gt[1])), v3 = o[qb][d][3] * inv * silu_f(hi16(gt[1]));
            u32x2 o2; o2.x = pk2(v0, v1); o2.y = pk2(v2, v3);
            *(u32x2*)(rowp + qcol + dd) = o2;
        }
    }
}

typedef float f32x16 __attribute__((ext_vector_type(16)));
__device__ __forceinline__ f32x16 mfma32(bf16x8 a, bf16x8 b, f32x16 c) { return __builtin_amdgcn_mfma_f32_32x32x16_bf16(a, b, c, 0, 0, 0); }

template <int MODE>
__device__ void attn_item32(const Params& p, int l, int b, int i1, int i2, unsigned char* lds, bool dostore = true) {
    const int t = tid_opaque(), lane = t & 63, w = t >> 6, h = lane >> 5, c = lane & 31;
    bf16_t* Ks = (bf16_t*)lds;
    bf16_t* Vt = Ks + 2 * 64 * 72;
    u32x4* Qs = (u32x4*)(lds + 36864) + w * 512;
    int qbase, qcol, kcol, vcol, gcol, ntiles;
    if (MODE == 0 || MODE == 1) {
        const int kvh = i1, qt = i2, head = kvh * 4 + w;
        qbase = (MODE == 0 ? b * 8192 : NTOK + b * 256) + qt * 64;
        qcol = C_GQ + head * 64; kcol = C_GK + kvh * 64; vcol = C_GV + kvh * 64; gcol = C_GG + head * 64;
        ntiles = MODE == 0 ? 132 : 4;
    } else {
        const int hh = i1;
        qbase = NTOK + b * 256 + w * 64;
        qcol = C_NQ + hh * 64; kcol = C_NK + hh * 64; vcol = C_NV + hh * 64; gcol = C_NG + hh * 64;
        ntiles = 4;
    }
    const float scale = 0.125f * LOG2E;
    f32x16 o[2][2];
    float mrun[2], lsum[2];
#pragma unroll
    for (int qb = 0; qb < 2; ++qb) {
        mrun[qb] = -INFINITY; lsum[qb] = 0.f;
#pragma unroll
        for (int d = 0; d < 2; ++d)
#pragma unroll
            for (int r = 0; r < 16; ++r) o[qb][d][r] = 0.f;
    }
    const int kkey = t >> 3, kch = (t & 7) * 8;
    const int vkey = t & 63, vch = (t >> 6);
    u32x4 kr[2], vr[2];
    auto load_tile = [&](int tt) {
        const int base = MODE == 0 ? (tt < 128 ? b * 8192 + tt * 64 : NTOK + b * 256 + (tt - 128) * 64) : NTOK + b * 256 + tt * 64;
#pragma unroll
        for (int i = 0; i < 2; ++i) {
            kr[i] = ldg16(p.P + (size_t)(base + kkey + 32 * i) * PC + kcol + kch);
            if (MODE <= 1) vr[i] = ldg16(VG(p) + ((size_t)(b * 2 + i1) * 64 + kkey + 32 * i) * 8448 + (MODE == 0 ? tt * 64 : 8192 + tt * 64) + kch);
            else vr[i] = ldg16(p.P + (size_t)(base + vkey) * PC + vcol + (vch + 4 * i) * 8);
        }
    };
    auto store_tile = [&](int buf) {
        bf16_t* ks_ = Ks + buf * 64 * 72; bf16_t* vt_ = Vt + buf * 64 * 72;
#pragma unroll
        for (int i = 0; i < 2; ++i) {
            *(u32x4*)(ks_ + (kkey + 32 * i) * 72 + kch) = kr[i];
            if (MODE <= 1) { *(u32x4*)(vt_ + (kkey + 32 * i) * 72 + kch) = vr[i]; continue; }
#pragma unroll
            for (int e = 0; e < 4; ++e) {
                const int d = (vch + 4 * i) * 8 + 2 * e;
                vt_[d * 72 + vkey] = (bf16_t)(vr[i][e] & 0xffffu);
                vt_[(d + 1) * 72 + vkey] = (bf16_t)(vr[i][e] >> 16);
            }
        }
    };
    load_tile(0);
    __syncthreads();
#pragma unroll
    for (int qb = 0; qb < 2; ++qb)
#pragma unroll
        for (int ks = 0; ks < 4; ++ks) Qs[(qb * 4 + ks) * 64 + lane] = ldg16(p.P + (size_t)(qbase + qb * 32 + c) * PC + qcol + ks * 16 + h * 8);
    store_tile(0);
    __syncthreads();
    for (int tt = 0; tt < ntiles; ++tt) {
        const int cur = tt & 1;
        if (tt + 1 < ntiles) load_tile(tt + 1);
        const bf16_t* ks_ = Ks + cur * 64 * 72; const bf16_t* vt_ = Vt + cur * 64 * 72;
        f32x16 s[2][2];
#pragma unroll
        for (int qb = 0; qb < 2; ++qb)
#pragma unroll
            for (int kb = 0; kb < 2; ++kb)
#pragma unroll
                for (int r = 0; r < 16; ++r) s[qb][kb][r] = 0.f;
#pragma unroll
        for (int ks = 0; ks < 4; ++ks) {
            const bf16x8 q0 = as_bf(Qs[ks * 64 + lane]), q1 = as_bf(Qs[(4 + ks) * 64 + lane]);
#pragma unroll
            for (int kb = 0; kb < 2; ++kb) {
                const bf16x8 kf = *(const bf16x8*)(ks_ + (kb * 32 + c) * 72 + ks * 16 + h * 8);
                s[0][kb] = mfma32(kf, q0, s[0][kb]);
                s[1][kb] = mfma32(kf, q1, s[1][kb]);
            }
        }
        bf16x8 pf[2][4];
#pragma unroll
        for (int qb = 0; qb < 2; ++qb) {
            float tmax = s[qb][0][0];
#pragma unroll
            for (int kb = 0; kb < 2; ++kb)
#pragma unroll
                for (int r = 0; r < 16; r += 4) tmax = fmaxf(tmax, fmaxf(fmaxf(s[qb][kb][r], s[qb][kb][r + 1]), fmaxf(s[qb][kb][r + 2], s[qb][kb][r + 3])));
            tmax = fmaxf(tmax, __shfl_xor(tmax, 32));
            const float mn = fmaxf(mrun[qb], tmax * scale);
            const float alpha = ex2(mrun[qb] - mn);
            mrun[qb] = mn;
            float psum = 0.f;
#pragma unroll
            for (int kb = 0; kb < 2; ++kb)
#pragma unroll
                for (int r = 0; r < 16; ++r) { const float pv = ex2(__builtin_fmaf(s[qb][kb][r], scale, -mn)); s[qb][kb][r] = pv; psum += pv; }
            lsum[qb] = lsum[qb] * alpha + psum;
            if (__builtin_amdgcn_ballot_w64(alpha != 1.f) != 0ull) {
#pragma unroll
                for (int d = 0; d < 2; ++d)
#pragma unroll
                    for (int r = 0; r < 16; ++r) o[qb][d][r] *= alpha;
            }
#pragma unroll
            for (int kb = 0; kb < 2; ++kb)
#pragma unroll
                for (int st = 0; st < 2; ++st) {
                    u32x4 u;
#pragma unroll
                    for (int e = 0; e < 4; ++e) u[e] = pk2(s[qb][kb][8 * st + 2 * e], s[qb][kb][8 * st + 2 * e + 1]);
                    pf[qb][kb * 2 + st] = as_bf(u);
                }
        }
#pragma unroll
        for (int kk = 0; kk < 4; ++kk)
#pragma unroll
            for (int d = 0; d < 2; ++d) {
                const u32x2 vlo = *(const u32x2*)(vt_ + (d * 32 + c) * 72 + kk * 16 + h * 4);
                const u32x2 vhi = *(const u32x2*)(vt_ + (d * 32 + c) * 72 + kk * 16 + 8 + h * 4);
                u32x4 vv; vv[0] = vlo[0]; vv[1] = vlo[1]; vv[2] = vhi[0]; vv[3] = vhi[1];
                const bf16x8 vf = as_bf(vv);
                o[0][d] = mfma32(vf, pf[0][kk], o[0][d]);
                o[1][d] = mfma32(vf, pf[1][kk], o[1][d]);
            }
        if (tt + 1 < ntiles) store_tile(cur ^ 1);
        __syncthreads();
    }
    if (dostore)
#pragma unroll
    for (int qb = 0; qb < 2; ++qb) {
        float ls = lsum[qb];
        ls += __shfl_xor(ls, 32);
        const float inv = __builtin_amdgcn_rcpf(ls);
        bf16_t* rowp = p.P + (size_t)(qbase + qb * 32 + c) * PC;
#pragma unroll
        for (int d = 0; d < 2; ++d)
#pragma unroll
            for (int rg = 0; rg < 4; ++rg) {
                const int dd = d * 32 + rg * 8 + h * 4;
                const u32x2 gt = *(const u32x2*)(rowp + gcol + dd);
                const float v0 = o[qb][d][rg * 4 + 0] * inv * silu_f(lo16(gt[0])), v1 = o[qb][d][rg * 4 + 1] * inv * silu_f(hi16(gt[0]));
                const float v2 = o[qb][d][rg * 4 + 2] * inv * silu_f(lo16(gt[1])), v3 = o[qb][d][rg * 4 + 3] * inv * silu_f(hi16(gt[1]));
                u32x2 o2; o2.x = pk2(v0, v1); o2.y = pk2(v2, v3);
                *(u32x2*)(rowp + qcol + dd) = o2;
            }
    }
}

__device__ __forceinline__ bf16x8 scale_frag(bf16x8 f, float sc) {
    u32x4 u = as_u(f), r;
#pragma unroll
    for (int e = 0; e < 4; ++e) r[e] = pk2(lo16(u[e]) * sc, hi16(u[e]) * sc);
    return as_bf(r);
}

__device__ void ret_item(const Params& p, int l, int b, int h, int cidx, int hf, unsigned char* lds, bool dostore = true) {
    const int t = tid_opaque(), lane = t & 63, w = t >> 6, g = lane >> 4, c = lane & 15;
    bf16_t* B0 = (bf16_t*)lds;
    bf16_t* B1 = B0 + 128 * 136;
    const float lgf = -__expf(p.ret_log_decay[l * 8 + h]) * LOG2E, lgb = -__expf(p.ret_log_decay[l * 8 + 4 + h]) * LOG2E;
    const float ksc = 0.08838834764831845f;
    const int rowbase = chunk_row(b, cidx);
    const int ti = hf * 64 + w * 16 + c;
    bf16x8 qf[4];
#pragma unroll
    for (int ks = 0; ks < 4; ++ks) qf[ks] = as_bf(ldg16(p.P + (size_t)(rowbase + ti) * PC + C_RQ + h * 128 + ks * 32 + g * 8));
    __syncthreads();
#pragma unroll
    for (int i = 0; i < 8; ++i) {
        const int cc = t + 256 * i;
        { const int r = cc >> 4, ch = cc & 15; *(u32x4*)(B0 + r * 136 + ch * 8) = ldg16(p.P + (size_t)(rowbase + r) * PC + C_RK + h * 128 + ch * 8); }
        { const int tok = cc & 127, ch = cc >> 7;
          const u32x4 vv = ldg16(p.P + (size_t)(rowbase + tok) * PC + C_RV + h * 128 + ch * 8);
#pragma unroll
          for (int e = 0; e < 4; ++e) { B1[(ch * 8 + 2 * e) * 136 + tok] = (bf16_t)(vv[e] & 0xffffu); B1[(ch * 8 + 2 * e + 1) * 136 + tok] = (bf16_t)(vv[e] >> 16); } }
    }
    __syncthreads();
    bf16x8 pf[4];
    {
        f32x4 s[8];
#pragma unroll
        for (int kb = 0; kb < 8; ++kb) s[kb] = (f32x4){0.f, 0.f, 0.f, 0.f};
#pragma unroll
        for (int ks = 0; ks < 4; ++ks)
#pragma unroll
            for (int kb = 0; kb < 8; ++kb) {
                const bf16x8 kf = *(const bf16x8*)(B0 + (kb * 16 + c) * 136 + ks * 32 + g * 8);
                s[kb] = mfma16(kf, qf[ks], s[kb]);
            }
#pragma unroll
        for (int kb = 0; kb < 8; ++kb)
#pragma unroll
            for (int r = 0; r < 4; ++r) {
                const int j = kb * 16 + g * 4 + r, d = ti - j;
                const float wgt = d > 0 ? ex2(lgf * (float)d) : (d < 0 ? ex2(lgb * (float)(-d)) : 2.f);
                s[kb][r] *= wgt * ksc;
            }
#pragma unroll
        for (int kk = 0; kk < 4; ++kk) {
            u32x4 u;
            u[0] = pk2(s[2 * kk][0], s[2 * kk][1]); u[1] = pk2(s[2 * kk][2], s[2 * kk][3]);
            u[2] = pk2(s[2 * kk + 1][0], s[2 * kk + 1][1]); u[3] = pk2(s[2 * kk + 1][2], s[2 * kk + 1][3]);
            pf[kk] = as_bf(u);
        }
    }
    f32x4 o[8];
#pragma unroll
    for (int d = 0; d < 8; ++d) o[d] = (f32x4){0.f, 0.f, 0.f, 0.f};
#pragma unroll
    for (int kk = 0; kk < 4; ++kk)
#pragma unroll
        for (int d = 0; d < 8; ++d) {
            const u32x2 vlo = *(const u32x2*)(B1 + (d * 16 + c) * 136 + kk * 32 + g * 4);
            const u32x2 vhi = *(const u32x2*)(B1 + (d * 16 + c) * 136 + kk * 32 + 16 + g * 4);
            u32x4 vv; vv[0] = vlo[0]; vv[1] = vlo[1]; vv[2] = vhi[0]; vv[3] = vhi[1];
            o[d] = mfma16(as_bf(vv), pf[kk], o[d]);
        }
    __syncthreads();
    {
        const bf16_t* Sf = p.SU + ((size_t)((0 * 4 + b) * 4 + h) * 66 + cidx) * 16384;
        const bf16_t* Sb = p.SU + ((size_t)((1 * 4 + b) * 4 + h) * 66 + cidx) * 16384;
#pragma unroll
        for (int i = 0; i < 8; ++i) {
            const int cc = t + 256 * i, r = cc >> 4, ch = cc & 15;
            *(u32x4*)(B0 + r * 136 + ch * 8) = ldg16(Sf + r * 128 + ch * 8);
            *(u32x4*)(B1 + r * 136 + ch * 8) = ldg16(Sb + r * 128 + ch * 8);
        }
    }
    __syncthreads();
#pragma unroll
    for (int dir = 0; dir < 2; ++dir) {
        const bf16_t* Bd = dir ? B1 : B0;
        const float xi = dir == 0 ? ex2(lgf * (float)(ti + 1)) : ex2(lgb * (float)(128 - ti));
        bf16x8 qs[4];
#pragma unroll
        for (int ks = 0; ks < 4; ++ks) qs[ks] = scale_frag(qf[ks], xi);
#pragma unroll
        for (int ks = 0; ks < 4; ++ks)
#pragma unroll
            for (int d = 0; d < 8; ++d) {
                const bf16x8 sf = *(const bf16x8*)(Bd + (d * 16 + c) * 136 + ks * 32 + g * 8);
                o[d] = mfma16(sf, qs[ks], o[d]);
            }
    }
    if (dostore) {
        float sum = 0.f;
#pragma unroll
        for (int d = 0; d < 8; ++d) sum += (o[d][0] + o[d][1]) + (o[d][2] + o[d][3]);
        sum += __shfl_xor(sum, 16); sum += __shfl_xor(sum, 32);
        const float mu = sum * (1.f / 128.f);
        float var = 0.f;
#pragma unroll
        for (int d = 0; d < 8; ++d)
#pragma unroll
            for (int r = 0; r < 4; ++r) { const float dd = o[d][r] - mu; var += dd * dd; }
        var += __shfl_xor(var, 16); var += __shfl_xor(var, 32);
        const float rstd = rsqrtf(var * (1.f / 128.f) + EPSN);
        bf16_t* rowp = p.P + (size_t)(rowbase + ti) * PC;
#pragma unroll
        for (int d = 0; d < 8; ++d) {
            const int dv = d * 16 + g * 4;
            const f32x4 gn = *(const f32x4*)(p.ret_gn_w + l * 512 + h * 128 + dv);
            const u32x2 gt = *(const u32x2*)(rowp + C_RG + h * 128 + dv);
            const float v0 = (o[d][0] - mu) * rstd * gn[0] * silu_f(lo16(gt[0])), v1 = (o[d][1] - mu) * rstd * gn[1] * silu_f(hi16(gt[0]));
            const float v2 = (o[d][2] - mu) * rstd * gn[2] * silu_f(lo16(gt[1])), v3 = (o[d][3] - mu) * rstd * gn[3] * silu_f(hi16(gt[1]));
            u32x2 o2; o2.x = pk2(v0, v1); o2.y = pk2(v2, v3);
            *(u32x2*)(rowp + C_RQ + h * 128 + dv) = o2;
        }
    }
}

__device__ void phase_d(const Params& p, int l, unsigned char* lds) {
    const bool need_ctx = l < 3;
    const int G = gridDim.x, bid = blockIdx.x;
    const bool small_first = bid >= (G >> 1);
#pragma unroll 1
    for (int stage = 0; stage < 3; ++stage) {
        const int kind = small_first ? (stage + 1) % 3 : stage;
        if (kind == 0) {
#pragma unroll 1
            for (int it = bid; it < 1024; it += G) {
                attn_item32<0>(p, l, it >> 8, (it >> 7) & 1, it & 127, lds);
            }
        } else if (kind == 1) {
#pragma unroll 1
            for (int it = bid; it < 2048; it += G) {
                attn_item<2>(p, l, it >> 9, (it >> 6) & 7, (it >> 2) & 15, it & 3, lds);
            }
        } else {
            const int nch = need_ctx ? 66 : 64, n_ret = nch * 32;
#pragma unroll 1
            for (int it = G - 1 - bid; it < n_ret; it += G) {
                const int hf = it & 1, it2 = it >> 1;
                const int cidx = it2 % nch, bh = it2 / nch;
                ret_item(p, l, bh >> 2, bh & 3, cidx, hf, lds);
            }
        }
        __syncthreads();
    }
    if (need_ctx) {
#pragma unroll 1
        for (int it = G - 1 - bid; it < 32; it += G) attn_item32<1>(p, l, it >> 3, (it >> 2) & 1, it & 3, lds);
        __syncthreads();
#pragma unroll 1
        for (int it = G - 1 - bid - 32; it < 32; it += G) { if (it >= 0) attn_item32<3>(p, l, it >> 3, it & 7, 0, lds); }
    }
}

__device__ void phase_e1(const Params& p, int l, unsigned char* lds) {
    const int t = tid_opaque(), lane = t & 63, w = t >> 6, wm = w >> 1, wn = w & 1;
    const int nmt = l < 3 ? 264 : 256;
    const int total = nmt * 8;
    for (int item = blockIdx.x; item < total; item += gridDim.x) {
        const int mt = item >> 3, nt = item & 7;
        u32x2 macc[4][4];
#pragma unroll
        for (int a = 0; a < 4; ++a)
#pragma unroll
            for (int b = 0; b < 4; ++b) macc[a][b] = (u32x2){0u, 0u};
#pragma unroll 1
        for (int br = 0; br < 3; ++br) {
            u32x2 sg[4][4];
            {
                f32x4 gacc[4][4];
#pragma unroll
                for (int a = 0; a < 4; ++a)
#pragma unroll
                    for (int b = 0; b < 4; ++b) gacc[a][b] = (f32x4){0.f, 0.f, 0.f, 0.f};
                gemm_core<4>(gacc, p.HX + (size_t)mt * 128 * DM, DM, p.Wt + WT_IN + (size_t)(PC + br * 1024 + nt * 128) * DM, DM, DM, lds);
#pragma unroll
                for (int a = 0; a < 4; ++a)
#pragma unroll
                    for (int b = 0; b < 4; ++b) { sg[a][b].x = pk2(sigm_f(gacc[a][b][0]), sigm_f(gacc[a][b][1])); sg[a][b].y = pk2(sigm_f(gacc[a][b][2]), sigm_f(gacc[a][b][3])); }
            }
            f32x4 pacc[4][4];
#pragma unroll
            for (int a = 0; a < 4; ++a)
#pragma unroll
                for (int b = 0; b < 4; ++b) pacc[a][b] = (f32x4){0.f, 0.f, 0.f, 0.f};
            const int xcol = br == 0 ? C_RQ : (br == 1 ? C_NQ : C_GQ);
            const int woff = br == 0 ? WT_RET : (br == 1 ? WT_NA : WT_GQA);
            gemm_core<4>(pacc, p.P + (size_t)mt * 128 * PC + xcol, PC, p.Wt + woff + (size_t)nt * 128 * 512, 512, 512, lds);
#pragma unroll
            for (int a = 0; a < 4; ++a)
#pragma unroll
                for (int b = 0; b < 4; ++b) {
                    const float m0 = lo16(macc[a][b].x) + lo16(sg[a][b].x) * pacc[a][b][0], m1 = hi16(macc[a][b].x) + hi16(sg[a][b].x) * pacc[a][b][1];
                    const float m2 = lo16(macc[a][b].y) + lo16(sg[a][b].y) * pacc[a][b][2], m3 = hi16(macc[a][b].y) + hi16(sg[a][b].y) * pacc[a][b][3];
                    macc[a][b].x = pk2(m0, m1); macc[a][b].y = pk2(m2, m3);
                }
        }
#pragma unroll
        for (int ni = 0; ni < 4; ++ni)
#pragma unroll
            for (int mi = 0; mi < 4; ++mi) {
                const int n = nt * 128 + wn * 64 + ni * 16 + (lane >> 4) * 4, m = mt * 128 + wm * 64 + mi * 16 + (lane & 15);
                *(u32x2*)(p.P + (size_t)m * PC + C_M + n) = macc[ni][mi];
            }
    }
}

__device__ void phase_e2(const Params& p, int l, unsigned char* lds, bool dostore = true) {
    const int t = tid_opaque(), lane = t & 63, w = t >> 6, wm = w >> 1, wn = w & 1;
    const int nmt = l < 3 ? 264 : 256;
    const int total = nmt * 8;
    const float* xsrc = l == 0 ? p.x : p.out;
    const float* ysrc = l == 0 ? p.ctx : p.y;
    for (int item = blockIdx.x; item < total; item += gridDim.x) {
        const int mt = item >> 3, nt = item & 7;
        f32x4 acc[4][4];
#pragma unroll
        for (int a = 0; a < 4; ++a)
#pragma unroll
            for (int b = 0; b < 4; ++b) acc[a][b] = (f32x4){0.f, 0.f, 0.f, 0.f};
        gemm_core<4>(acc, p.P + (size_t)mt * 128 * PC + C_M, PC, p.Wt + WT_OUT + (size_t)nt * 128 * DM, DM, DM, lds);
#pragma unroll
        for (int mi = 0; mi < 4; ++mi) {
            const int m = mt * 128 + wm * 64 + mi * 16 + (lane & 15);
            const bool lat = m < NTOK;
            const int bb = lat ? (m >> 13) : 4;
            const float* src = lat ? xsrc + (size_t)m * DM : ysrc + (size_t)(m - NTOK) * DM;
            float* dst = lat ? p.out + (size_t)m * DM : p.y + (size_t)(m - NTOK) * DM;
            const float* gate = p.mod + (size_t)(l * 5 + bb) * 3072 + 2048;
#pragma unroll
            for (int ni = 0; ni < 4; ++ni) {
                const int n = nt * 128 + wn * 64 + ni * 16 + (lane >> 4) * 4;
                const f32x4 xo = *(const f32x4*)(src + n), gv = *(const f32x4*)(gate + n);
                if (dostore) *(f32x4*)(dst + n) = xo + gv * acc[ni][mi];
            }
        }
    }
}

__device__ void phase_e3(const Params& p, int l, unsigned char* lds) {
    norm_rows(p, l + 1, p.out, p.y);
    if (l < 3)
        for (int item = blockIdx.x; item < NCONV_ITEMS; item += gridDim.x) convert_item(p, l + 1, item, lds);
}


__device__ __forceinline__ void run_phase(const Params& p, int ph, int l, unsigned char* lds) {
    switch (ph) {
        case 0: phase_p0(p, lds);
            break;
        case 1: norm_rows(p, 0, p.x, p.ctx); break;
        case 2: phase_a(p, l, lds);
            break;
        case 3: phase_b(p, l, lds); break;
        case 4:
            phase_c(p, l); break;
        case 5: phase_d(p, l, lds); break;
        case 6: phase_e1(p, l, lds);
            break;
        case 7:
            phase_e2(p, l, lds); break;
        default: phase_e3(p, l, lds);
            break;
    }
}

__device__ __forceinline__ void fast_grid_barrier(unsigned* bar, unsigned k) {
    asm volatile("s_waitcnt vmcnt(0) lgkmcnt(0)" ::: "memory");
    __syncthreads();
    if (threadIdx.x == 0) {
        const unsigned grp = blockIdx.x & 7u, members = (gridDim.x - grp + 7u) >> 3;
        __builtin_amdgcn_fence(__ATOMIC_RELEASE, "agent");
        const unsigned old = __hip_atomic_fetch_add(bar + grp * 32, 1u, __ATOMIC_RELAXED, __HIP_MEMORY_SCOPE_AGENT);
        if (old + 1u == k * members) {
            __hip_atomic_fetch_add(bar + 256, 1u, __ATOMIC_RELAXED, __HIP_MEMORY_SCOPE_AGENT);
            while (__hip_atomic_load(bar + 256, __ATOMIC_RELAXED, __HIP_MEMORY_SCOPE_AGENT) < k * 8u) __builtin_amdgcn_s_sleep(1);
            __hip_atomic_store(bar + 288 + grp * 32, k, __ATOMIC_RELAXED, __HIP_MEMORY_SCOPE_AGENT);
        } else {
            while (__hip_atomic_load(bar + 288 + grp * 32, __ATOMIC_RELAXED, __HIP_MEMORY_SCOPE_AGENT) < k) __builtin_amdgcn_s_sleep(1);
        }
        __builtin_amdgcn_fence(__ATOMIC_ACQUIRE, "agent");
    }
    __syncthreads();
}
#define GSYNC() do { asm volatile("s_waitcnt vmcnt(0) lgkmcnt(0)" ::: "memory"); grid.sync(); } while (0)
__global__ void __launch_bounds__(256, 2) mega_kernel(Params p) {
    __shared__ __attribute__((aligned(16))) unsigned char lds[LDS_BYTES];
    cg::grid_group grid = cg::this_grid();
    unsigned bk = 0;
    run_phase(p, 0, 0, lds); GSYNC();
    run_phase(p, 1, 0, lds); fast_grid_barrier(p.bar, ++bk);
    for (int l = 0; l < 4; ++l) {
#pragma unroll 1
        for (int ph = 2; ph <= 8; ++ph) {
            run_phase(p, ph, l, lds);
            if (!(l == 3 && ph == 8)) fast_grid_barrier(p.bar, ++bk);
        }
    }
}

extern "C" void kernel_launch(void* const* d_in, const int* in_sizes, int n_in, void* d_out, int out_size, void* d_ws, size_t ws_size, hipStream_t stream) {
    Params p{};
    p.x = (const float*)d_in[0]; p.c = (const float*)d_in[1]; p.ctx = (const float*)d_in[2]; p.c_ctx = (const float*)d_in[3];
    p.ada_w = (const float*)d_in[4]; p.ada_b = (const float*)d_in[5]; p.norm_w = (const float*)d_in[6]; p.w_in = (const float*)d_in[7];
    p.ret_log_decay = (const float*)d_in[8]; p.ret_gn_w = (const float*)d_in[9]; p.na_rpb = (const float*)d_in[10];
    p.q_norm_w = (const float*)d_in[11]; p.k_norm_w = (const float*)d_in[12]; p.w_ret_o = (const float*)d_in[13];
    p.w_na_o = (const float*)d_in[14]; p.w_gqa_o = (const float*)d_in[15]; p.w_out = (const float*)d_in[16]; p.final_norm_w = (const float*)d_in[17];
    p.out = (float*)d_out;
    unsigned char* ws = (unsigned char*)d_ws;
    size_t off = 0;
    p.P = (bf16_t*)(ws + off); off += (size_t)NROWS * PC * 2;
    p.HX = (bf16_t*)(ws + off); off += (size_t)NROWS * DM * 2;
    p.Wt = (bf16_t*)(ws + off); off += (size_t)WT_TOTAL * 2;
    p.SU = (bf16_t*)(ws + off); off += (size_t)2 * 4 * 4 * 66 * 16384 * 2;
    p.y = (float*)(ws + off); off += (size_t)1024 * 1024 * 4;
    p.mod = (float*)(ws + off); off += (size_t)4 * 5 * 3072 * 4;
    p.rope = (float*)(ws + off); off += (size_t)128 * 16 * 2 * 4 + 256;
    p.bar = (unsigned*)(ws + off); off += 4096;
    off += (size_t)4 * 2 * 64 * 8448 * 2;
    if (off > ws_size) { fprintf(stderr, "workspace too small: need %zu have %zu\n", off, ws_size); return; }
    static int grid_blocks = 0;
    if (!grid_blocks) {
        int dev = 0, cus = 0, per_cu = 0;
        hipGetDevice(&dev);
        hipDeviceGetAttribute(&cus, hipDeviceAttributeMultiprocessorCount, dev);
        hipOccupancyMaxActiveBlocksPerMultiprocessor(&per_cu, mega_kernel, 256, 0);
        if (per_cu > 2) per_cu = 2;
        grid_blocks = cus * per_cu;
    }
    hipMemsetAsync(p.bar, 0, 4096, stream);
    void* args[] = {&p};
    hipError_t e = hipLaunchCooperativeKernel((void*)mega_kernel, dim3(grid_blocks), dim3(256), args, 0, stream);
    if (e != hipSuccess) fprintf(stderr, "cooperative launch failed: %s (grid %d)\n", hipGetErrorString(e), grid_blocks);
}
```

```cpp
#include <hip/hip_runtime.h>
#include <hip/hip_cooperative_groups.h>
#include <cstdio>
#include <cstdint>
namespace cg = cooperative_groups;


typedef unsigned short bf16_t;
typedef short bf16x8 __attribute__((ext_vector_type(8)));
typedef float f32x4 __attribute__((ext_vector_type(4)));
typedef unsigned u32x4 __attribute__((ext_vector_type(4)));
typedef unsigned u32x2 __attribute__((ext_vector_type(2)));

#define DM 1024
#define NTOK 32768
#define NROWS 33792
#define PC 5376
#define INC 8448
#define LOG2E 1.4426950408889634f
#define EPSN 1e-6f
#define LDS_BYTES 73728

#define C_RQ 0
#define C_RK 512
#define C_RV 1024
#define C_RG 1536
#define C_NQ 2048
#define C_NK 2560
#define C_NV 3072
#define C_NG 3584
#define C_GQ 4096
#define C_GK 4608
#define C_GV 4736
#define C_GG 4864
#define C_M  512

#define WT_IN 0
#define WT_RET (8448 * 1024)
#define WT_NA (WT_RET + 1024 * 512)
#define WT_GQA (WT_NA + 1024 * 512)
#define WT_OUT (WT_GQA + 1024 * 512)
#define WT_TOTAL (WT_OUT + 1024 * 1024)

#define VG(p) ((bf16_t*)((unsigned char*)(p).bar + 4096))
struct Params {
    const float *x, *c, *ctx, *c_ctx, *ada_w, *ada_b, *norm_w, *w_in, *ret_log_decay, *ret_gn_w, *na_rpb, *q_norm_w, *k_norm_w,
        *w_ret_o, *w_na_o, *w_gqa_o, *w_out, *final_norm_w;
    float* out;
    bf16_t* P;
    bf16_t* HX;
    bf16_t* Wt;
    bf16_t* SU;
    float* y;
    float* mod;
    float* rope;
    unsigned* bar;
};

__device__ __forceinline__ int tid_opaque() { int t = threadIdx.x; asm volatile("" : "+v"(t)); return t; }
__device__ __forceinline__ float bf2f(bf16_t v) { return __uint_as_float(((unsigned)v) << 16); }
typedef __bf16 bf16x2_t __attribute__((ext_vector_type(2)));
typedef float f32x2_t __attribute__((ext_vector_type(2)));
__device__ __forceinline__ unsigned pk2(float lo, float hi) {
    f32x2_t v = {lo, hi};
    union { bf16x2_t b; unsigned u; } x; x.b = __builtin_convertvector(v, bf16x2_t); return x.u;
}
__device__ __forceinline__ bf16_t f2bf(float f) { return (bf16_t)(pk2(f, 0.f) & 0xffffu); }
__device__ __forceinline__ float lo16(unsigned u) { return __uint_as_float(u << 16); }
__device__ __forceinline__ float hi16(unsigned u) { return __uint_as_float(u & 0xffff0000u); }
__device__ __forceinline__ float ex2(float x) { return __builtin_amdgcn_exp2f(x); }
__device__ __forceinline__ float silu_f(float x) { return x * __builtin_amdgcn_rcpf(1.f + ex2(-x * LOG2E)); }
__device__ __forceinline__ float sigm_f(float x) { return __builtin_amdgcn_rcpf(1.f + ex2(-x * LOG2E)); }
__device__ __forceinline__ f32x4 mfma16(bf16x8 a, bf16x8 b, f32x4 c) { return __builtin_amdgcn_mfma_f32_16x16x32_bf16(a, b, c, 0, 0, 0); }
__device__ __forceinline__ bf16x8 as_bf(u32x4 u) { union { u32x4 a; bf16x8 b; } x; x.a = u; return x.b; }
__device__ __forceinline__ u32x4 as_u(bf16x8 u) { union { u32x4 a; bf16x8 b; } x; x.b = u; return x.a; }
__device__ __forceinline__ u32x4 ldg16(const bf16_t* p) { return *(const u32x4*)p; }

template <int NI>
__device__ __forceinline__ void gemm_core(f32x4 (&acc)[NI][4], const bf16_t* __restrict__ X, int ldx, const bf16_t* __restrict__ W, int ldw, int K, unsigned char* lds) {
    const int t = tid_opaque(), lane = t & 63, w = t >> 6, wm = w >> 1, wn = w & 1;
    bf16_t* Xs = (bf16_t*)lds;
    bf16_t* Ws = Xs + 2 * 128 * 72;
    const int sr = t >> 3, sc = (t & 7) * 8;
    const bf16_t* xg = X + (size_t)sr * ldx + sc;
    const bf16_t* wg = W + (size_t)sr * ldw + sc;
    u32x4 xr[4], wr[NI];
#pragma unroll
    for (int i = 0; i < 4; ++i) xr[i] = ldg16(xg + (size_t)i * 32 * ldx);
#pragma unroll
    for (int i = 0; i < NI; ++i) wr[i] = ldg16(wg + (size_t)i * 32 * ldw);
    __syncthreads();
#pragma unroll
    for (int i = 0; i < 4; ++i) *(u32x4*)(Xs + (sr + i * 32) * 72 + sc) = xr[i];
#pragma unroll
    for (int i = 0; i < NI; ++i) *(u32x4*)(Ws + (sr + i * 32) * 72 + sc) = wr[i];
    __syncthreads();
    const int nk = K >> 6;
    for (int kt = 0; kt < nk; ++kt) {
        const int cur = kt & 1;
        if (kt + 1 < nk) {
            const int ko = (kt + 1) * 64;
#pragma unroll
            for (int i = 0; i < 4; ++i) xr[i] = ldg16(xg + (size_t)i * 32 * ldx + ko);
#pragma unroll
            for (int i = 0; i < NI; ++i) wr[i] = ldg16(wg + (size_t)i * 32 * ldw + ko);
        }
        __builtin_amdgcn_sched_barrier(0);
        const bf16_t* xs = Xs + cur * 128 * 72 + (wm * 64 + (lane & 15)) * 72 + (lane >> 4) * 8;
        const bf16_t* ws = Ws + cur * 128 * 72 + (wn * (NI * 16) + (lane & 15)) * 72 + (lane >> 4) * 8;
#pragma unroll
        for (int ks = 0; ks < 2; ++ks) {
            bf16x8 xf[4], wf[NI];
#pragma unroll
            for (int i = 0; i < 4; ++i) xf[i] = *(const bf16x8*)(xs + i * 16 * 72 + ks * 32);
#pragma unroll
            for (int i = 0; i < NI; ++i) wf[i] = *(const bf16x8*)(ws + i * 16 * 72 + ks * 32);
#pragma unroll
            for (int ni = 0; ni < NI; ++ni)
#pragma unroll
                for (int mi = 0; mi < 4; ++mi) acc[ni][mi] = mfma16(wf[ni], xf[mi], acc[ni][mi]);
        }
        if (kt + 1 < nk) {
            const int nx = cur ^ 1;
#pragma unroll
            for (int i = 0; i < 4; ++i) *(u32x4*)(Xs + nx * 128 * 72 + (sr + i * 32) * 72 + sc) = xr[i];
#pragma unroll
            for (int i = 0; i < NI; ++i) *(u32x4*)(Ws + nx * 128 * 72 + (sr + i * 32) * 72 + sc) = wr[i];
        }
        __syncthreads();
    }
}

__device__ __forceinline__ void gemm_big(f32x4 (&acc)[4][8], const bf16_t* __restrict__ X, int ldx, const bf16_t* __restrict__ W, int ldw, int K, unsigned char* lds) {
    const int t = tid_opaque(), lane = t & 63, w = t >> 6, wm = w >> 1, wn = w & 1;
    bf16_t* Xs = (bf16_t*)lds;
    bf16_t* Ws = Xs + 2 * 256 * 40;
    const int sr = t >> 2, sc = (t & 3) * 8;
    const bf16_t* xg = X + (size_t)sr * ldx + sc;
    const bf16_t* wg = W + (size_t)sr * ldw + sc;
    u32x4 ra[6], rb[6];
#define GB_LOAD(r, ko) do { _Pragma("unroll") for (int i = 0; i < 4; ++i) r[i] = ldg16(xg + (size_t)i * 64 * ldx + (ko)); _Pragma("unroll") for (int i = 0; i < 2; ++i) r[4 + i] = ldg16(wg + (size_t)i * 64 * ldw + (ko)); } while (0)
#define GB_ST1(r, st, i) do { if ((i) < 4) *(u32x4*)(Xs + (st) * 256 * 40 + (sr + (i) * 64) * 40 + sc) = r[i]; else *(u32x4*)(Ws + (st) * 128 * 40 + (sr + ((i) - 4) * 64) * 40 + sc) = r[i]; } while (0)
#define GB_STEP(st, r, dostore) do { \
        const bf16_t* xs = Xs + (st) * 256 * 40 + (wm * 128 + (lane & 15)) * 40 + (lane >> 4) * 8; \
        const bf16_t* ws = Ws + (st) * 128 * 40 + (wn * 64 + (lane & 15)) * 40 + (lane >> 4) * 8; \
        bf16x8 wf[4]; \
        _Pragma("unroll") for (int i = 0; i < 4; ++i) wf[i] = *(const bf16x8*)(ws + i * 16 * 40); \
        _Pragma("unroll") for (int mi = 0; mi < 8; ++mi) { \
            const bf16x8 xf = *(const bf16x8*)(xs + mi * 16 * 40); \
            _Pragma("unroll") for (int ni = 0; ni < 4; ++ni) acc[ni][mi] = mfma16(wf[ni], xf, acc[ni][mi]); \
            if ((dostore) && mi >= 1 && mi <= 6) GB_ST1(r, (st) ^ 1, mi - 1); } } while (0)
    GB_LOAD(ra, 0);
    GB_LOAD(rb, 32);
    __syncthreads();
#pragma unroll
    for (int i = 0; i < 6; ++i) GB_ST1(ra, 0, i);
    __syncthreads();
    const int nk = K >> 5;
    for (int kt = 0; kt < nk; kt += 2) {
        if (kt + 2 < nk) GB_LOAD(ra, (kt + 2) * 32);
        GB_STEP(0, rb, true);
        __syncthreads();
        if (kt + 3 < nk) GB_LOAD(rb, (kt + 3) * 32);
        GB_STEP(1, ra, kt + 2 < nk);
        __syncthreads();
    }
#undef GB_LOAD
#undef GB_ST1
#undef GB_STEP
}

__device__ void adaln_item(const Params& p, int item, unsigned char* lds) {
    const int t = tid_opaque(), lane = t & 63, w = t >> 6;
    const int l = item / 48, cgp = item % 48, j = cgp * 64 + lane;
    float* cs = (float*)lds;
    float* red = (float*)(lds + 20480);
    __syncthreads();
    for (int idx = t; idx < 5120; idx += 256) {
        const int bb = idx >> 10, k = idx & 1023;
        const float v = bb < 4 ? p.c[bb * 1024 + k] : p.c_ctx[k];
        cs[idx] = silu_f(v);
    }
    __syncthreads();
    float a0 = 0.f, a1 = 0.f, a2 = 0.f, a3 = 0.f, a4 = 0.f;
    const float* aw = p.ada_w + ((size_t)l * 1024 + w * 256) * 3072 + j;
    for (int k = 0; k < 256; ++k) {
        const float wv = aw[(size_t)k * 3072];
        const int kk = w * 256 + k;
        a0 += cs[kk] * wv; a1 += cs[1024 + kk] * wv; a2 += cs[2048 + kk] * wv; a3 += cs[3072 + kk] * wv; a4 += cs[4096 + kk] * wv;
    }
    red[(w * 5 + 0) * 64 + lane] = a0; red[(w * 5 + 1) * 64 + lane] = a1; red[(w * 5 + 2) * 64 + lane] = a2;
    red[(w * 5 + 3) * 64 + lane] = a3; red[(w * 5 + 4) * 64 + lane] = a4;
    __syncthreads();
    for (int idx = t; idx < 320; idx += 256) {
        const int bb = idx >> 6, ln = idx & 63;
        float v = p.ada_b[l * 3072 + cgp * 64 + ln];
#pragma unroll
        for (int ww = 0; ww < 4; ++ww) v += red[(ww * 5 + bb) * 64 + ln];
        p.mod[(l * 5 + bb) * 3072 + cgp * 64 + ln] = v;
    }
}

__device__ void transpose_tile(const float* __restrict__ src, int N, bf16_t* __restrict__ dst, int K, int k0, int n0, unsigned char* lds) {
    const int t = tid_opaque();
    bf16_t* T = (bf16_t*)lds;
    __syncthreads();
#pragma unroll
    for (int i = 0; i < 4; ++i) {
        const int k = (t >> 4) + 16 * i, n4 = (t & 15) * 4;
        const f32x4 v = *(const f32x4*)(src + (size_t)(k0 + k) * N + n0 + n4);
        T[(n4 + 0) * 72 + k] = f2bf(v[0]); T[(n4 + 1) * 72 + k] = f2bf(v[1]); T[(n4 + 2) * 72 + k] = f2bf(v[2]); T[(n4 + 3) * 72 + k] = f2bf(v[3]);
    }
    __syncthreads();
#pragma unroll
    for (int i = 0; i < 2; ++i) {
        const int cidx = t + 256 * i, n = cidx >> 3, kc = cidx & 7;
        *(u32x4*)(dst + (size_t)(n0 + n) * K + k0 + kc * 8) = *(const u32x4*)(T + n * 72 + kc * 8);
    }
}

#define NCONV_ITEMS (2112 + 3 * 128 + 256)
__device__ void convert_item(const Params& p, int l, int item, unsigned char* lds) {
    if (item < 2112) {
        const int kt = item / 132, nt = item % 132;
        transpose_tile(p.w_in + (size_t)l * 1024 * INC, INC, p.Wt + WT_IN, 1024, kt * 64, nt * 64, lds);
    } else if (item < 2112 + 384) {
        const int it = item - 2112, which = it / 128, r = it % 128, kt = r / 16, nt = r % 16;
        const float* src = (which == 0 ? p.w_ret_o : which == 1 ? p.w_na_o : p.w_gqa_o) + (size_t)l * 512 * 1024;
        bf16_t* dst = p.Wt + (which == 0 ? WT_RET : which == 1 ? WT_NA : WT_GQA);
        transpose_tile(src, 1024, dst, 512, kt * 64, nt * 64, lds);
    } else {
        const int it = item - 2112 - 384, kt = it / 16, nt = it % 16;
        transpose_tile(p.w_out + (size_t)l * 1024 * 1024, 1024, p.Wt + WT_OUT, 1024, kt * 64, nt * 64, lds);
    }
}

__device__ void rope_table(const Params& p) {
    for (int idx = tid_opaque(); idx < 2048; idx += 256) {
        const int pos = idx >> 4, i = idx & 15;
        const float f = ex2(-(float)i * (13.287712379549449f / 16.f));
        const float ang = (float)pos * f;
        float rev = ang * 0.15915494309189535f;
        rev = rev - rintf(rev);
        p.rope[idx * 2 + 0] = __builtin_amdgcn_cosf(rev);
        p.rope[idx * 2 + 1] = __builtin_amdgcn_sinf(rev);
    }
}

__device__ void phase_p0(const Params& p, unsigned char* lds) {
    const int total = 192 + NCONV_ITEMS + 1;
    for (int item = blockIdx.x; item < total; item += gridDim.x) {
        if (item < 192) adaln_item(p, item, lds);
        else if (item < 192 + NCONV_ITEMS) convert_item(p, 0, item - 192, lds);
        else rope_table(p);
    }
}

__device__ void norm_rows(const Params& p, int lnext, const float* xsrc, const float* ysrc) {
    const int t = tid_opaque(), lane = t & 63, w = t >> 6;
    const int nrows = lnext < 4 ? NROWS : NTOK;
    for (int row = blockIdx.x * 4 + w; row < nrows; row += gridDim.x * 4) {
        const float* src = row < NTOK ? xsrc + (size_t)row * DM : ysrc + (size_t)(row - NTOK) * DM;
        f32x4 v[4];
        float ss = 0.f;
#pragma unroll
        for (int i = 0; i < 4; ++i) { v[i] = *(const f32x4*)(src + i * 256 + lane * 4); ss += v[i][0] * v[i][0] + v[i][1] * v[i][1] + v[i][2] * v[i][2] + v[i][3] * v[i][3]; }
#pragma unroll
        for (int o = 32; o >= 1; o >>= 1) ss += __shfl_xor(ss, o);
        const float rstd = rsqrtf(ss * (1.f / 1024.f) + EPSN);
        if (lnext < 4) {
            const int bb = row < NTOK ? (row >> 13) : 4;
            const float* md = p.mod + (size_t)(lnext * 5 + bb) * 3072;
            const float* nw = p.norm_w + lnext * 1024;
#pragma unroll
            for (int i = 0; i < 4; ++i) {
                const int col = i * 256 + lane * 4;
                const f32x4 nwv = *(const f32x4*)(nw + col), sh = *(const f32x4*)(md + col), scl = *(const f32x4*)(md + 1024 + col);
                f32x4 h = v[i] * rstd * nwv * (scl + 1.f) + sh;
                u32x2 o2; o2.x = pk2(h[0], h[1]); o2.y = pk2(h[2], h[3]);
                *(u32x2*)(p.HX + (size_t)row * DM + col) = o2;
            }
        } else {
#pragma unroll
            for (int i = 0; i < 4; ++i) {
                const int col = i * 256 + lane * 4;
                const f32x4 nwv = *(const f32x4*)(p.final_norm_w + col);
                f32x4 ov = v[i] * rstd * nwv;
                *(f32x4*)(p.out + (size_t)row * DM + col) = ov;
            }
        }
    }
}

__device__ void phase_a(const Params& p, int l, unsigned char* lds) {
    const int t = tid_opaque(), lane = t & 63, w = t >> 6, wm = w >> 1, wn = w & 1;
    const int total = 132 * 42;
    const bool xmap = (gridDim.x & 7) == 0;
    const int per = xmap ? (total + 7) / 8 : total;
    const int lo = xmap ? (int)(blockIdx.x & 7) * per : 0, hi = min(lo + per, total);
    const int step = xmap ? (int)(gridDim.x >> 3) : (int)gridDim.x;
    for (int idx = lo + (xmap ? (int)(blockIdx.x >> 3) : (int)blockIdx.x); idx < hi; idx += step) {
        const int nb = idx / 924, rem = idx - nb * 924;
        const int mt = rem / 7, nt = nb * 7 + (rem - mt * 7);
        f32x4 acc[4][8];
#pragma unroll
        for (int a = 0; a < 4; ++a)
#pragma unroll
            for (int b = 0; b < 8; ++b) acc[a][b] = (f32x4){0.f, 0.f, 0.f, 0.f};
        gemm_big(acc, p.HX + (size_t)mt * 256 * DM, DM, p.Wt + WT_IN + (size_t)nt * 128 * DM, DM, DM, lds);
#pragma unroll
        for (int ni = 0; ni < 4; ++ni)
#pragma unroll
            for (int mi = 0; mi < 8; ++mi) {
                const int n = nt * 128 + wn * 64 + ni * 16 + (lane >> 4) * 4, m = mt * 256 + wm * 128 + mi * 16 + (lane & 15);
                u32x2 o2; o2.x = pk2(acc[ni][mi][0], acc[ni][mi][1]); o2.y = pk2(acc[ni][mi][2], acc[ni][mi][3]);
                *(u32x2*)(p.P + (size_t)m * PC + n) = o2;
            }
    }
}

__device__ __forceinline__ int chunk_row(int b, int cidx) { return cidx < 64 ? b * 8192 + cidx * 128 : NTOK + b * 256 + (cidx - 64) * 128; }

__device__ void ret_state_item(const Params& p, int l, int b, int h, int cidx, unsigned char* lds) {
    const int t = tid_opaque(), lane = t & 63, w = t >> 6, g = lane >> 4, c = lane & 15;
    bf16_t* Ktf = (bf16_t*)lds;
    bf16_t* Vt = Ktf + 128 * 72;
    const float lgf = -__expf(p.ret_log_decay[l * 8 + h]) * LOG2E, lgb = -__expf(p.ret_log_decay[l * 8 + 4 + h]) * LOG2E;
    const float ksc = 0.08838834764831845f;
    const int rowbase = chunk_row(b, cidx);
    for (int dir = 0; dir < 2; ++dir) {
        f32x4 acc[2][8];
#pragma unroll
        for (int i = 0; i < 2; ++i)
#pragma unroll
            for (int d = 0; d < 8; ++d) acc[i][d] = (f32x4){0.f, 0.f, 0.f, 0.f};
        const float lg = dir ? lgb : lgf;
#pragma unroll 1
        for (int half = 0; half < 2; ++half) {
            __syncthreads();
#pragma unroll
            for (int i = 0; i < 4; ++i) {
                const int cc = t + 256 * i, tok = cc & 63, dch = cc >> 6, j = half * 64 + tok;
                const float wgt = ex2(lg * (float)(dir ? j : 127 - j)) * ksc;
                const bf16_t* rp = p.P + (size_t)(rowbase + j) * PC + h * 128 + dch * 8;
                const u32x4 kv = ldg16(rp + C_RK), vv = ldg16(rp + C_RV);
#pragma unroll
                for (int e = 0; e < 4; ++e) {
                    const int r0 = (dch * 8 + 2 * e) * 72 + tok, r1 = r0 + 72;
                    Ktf[r0] = f2bf(lo16(kv[e]) * wgt); Ktf[r1] = f2bf(hi16(kv[e]) * wgt);
                    Vt[r0] = (bf16_t)(vv[e] & 0xffffu); Vt[r1] = (bf16_t)(vv[e] >> 16);
                }
            }
            __syncthreads();
#pragma unroll
            for (int ks = 0; ks < 2; ++ks) {
                bf16x8 kf[2];
#pragma unroll
                for (int i = 0; i < 2; ++i) kf[i] = *(const bf16x8*)(Ktf + (w * 32 + i * 16 + c) * 72 + ks * 32 + g * 8);
#pragma unroll
                for (int d = 0; d < 8; ++d) {
                    const bf16x8 vf = *(const bf16x8*)(Vt + (d * 16 + c) * 72 + ks * 32 + g * 8);
#pragma unroll
                    for (int i = 0; i < 2; ++i) acc[i][d] = mfma16(kf[i], vf, acc[i][d]);
                }
            }
        }
        bf16_t* Sd = p.SU + ((size_t)((dir * 4 + b) * 4 + h) * 66 + cidx) * 16384;
#pragma unroll
        for (int i = 0; i < 2; ++i)
#pragma unroll
            for (int d = 0; d < 8; ++d) {
                const int dk = w * 32 + i * 16 + g * 4, dv = d * 16 + c;
                u32x2 o2; o2.x = pk2(acc[i][d][0], acc[i][d][1]); o2.y = pk2(acc[i][d][2], acc[i][d][3]);
                *(u32x2*)(Sd + dv * 128 + dk) = o2;
            }
    }
}

__device__ void qk_prep_item(const Params& p, int l, int item) {
    const int t = tid_opaque(), tok = t >> 2, sub = t & 3;
    const int row = item * 64 + tok;
    const bool lat = row < NTOK;
    const int tseq = row & 8191, pr = tseq >> 6, pc = tseq & 63;
    for (int hv = sub; hv < 10; hv += 4) {
        bf16_t* ptr = p.P + (size_t)row * PC + (hv < 8 ? C_GQ + hv * 64 : C_GK + (hv - 8) * 64);
        const float* nw = hv < 8 ? p.q_norm_w + l * 64 : p.k_norm_w + l * 64;
        float x[64];
        float ss = 0.f;
#pragma unroll
        for (int i = 0; i < 8; ++i) {
            const u32x4 u = ldg16(ptr + i * 8);
#pragma unroll
            for (int e = 0; e < 4; ++e) { x[i * 8 + 2 * e] = lo16(u[e]); x[i * 8 + 2 * e + 1] = hi16(u[e]); }
        }
#pragma unroll
        for (int d = 0; d < 64; ++d) ss += x[d] * x[d];
        const float rstd = rsqrtf(ss * (1.f / 64.f) + EPSN);
#pragma unroll
        for (int d = 0; d < 64; ++d) x[d] = x[d] * rstd * nw[d];
        if (lat) {
#pragma unroll
            for (int i = 0; i < 16; ++i) {
                const float cr = p.rope[(pr * 16 + i) * 2], sr = p.rope[(pr * 16 + i) * 2 + 1];
                const float cc = p.rope[(pc * 16 + i) * 2], sc = p.rope[(pc * 16 + i) * 2 + 1];
                const float a = x[i], b2 = x[16 + i], a2 = x[32 + i], b3 = x[48 + i];
                x[i] = a * cr - b2 * sr; x[16 + i] = b2 * cr + a * sr;
                x[32 + i] = a2 * cc - b3 * sc; x[48 + i] = b3 * cc + a2 * sc;
            }
        }
#pragma unroll
        for (int i = 0; i < 8; ++i) {
            u32x4 u;
#pragma unroll
            for (int e = 0; e < 4; ++e) u[e] = pk2(x[i * 8 + 2 * e], x[i * 8 + 2 * e + 1]);
            *(u32x4*)(ptr + i * 8) = u;
        }
    }
    {
        const int b = lat ? (row >> 13) : ((row - NTOK) >> 8);
        const int key = lat ? tseq : 8192 + ((row - NTOK) & 255);
        const bf16_t* vp = p.P + (size_t)row * PC + C_GV + sub * 32;
        bf16_t* dst = VG(p) + ((size_t)(b * 2 + (sub >> 1)) * 64 + (sub & 1) * 32) * 8448 + key;
#pragma unroll
        for (int i = 0; i < 4; ++i) {
            const u32x4 u = ldg16(vp + i * 8);
#pragma unroll
            for (int e = 0; e < 4; ++e) {
                dst[(size_t)(i * 8 + 2 * e) * 8448] = (bf16_t)(u[e] & 0xffffu);
                dst[(size_t)(i * 8 + 2 * e + 1) * 8448] = (bf16_t)(u[e] >> 16);
            }
        }
    }
}

__device__ void phase_b(const Params& p, int l, unsigned char* lds) {
    const int total = 1056 + 528;
    for (int item = blockIdx.x; item < total; item += gridDim.x) {
        if (item < 1056) { const int cidx = item % 66, bh = item / 66; ret_state_item(p, l, bh >> 2, bh & 3, cidx, lds);
        }
        else qk_prep_item(p, l, item - 1056);
    }
}

__device__ void phase_c(const Params& p, int l, bool dostore = true) {
    const int t = tid_opaque();
    for (int item = blockIdx.x; item < 256; item += gridDim.x) {
        const int part = item & 7, dbh = item >> 3, dir = dbh >> 4, h = dbh & 3;
        const float lg = -__expf(p.ret_log_decay[l * 8 + dir * 4 + h]) * LOG2E;
        const float gc = ex2(lg * 128.f);
        bf16_t* base = p.SU + (size_t)dbh * 66 * 16384 + part * 2048 + t * 8;
        float s[8];
#pragma unroll
        for (int e = 0; e < 8; ++e) s[e] = 0.f;
        for (int st0 = 0; st0 < 66; st0 += 11) {
            u32x4 u[11];
#pragma unroll
            for (int q = 0; q < 11; ++q) {
                const int st = st0 + q;
                const int n = dir == 0 ? (st < 2 ? 64 + st : st - 2) : (st < 2 ? 65 - st : 65 - st);
                u[q] = *(const u32x4*)(base + (size_t)n * 16384);
            }
#pragma unroll
            for (int q = 0; q < 11; ++q) {
                const int st = st0 + q;
                const int n = dir == 0 ? (st < 2 ? 64 + st : st - 2) : (st < 2 ? 65 - st : 65 - st);
                u32x4 o;
#pragma unroll
                for (int e = 0; e < 4; ++e) o[e] = pk2(s[2 * e], s[2 * e + 1]);
                if (dostore) *(u32x4*)(base + (size_t)n * 16384) = o;
#pragma unroll
                for (int e = 0; e < 4; ++e) { s[2 * e] = gc * s[2 * e] + lo16(u[q][e]); s[2 * e + 1] = gc * s[2 * e + 1] + hi16(u[q][e]); }
            }
        }
    }
}

template <int MODE>
__device__ void attn_item(const Params& p, int l, int b, int i1, int i2, int i3, unsigned char* lds, bool dostore = true) {
    constexpr int NQB = (MODE == 2) ? 2 : 4, NHQ = NQB / 2;
    const int t = tid_opaque(), lane = t & 63, w = t >> 6, g = lane >> 4, c = lane & 15;
    bf16_t* Ks = (bf16_t*)lds;
    bf16_t* Vt = Ks + 2 * 64 * 72;
    u32x4* Qs = (u32x4*)(lds + 36864) + w * 512;
    float* rpbs = (float*)(lds + 36864 + 32768);
    int qbase, qstep, qcol, kcol, vcol, gcol, ntiles;
    int R0 = 0, c0 = 0, start = 0, bstart = 0, hh = 0;
    if (MODE == 0 || MODE == 1) {
        const int kvh = i1, qt = i2, head = kvh * 4 + w;
        qbase = (MODE == 0 ? b * 8192 : NTOK + b * 256) + qt * 64; qstep = 16;
        qcol = C_GQ + head * 64; kcol = C_GK + kvh * 64; vcol = C_GV + kvh * 64; gcol = C_GG + head * 64;
        ntiles = MODE == 0 ? 132 : 4;
    } else if (MODE == 2) {
        hh = i1; R0 = i2 * 8; c0 = i3 * 16;
        start = min(max(R0 - 4, 0), 112); bstart = min(max(c0 - 8, 0), 32);
        qbase = b * 8192 + (R0 + w * 2) * 64 + c0; qstep = 64;
        qcol = C_NQ + hh * 64; kcol = C_NK + hh * 64; vcol = C_NV + hh * 64; gcol = C_NG + hh * 64;
        ntiles = 12;
    } else {
        hh = i1;
        qbase = NTOK + b * 256 + w * 64; qstep = 16;
        qcol = C_NQ + hh * 64; kcol = C_NK + hh * 64; vcol = C_NV + hh * 64; gcol = C_NG + hh * 64;
        ntiles = 4;
    }
    const float scale = 0.125f * LOG2E;
    f32x4 o[NQB][4];
    float mrun[NQB], lsum[NQB];
#pragma unroll
    for (int qb = 0; qb < NQB; ++qb) {
        mrun[qb] = -INFINITY; lsum[qb] = 0.f;
#pragma unroll
        for (int d = 0; d < 4; ++d) o[qb][d] = (f32x4){0.f, 0.f, 0.f, 0.f};
    }
    const int kkey = t >> 3, kch = (t & 7) * 8;
    const int vkey = t & 63, vch = (t >> 6);
    u32x4 kr[2], vr[2];
    auto load_tile = [&](int tt) {
        int base, rstep;
        if (MODE == 0) { base = tt < 128 ? b * 8192 + tt * 64 : NTOK + b * 256 + (tt - 128) * 64; rstep = 32; }
        else if (MODE == 2) {
            if (tt < 4) { base = NTOK + b * 256 + tt * 64; rstep = 32; }
            else { base = b * 8192 + (start + 2 * (tt - 4)) * 64 + bstart; rstep = 64; }
        } else { base = NTOK + b * 256 + tt * 64; rstep = 32; }
#pragma unroll
        for (int i = 0; i < 2; ++i) {
            const int key = kkey + 32 * i;
            kr[i] = ldg16(p.P + (size_t)(base + (key >> 5) * rstep + (key & 31)) * PC + kcol + kch);
            if (MODE <= 1) vr[i] = ldg16(VG(p) + ((size_t)(b * 2 + i1) * 64 + kkey + 32 * i) * 8448 + (MODE == 0 ? tt * 64 : 8192 + tt * 64) + kch);
            else vr[i] = ldg16(p.P + (size_t)(base + (vkey >> 5) * rstep + (vkey & 31)) * PC + vcol + (vch + 4 * i) * 8);
        }
    };
    auto store_tile = [&](int buf) {
        bf16_t* ks_ = Ks + buf * 64 * 72; bf16_t* vt_ = Vt + buf * 64 * 72;
#pragma unroll
        for (int i = 0; i < 2; ++i) {
            *(u32x4*)(ks_ + (kkey + 32 * i) * 72 + kch) = kr[i];
            if (MODE <= 1) { *(u32x4*)(vt_ + (kkey + 32 * i) * 72 + kch) = vr[i]; continue; }
#pragma unroll
            for (int e = 0; e < 4; ++e) {
                const int d = (vch + 4 * i) * 8 + 2 * e;
                vt_[d * 72 + vkey] = (bf16_t)(vr[i][e] & 0xffffu);
                vt_[(d + 1) * 72 + vkey] = (bf16_t)(vr[i][e] >> 16);
            }
        }
    };
    load_tile(0);
    __syncthreads();
#pragma unroll
    for (int qb = 0; qb < NQB; ++qb)
#pragma unroll
        for (int ks = 0; ks < 2; ++ks) Qs[(qb * 2 + ks) * 64 + lane] = ldg16(p.P + (size_t)(qbase + qb * qstep + c) * PC + qcol + ks * 32 + g * 8);
    if (MODE == 2) for (int idx = t; idx < 465; idx += 256) rpbs[idx] = p.na_rpb[((size_t)l * 8 + hh) * 465 + idx] * LOG2E;
    store_tile(0);
    __syncthreads();
    const int wlo = min(max(R0 + w * 2 - 4, 0), 120), whi = min(max(R0 + w * 2 + 1 - 4, 0), 120) + 7;
    int colterm[8];
    if (MODE == 2) {
        const int qc = c0 + c, cs = min(max(qc - 8, 0), 48);
#pragma unroll
        for (int j = 0; j < 8; ++j) {
            const int kc = bstart + (j >> 2) * 16 + g * 4 + (j & 3);
            colterm[j] = ((unsigned)(kc - cs) < 16u) ? (kc - qc + 15) : -1;
        }
    }
    for (int tt = 0; tt < ntiles; ++tt) {
        const int cur = tt & 1;
        if (tt + 1 < ntiles) load_tile(tt + 1);
        bool skip = false;
        int krow0 = 0;
        if (MODE == 2 && tt >= 4) { krow0 = start + 2 * (tt - 4); skip = (krow0 + 1 < wlo) || (krow0 > whi); }
        if (!skip) {
            const bf16_t* ks_ = Ks + cur * 64 * 72; const bf16_t* vt_ = Vt + cur * 64 * 72;
            f32x4 s[NQB][4];
#pragma unroll
            for (int qq = 0; qq < NQB; ++qq)
#pragma unroll
                for (int kb = 0; kb < 4; ++kb) s[qq][kb] = (f32x4){0.f, 0.f, 0.f, 0.f};
#pragma unroll
            for (int ks = 0; ks < 2; ++ks) {
                bf16x8 qv[NQB];
#pragma unroll
                for (int qq = 0; qq < NQB; ++qq) qv[qq] = as_bf(Qs[(qq * 2 + ks) * 64 + lane]);
#pragma unroll
                for (int kb = 0; kb < 4; ++kb) {
                    const bf16x8 kf = *(const bf16x8*)(ks_ + (kb * 16 + c) * 72 + ks * 32 + g * 8);
#pragma unroll
                    for (int qq = 0; qq < NQB; ++qq) s[qq][kb] = mfma16(kf, qv[qq], s[qq][kb]);
                }
            }
            __builtin_amdgcn_sched_barrier(0);
            bf16x8 pf[NQB][2];
#pragma unroll
            for (int qq = 0; qq < NQB; ++qq) {
                const int qb = qq;
                if (MODE == 2 && tt >= 4) {
                    const int qrow = R0 + w * 2 + qb;
                    const int rs = min(max(qrow - 4, 0), 120);
#pragma unroll
                    for (int kb = 0; kb < 4; ++kb) {
                        const int krow = krow0 + (kb >> 1);
                        const bool rowok = (unsigned)(krow - rs) < 8u;
                        const int ridx = (krow - qrow + 7) * 31;
#pragma unroll
                        for (int r = 0; r < 4; ++r) {
                            const int ct = colterm[(kb & 1) * 4 + r];
                            const bool valid = rowok && ct >= 0;
                            const float bias = rpbs[valid ? ridx + ct : 0];
                            s[qq][kb][r] = valid ? s[qq][kb][r] * scale + bias : -INFINITY;
                        }
                    }
                }
                const bool raw = !(MODE == 2 && tt >= 4);
                float tmax = fmaxf(fmaxf(s[qq][0][0], s[qq][0][1]), fmaxf(s[qq][0][2], s[qq][0][3]));
#pragma unroll
                for (int kb = 1; kb < 4; ++kb) tmax = fmaxf(tmax, fmaxf(fmaxf(s[qq][kb][0], s[qq][kb][1]), fmaxf(s[qq][kb][2], s[qq][kb][3])));
                tmax = fmaxf(tmax, __shfl_xor(tmax, 16)); tmax = fmaxf(tmax, __shfl_xor(tmax, 32));
                const float mn = fmaxf(mrun[qb], raw ? tmax * scale : tmax);
                const float alpha = ex2(mrun[qb] - mn);
                mrun[qb] = mn;
                float psum = 0.f;
#pragma unroll
                for (int kb = 0; kb < 4; ++kb)
#pragma unroll
                    for (int r = 0; r < 4; ++r) { const float pv = raw ? ex2(__builtin_fmaf(s[qq][kb][r], scale, -mn)) : ex2(s[qq][kb][r] - mn); s[qq][kb][r] = pv; psum += pv; }
                lsum[qb] = lsum[qb] * alpha + psum;
                if (__builtin_amdgcn_ballot_w64(alpha != 1.f) != 0ull) {
#pragma unroll
                    for (int d = 0; d < 4; ++d) o[qb][d] = o[qb][d] * alpha;
                }
#pragma unroll
                for (int kk = 0; kk < 2; ++kk) {
                    u32x4 u;
                    u[0] = pk2(s[qq][2 * kk][0], s[qq][2 * kk][1]); u[1] = pk2(s[qq][2 * kk][2], s[qq][2 * kk][3]);
                    u[2] = pk2(s[qq][2 * kk + 1][0], s[qq][2 * kk + 1][1]); u[3] = pk2(s[qq][2 * kk + 1][2], s[qq][2 * kk + 1][3]);
                    pf[qq][kk] = as_bf(u);
                }
            }
            __builtin_amdgcn_sched_barrier(0);
#pragma unroll
            for (int kk = 0; kk < 2; ++kk)
#pragma unroll
                for (int d = 0; d < 4; ++d) {
                    const u32x2 vlo = *(const u32x2*)(vt_ + (d * 16 + c) * 72 + kk * 32 + g * 4);
                    const u32x2 vhi = *(const u32x2*)(vt_ + (d * 16 + c) * 72 + kk * 32 + 16 + g * 4);
                    u32x4 vv; vv[0] = vlo[0]; vv[1] = vlo[1]; vv[2] = vhi[0]; vv[3] = vhi[1];
                    const bf16x8 vf = as_bf(vv);
#pragma unroll
                    for (int qq = 0; qq < NQB; ++qq) o[qq][d] = mfma16(vf, pf[qq][kk], o[qq][d]);
                }
        }
        if (tt + 1 < ntiles) store_tile(cur ^ 1);
        __syncthreads();
    }
    if (dostore)
#pragma unroll
    for (int qb = 0; qb < NQB; ++qb) {
        float ls = lsum[qb];
        ls += __shfl_xor(ls, 16); ls += __shfl_xor(ls, 32);
        const float inv = __builtin_amdgcn_rcpf(ls);
        bf16_t* rowp = p.P + (size_t)(qbase + qb * qstep + c) * PC;
#pragma unroll
        for (int d = 0; d < 4; ++d) {
            const int dd = d * 16 + g * 4;
            const u32x2 gt = *(const u32x2*)(rowp + gcol + dd);
            const float v0 = o[qb][d][0] * inv * silu_f(lo16(gt[0])), v1 = o[qb][d][1] * inv * silu_f(hi16(gt[0]));
            const float v2 = o[qb][d][2] * inv * silu_f(lo16(gt[1])), v3 = o[qb][d][3] * inv * silu_f(hi16(gt[1]));
            u32x2 o2; o2.x = pk2(v0, v1); o2.y = pk2(v2, v3);
            *(u32x2*)(rowp + qcol + dd) = o2;
        }
    }
}

typedef float f32x16 __attribute__((ext_vector_type(16)));
__device__ __forceinline__ f32x16 mfma32(bf16x8 a, bf16x8 b, f32x16 c) { return __builtin_amdgcn_mfma_f32_32x32x16_bf16(a, b, c, 0, 0, 0); }

template <int MODE, bool FIXM>
__device__ void attn_item32(const Params& p, int l, int b, int i1, int i2, unsigned char* lds, float mfix, bool dostore = true) {
    const int t = tid_opaque(), lane = t & 63, w = t >> 6, h = lane >> 5, c = lane & 31;
    bf16_t* Ks = (bf16_t*)lds;
    bf16_t* Vt = Ks + 2 * 64 * 72;
    u32x4* Qs = (u32x4*)(lds + 36864) + w * 512;
    int qbase, qcol, kcol, vcol, gcol, ntiles;
    if (MODE == 0 || MODE == 1) {
        const int kvh = i1, qt = i2, head = kvh * 4 + w;
        qbase = (MODE == 0 ? b * 8192 : NTOK + b * 256) + qt * 64;
        qcol = C_GQ + head * 64; kcol = C_GK + kvh * 64; vcol = C_GV + kvh * 64; gcol = C_GG + head * 64;
        ntiles = MODE == 0 ? 132 : 4;
    } else {
        const int hh = i1;
        qbase = NTOK + b * 256 + w * 64;
        qcol = C_NQ + hh * 64; kcol = C_NK + hh * 64; vcol = C_NV + hh * 64; gcol = C_NG + hh * 64;
        ntiles = 4;
    }
    const float scale = 0.125f * LOG2E;
    f32x16 o[2][2];
    float mrun[2], lsum[2];
#pragma unroll
    for (int qb = 0; qb < 2; ++qb) {
        mrun[qb] = -INFINITY; lsum[qb] = 0.f;
#pragma unroll
        for (int d = 0; d < 2; ++d)
#pragma unroll
            for (int r = 0; r < 16; ++r) o[qb][d][r] = 0.f;
    }
    const int kkey = t >> 3, kch = (t & 7) * 8;
    const int vkey = t & 63, vch = (t >> 6);
    u32x4 kr[2], vr[2];
    auto load_tile = [&](int tt) {
        const int base = MODE == 0 ? (tt < 128 ? b * 8192 + tt * 64 : NTOK + b * 256 + (tt - 128) * 64) : NTOK + b * 256 + tt * 64;
#pragma unroll
        for (int i = 0; i < 2; ++i) {
            kr[i] = ldg16(p.P + (size_t)(base + kkey + 32 * i) * PC + kcol + kch);
            if (MODE <= 1) vr[i] = ldg16(VG(p) + ((size_t)(b * 2 + i1) * 64 + kkey + 32 * i) * 8448 + (MODE == 0 ? tt * 64 : 8192 + tt * 64) + kch);
            else vr[i] = ldg16(p.P + (size_t)(base + vkey) * PC + vcol + (vch + 4 * i) * 8);
        }
    };
    auto store_tile = [&](int buf) {
        bf16_t* ks_ = Ks + buf * 64 * 72; bf16_t* vt_ = Vt + buf * 64 * 72;
#pragma unroll
        for (int i = 0; i < 2; ++i) {
            *(u32x4*)(ks_ + (kkey + 32 * i) * 72 + kch) = kr[i];
            if (MODE <= 1) { *(u32x4*)(vt_ + (kkey + 32 * i) * 72 + kch) = vr[i]; continue; }
#pragma unroll
            for (int e = 0; e < 4; ++e) {
                const int d = (vch + 4 * i) * 8 + 2 * e;
                vt_[d * 72 + vkey] = (bf16_t)(vr[i][e] & 0xffffu);
                vt_[(d + 1) * 72 + vkey] = (bf16_t)(vr[i][e] >> 16);
            }
        }
    };
    load_tile(0);
    __syncthreads();
#pragma unroll
    for (int qb = 0; qb < 2; ++qb)
#pragma unroll
        for (int ks = 0; ks < 4; ++ks) Qs[(qb * 4 + ks) * 64 + lane] = ldg16(p.P + (size_t)(qbase + qb * 32 + c) * PC + qcol + ks * 16 + h * 8);
    store_tile(0);
    __syncthreads();
    for (int tt = 0; tt < ntiles; ++tt) {
        const int cur = tt & 1;
        if (tt + 1 < ntiles) load_tile(tt + 1);
        const bf16_t* ks_ = Ks + cur * 64 * 72; const bf16_t* vt_ = Vt + cur * 64 * 72;
        f32x16 s[2][2];
#pragma unroll
        for (int qb = 0; qb < 2; ++qb)
#pragma unroll
            for (int kb = 0; kb < 2; ++kb)
#pragma unroll
                for (int r = 0; r < 16; ++r) s[qb][kb][r] = 0.f;
#pragma unroll
        for (int ks = 0; ks < 4; ++ks) {
            const bf16x8 q0 = as_bf(Qs[ks * 64 + lane]), q1 = as_bf(Qs[(4 + ks) * 64 + lane]);
#pragma unroll
            for (int kb = 0; kb < 2; ++kb) {
                const bf16x8 kf = *(const bf16x8*)(ks_ + (kb * 32 + c) * 72 + ks * 16 + h * 8);
                s[0][kb] = mfma32(kf, q0, s[0][kb]);
                s[1][kb] = mfma32(kf, q1, s[1][kb]);
            }
        }
        bf16x8 pf[2][4];
#pragma unroll
        for (int qb = 0; qb < 2; ++qb) {
            float psum = 0.f;
            if (FIXM) {
#pragma unroll
                for (int kb = 0; kb < 2; ++kb)
#pragma unroll
                    for (int r = 0; r < 16; ++r) { const float pv = ex2(__builtin_fmaf(s[qb][kb][r], scale, -mfix)); s[qb][kb][r] = pv; psum += pv; }
                lsum[qb] += psum;
            } else {
                float tmax = s[qb][0][0];
#pragma unroll
                for (int kb = 0; kb < 2; ++kb)
#pragma unroll
                    for (int r = 0; r < 16; r += 4) tmax = fmaxf(tmax, fmaxf(fmaxf(s[qb][kb][r], s[qb][kb][r + 1]), fmaxf(s[qb][kb][r + 2], s[qb][kb][r + 3])));
                tmax = fmaxf(tmax, __shfl_xor(tmax, 32));
                const float mn = fmaxf(mrun[qb], tmax * scale);
                const float alpha = ex2(mrun[qb] - mn);
                mrun[qb] = mn;
#pragma unroll
                for (int kb = 0; kb < 2; ++kb)
#pragma unroll
                    for (int r = 0; r < 16; ++r) { const float pv = ex2(__builtin_fmaf(s[qb][kb][r], scale, -mn)); s[qb][kb][r] = pv; psum += pv; }
                lsum[qb] = lsum[qb] * alpha + psum;
                if (__builtin_amdgcn_ballot_w64(alpha != 1.f) != 0ull) {
#pragma unroll
                    for (int d = 0; d < 2; ++d)
#pragma unroll
                        for (int r = 0; r < 16; ++r) o[qb][d][r] *= alpha;
                }
            }
#pragma unroll
            for (int kb = 0; kb < 2; ++kb)
#pragma unroll
                for (int st = 0; st < 2; ++st) {
                    u32x4 u;
#pragma unroll
                    for (int e = 0; e < 4; ++e) u[e] = pk2(s[qb][kb][8 * st + 2 * e], s[qb][kb][8 * st + 2 * e + 1]);
                    pf[qb][kb * 2 + st] = as_bf(u);
                }
        }
#pragma unroll
        for (int kk = 0; kk < 4; ++kk)
#pragma unroll
            for (int d = 0; d < 2; ++d) {
                const u32x2 vlo = *(const u32x2*)(vt_ + (d * 32 + c) * 72 + kk * 16 + h * 4);
                const u32x2 vhi = *(const u32x2*)(vt_ + (d * 32 + c) * 72 + kk * 16 + 8 + h * 4);
                u32x4 vv; vv[0] = vlo[0]; vv[1] = vlo[1]; vv[2] = vhi[0]; vv[3] = vhi[1];
                const bf16x8 vf = as_bf(vv);
                o[0][d] = mfma32(vf, pf[0][kk], o[0][d]);
                o[1][d] = mfma32(vf, pf[1][kk], o[1][d]);
            }
        if (tt + 1 < ntiles) store_tile(cur ^ 1);
        __syncthreads();
    }
    if (dostore)
#pragma unroll
    for (int qb = 0; qb < 2; ++qb) {
        float ls = lsum[qb];
        ls += __shfl_xor(ls, 32);
        const float inv = __builtin_amdgcn_rcpf(ls);
        bf16_t* rowp = p.P + (size_t)(qbase + qb * 32 + c) * PC;
#pragma unroll
        for (int d = 0; d < 2; ++d)
#pragma unroll
            for (int rg = 0; rg < 4; ++rg) {
                const int dd = d * 32 + rg * 8 + h * 4;
                const u32x2 gt = *(const u32x2*)(rowp + gcol + dd);
                const float v0 = o[qb][d][rg * 4 + 0] * inv * silu_f(lo16(gt[0])), v1 = o[qb][d][rg * 4 + 1] * inv * silu_f(hi16(gt[0]));
                const float v2 = o[qb][d][rg * 4 + 2] * inv * silu_f(lo16(gt[1])), v3 = o[qb][d][rg * 4 + 3] * inv * silu_f(hi16(gt[1]));
                u32x2 o2; o2.x = pk2(v0, v1); o2.y = pk2(v2, v3);
                *(u32x2*)(rowp + qcol + dd) = o2;
            }
    }
}

__device__ __forceinline__ bf16x8 scale_frag(bf16x8 f, float sc) {
    u32x4 u = as_u(f), r;
#pragma unroll
    for (int e = 0; e < 4; ++e) r[e] = pk2(lo16(u[e]) * sc, hi16(u[e]) * sc);
    return as_bf(r);
}

__device__ void ret_item(const Params& p, int l, int b, int h, int cidx, int hf, unsigned char* lds, bool dostore = true) {
    const int t = tid_opaque(), lane = t & 63, w = t >> 6, g = lane >> 4, c = lane & 15;
    bf16_t* B0 = (bf16_t*)lds;
    bf16_t* B1 = B0 + 128 * 136;
    const float lgf = -__expf(p.ret_log_decay[l * 8 + h]) * LOG2E, lgb = -__expf(p.ret_log_decay[l * 8 + 4 + h]) * LOG2E;
    const float ksc = 0.08838834764831845f;
    const int rowbase = chunk_row(b, cidx);
    const int ti = hf * 64 + w * 16 + c;
    bf16x8 qf[4];
#pragma unroll
    for (int ks = 0; ks < 4; ++ks) qf[ks] = as_bf(ldg16(p.P + (size_t)(rowbase + ti) * PC + C_RQ + h * 128 + ks * 32 + g * 8));
    __syncthreads();
#pragma unroll
    for (int i = 0; i < 8; ++i) {
        const int cc = t + 256 * i;
        { const int r = cc >> 4, ch = cc & 15; *(u32x4*)(B0 + r * 136 + ch * 8) = ldg16(p.P + (size_t)(rowbase + r) * PC + C_RK + h * 128 + ch * 8); }
        { const int tok = cc & 127, ch = cc >> 7;
          const u32x4 vv = ldg16(p.P + (size_t)(rowbase + tok) * PC + C_RV + h * 128 + ch * 8);
#pragma unroll
          for (int e = 0; e < 4; ++e) { B1[(ch * 8 + 2 * e) * 136 + tok] = (bf16_t)(vv[e] & 0xffffu); B1[(ch * 8 + 2 * e + 1) * 136 + tok] = (bf16_t)(vv[e] >> 16); } }
    }
    __syncthreads();
    bf16x8 pf[4];
    {
        f32x4 s[8];
#pragma unroll
        for (int kb = 0; kb < 8; ++kb) s[kb] = (f32x4){0.f, 0.f, 0.f, 0.f};
#pragma unroll
        for (int ks = 0; ks < 4; ++ks)
#pragma unroll
            for (int kb = 0; kb < 8; ++kb) {
                const bf16x8 kf = *(const bf16x8*)(B0 + (kb * 16 + c) * 136 + ks * 32 + g * 8);
                s[kb] = mfma16(kf, qf[ks], s[kb]);
            }
#pragma unroll
        for (int kb = 0; kb < 8; ++kb)
#pragma unroll
            for (int r = 0; r < 4; ++r) {
                const int j = kb * 16 + g * 4 + r, d = ti - j;
                const float wgt = d > 0 ? ex2(lgf * (float)d) : (d < 0 ? ex2(lgb * (float)(-d)) : 2.f);
                s[kb][r] *= wgt * ksc;
            }
#pragma unroll
        for (int kk = 0; kk < 4; ++kk) {
            u32x4 u;
            u[0] = pk2(s[2 * kk][0], s[2 * kk][1]); u[1] = pk2(s[2 * kk][2], s[2 * kk][3]);
            u[2] = pk2(s[2 * kk + 1][0], s[2 * kk + 1][1]); u[3] = pk2(s[2 * kk + 1][2], s[2 * kk + 1][3]);
            pf[kk] = as_bf(u);
        }
    }
    f32x4 o[8];
#pragma unroll
    for (int d = 0; d < 8; ++d) o[d] = (f32x4){0.f, 0.f, 0.f, 0.f};
#pragma unroll
    for (int kk = 0; kk < 4; ++kk)
#pragma unroll
        for (int d = 0; d < 8; ++d) {
            const u32x2 vlo = *(const u32x2*)(B1 + (d * 16 + c) * 136 + kk * 32 + g * 4);
            const u32x2 vhi = *(const u32x2*)(B1 + (d * 16 + c) * 136 + kk * 32 + 16 + g * 4);
            u32x4 vv; vv[0] = vlo[0]; vv[1] = vlo[1]; vv[2] = vhi[0]; vv[3] = vhi[1];
            o[d] = mfma16(as_bf(vv), pf[kk], o[d]);
        }
    __syncthreads();
    {
        const bf16_t* Sf = p.SU + ((size_t)((0 * 4 + b) * 4 + h) * 66 + cidx) * 16384;
        const bf16_t* Sb = p.SU + ((size_t)((1 * 4 + b) * 4 + h) * 66 + cidx) * 16384;
#pragma unroll
        for (int i = 0; i < 8; ++i) {
            const int cc = t + 256 * i, r = cc >> 4, ch = cc & 15;
            *(u32x4*)(B0 + r * 136 + ch * 8) = ldg16(Sf + r * 128 + ch * 8);
            *(u32x4*)(B1 + r * 136 + ch * 8) = ldg16(Sb + r * 128 + ch * 8);
        }
    }
    __syncthreads();
#pragma unroll
    for (int dir = 0; dir < 2; ++dir) {
        const bf16_t* Bd = dir ? B1 : B0;
        const float xi = dir == 0 ? ex2(lgf * (float)(ti + 1)) : ex2(lgb * (float)(128 - ti));
        bf16x8 qs[4];
#pragma unroll
        for (int ks = 0; ks < 4; ++ks) qs[ks] = scale_frag(qf[ks], xi);
#pragma unroll
        for (int ks = 0; ks < 4; ++ks)
#pragma unroll
            for (int d = 0; d < 8; ++d) {
                const bf16x8 sf = *(const bf16x8*)(Bd + (d * 16 + c) * 136 + ks * 32 + g * 8);
                o[d] = mfma16(sf, qs[ks], o[d]);
            }
    }
    if (dostore) {
        float sum = 0.f;
#pragma unroll
        for (int d = 0; d < 8; ++d) sum += (o[d][0] + o[d][1]) + (o[d][2] + o[d][3]);
        sum += __shfl_xor(sum, 16); sum += __shfl_xor(sum, 32);
        const float mu = sum * (1.f / 128.f);
        float var = 0.f;
#pragma unroll
        for (int d = 0; d < 8; ++d)
#pragma unroll
            for (int r = 0; r < 4; ++r) { const float dd = o[d][r] - mu; var += dd * dd; }
        var += __shfl_xor(var, 16); var += __shfl_xor(var, 32);
        const float rstd = rsqrtf(var * (1.f / 128.f) + EPSN);
        bf16_t* rowp = p.P + (size_t)(rowbase + ti) * PC;
#pragma unroll
        for (int d = 0; d < 8; ++d) {
            const int dv = d * 16 + g * 4;
            const f32x4 gn = *(const f32x4*)(p.ret_gn_w + l * 512 + h * 128 + dv);
            const u32x2 gt = *(const u32x2*)(rowp + C_RG + h * 128 + dv);
            const float v0 = (o[d][0] - mu) * rstd * gn[0] * silu_f(lo16(gt[0])), v1 = (o[d][1] - mu) * rstd * gn[1] * silu_f(hi16(gt[0]));
            const float v2 = (o[d][2] - mu) * rstd * gn[2] * silu_f(lo16(gt[1])), v3 = (o[d][3] - mu) * rstd * gn[3] * silu_f(hi16(gt[1]));
            u32x2 o2; o2.x = pk2(v0, v1); o2.y = pk2(v2, v3);
            *(u32x2*)(rowp + C_RQ + h * 128 + dv) = o2;
        }
    }
}

__device__ void phase_d(const Params& p, int l, unsigned char* lds) {
    const bool need_ctx = l < 3;
    const int G = gridDim.x, bid = blockIdx.x;
    const bool small_first = bid >= (G >> 1);
    float mfix;
    {
        const int ln = tid_opaque() & 63;
        float wq = fabsf(p.q_norm_w[l * 64 + ln]), wk = fabsf(p.k_norm_w[l * 64 + ln]);
#pragma unroll
        for (int o = 32; o >= 1; o >>= 1) { wq = fmaxf(wq, __shfl_xor(wq, o)); wk = fmaxf(wk, __shfl_xor(wk, o)); }
        mfix = 64.f * wq * wk * (0.125f * LOG2E);
    }
    const bool usefix = mfix < 40.f;
#pragma unroll 1
    for (int stage = 0; stage < 3; ++stage) {
        const int kind = small_first ? (stage + 1) % 3 : stage;
        if (kind == 0) {
#pragma unroll 1
            for (int it = bid; it < 1024; it += G) {
                if (usefix) attn_item32<0, true>(p, l, it >> 8, (it >> 7) & 1, it & 127, lds, mfix);
                else attn_item32<0, false>(p, l, it >> 8, (it >> 7) & 1, it & 127, lds, 0.f);
            }
        } else if (kind == 1) {
#pragma unroll 1
            for (int it = bid; it < 2048; it += G) {
                attn_item<2>(p, l, it >> 9, (it >> 6) & 7, (it >> 2) & 15, it & 3, lds);
            }
        } else {
            const int nch = need_ctx ? 66 : 64, n_ret = nch * 32;
#pragma unroll 1
            for (int it = G - 1 - bid; it < n_ret; it += G) {
                const int hf = it & 1, it2 = it >> 1;
                const int cidx = it2 % nch, bh = it2 / nch;
                ret_item(p, l, bh >> 2, bh & 3, cidx, hf, lds);
            }
        }
        __syncthreads();
    }
    if (need_ctx) {
#pragma unroll 1
        for (int it = G - 1 - bid; it < 32; it += G) attn_item32<1, false>(p, l, it >> 3, (it >> 2) & 1, it & 3, lds, 0.f);
        __syncthreads();
#pragma unroll 1
        for (int it = G - 1 - bid - 32; it < 32; it += G) { if (it >= 0) attn_item32<3, false>(p, l, it >> 3, it & 7, 0, lds, 0.f); }
    }
}

__device__ void phase_e1(const Params& p, int l, unsigned char* lds) {
    const int t = tid_opaque(), lane = t & 63, w = t >> 6, wm = w >> 1, wn = w & 1;
    const int nmt = l < 3 ? 264 : 256;
    const int total = nmt * 8;
    for (int item = blockIdx.x; item < total; item += gridDim.x) {
        const int mt = item >> 3, nt = item & 7;
        u32x2 macc[4][4];
#pragma unroll
        for (int a = 0; a < 4; ++a)
#pragma unroll
            for (int b = 0; b < 4; ++b) macc[a][b] = (u32x2){0u, 0u};
#pragma unroll 1
        for (int br = 0; br < 3; ++br) {
            u32x2 sg[4][4];
            {
                f32x4 gacc[4][4];
#pragma unroll
                for (int a = 0; a < 4; ++a)
#pragma unroll
                    for (int b = 0; b < 4; ++b) gacc[a][b] = (f32x4){0.f, 0.f, 0.f, 0.f};
                gemm_core<4>(gacc, p.HX + (size_t)mt * 128 * DM, DM, p.Wt + WT_IN + (size_t)(PC + br * 1024 + nt * 128) * DM, DM, DM, lds);
#pragma unroll
                for (int a = 0; a < 4; ++a)
#pragma unroll
                    for (int b = 0; b < 4; ++b) { sg[a][b].x = pk2(sigm_f(gacc[a][b][0]), sigm_f(gacc[a][b][1])); sg[a][b].y = pk2(sigm_f(gacc[a][b][2]), sigm_f(gacc[a][b][3])); }
            }
            f32x4 pacc[4][4];
#pragma unroll
            for (int a = 0; a < 4; ++a)
#pragma unroll
                for (int b = 0; b < 4; ++b) pacc[a][b] = (f32x4){0.f, 0.f, 0.f, 0.f};
            const int xcol = br == 0 ? C_RQ : (br == 1 ? C_NQ : C_GQ);
            const int woff = br == 0 ? WT_RET : (br == 1 ? WT_NA : WT_GQA);
            gemm_core<4>(pacc, p.P + (size_t)mt * 128 * PC + xcol, PC, p.Wt + woff + (size_t)nt * 128 * 512, 512, 512, lds);
#pragma unroll
            for (int a = 0; a < 4; ++a)
#pragma unroll
                for (int b = 0; b < 4; ++b) {
                    const float m0 = lo16(macc[a][b].x) + lo16(sg[a][b].x) * pacc[a][b][0], m1 = hi16(macc[a][b].x) + hi16(sg[a][b].x) * pacc[a][b][1];
                    const float m2 = lo16(macc[a][b].y) + lo16(sg[a][b].y) * pacc[a][b][2], m3 = hi16(macc[a][b].y) + hi16(sg[a][b].y) * pacc[a][b][3];
                    macc[a][b].x = pk2(m0, m1); macc[a][b].y = pk2(m2, m3);
                }
        }
#pragma unroll
        for (int ni = 0; ni < 4; ++ni)
#pragma unroll
            for (int mi = 0; mi < 4; ++mi) {
                const int n = nt * 128 + wn * 64 + ni * 16 + (lane >> 4) * 4, m = mt * 128 + wm * 64 + mi * 16 + (lane & 15);
                *(u32x2*)(p.P + (size_t)m * PC + C_M + n) = macc[ni][mi];
            }
    }
}

__device__ void phase_e2(const Params& p, int l, unsigned char* lds, bool dostore = true) {
    const int t = tid_opaque(), lane = t & 63, w = t >> 6, wm = w >> 1, wn = w & 1;
    const int nmt = l < 3 ? 264 : 256;
    const int total = nmt * 8;
    const float* xsrc = l == 0 ? p.x : p.out;
    const float* ysrc = l == 0 ? p.ctx : p.y;
    for (int item = blockIdx.x; item < total; item += gridDim.x) {
        const int mt = item >> 3, nt = item & 7;
        f32x4 acc[4][4];
#pragma unroll
        for (int a = 0; a < 4; ++a)
#pragma unroll
            for (int b = 0; b < 4; ++b) acc[a][b] = (f32x4){0.f, 0.f, 0.f, 0.f};
        gemm_core<4>(acc, p.P + (size_t)mt * 128 * PC + C_M, PC, p.Wt + WT_OUT + (size_t)nt * 128 * DM, DM, DM, lds);
#pragma unroll
        for (int mi = 0; mi < 4; ++mi) {
            const int m = mt * 128 + wm * 64 + mi * 16 + (lane & 15);
            const bool lat = m < NTOK;
            const int bb = lat ? (m >> 13) : 4;
            const float* src = lat ? xsrc + (size_t)m * DM : ysrc + (size_t)(m - NTOK) * DM;
            float* dst = lat ? p.out + (size_t)m * DM : p.y + (size_t)(m - NTOK) * DM;
            const float* gate = p.mod + (size_t)(l * 5 + bb) * 3072 + 2048;
#pragma unroll
            for (int ni = 0; ni < 4; ++ni) {
                const int n = nt * 128 + wn * 64 + ni * 16 + (lane >> 4) * 4;
                const f32x4 xo = *(const f32x4*)(src + n), gv = *(const f32x4*)(gate + n);
                if (dostore) *(f32x4*)(dst + n) = xo + gv * acc[ni][mi];
            }
        }
    }
}

__device__ void phase_e3(const Params& p, int l, unsigned char* lds) {
    norm_rows(p, l + 1, p.out, p.y);
    if (l < 3)
        for (int item = blockIdx.x; item < NCONV_ITEMS; item += gridDim.x) convert_item(p, l + 1, item, lds);
}


__device__ __forceinline__ void run_phase(const Params& p, int ph, int l, unsigned char* lds) {
    switch (ph) {
        case 0: phase_p0(p, lds);
            break;
        case 1: norm_rows(p, 0, p.x, p.ctx); break;
        case 2: phase_a(p, l, lds);
            break;
        case 3: phase_b(p, l, lds); break;
        case 4:
            phase_c(p, l); break;
        case 5: phase_d(p, l, lds); break;
        case 6: phase_e1(p, l, lds);
            break;
        case 7:
            phase_e2(p, l, lds); break;
        default: phase_e3(p, l, lds);
            break;
    }
}

__device__ __forceinline__ void fast_grid_barrier(unsigned* bar, unsigned k) {
    asm volatile("s_waitcnt vmcnt(0) lgkmcnt(0)" ::: "memory");
    __syncthreads();
    if (threadIdx.x == 0) {
        const unsigned grp = blockIdx.x & 7u, members = (gridDim.x - grp + 7u) >> 3;
        __builtin_amdgcn_fence(__ATOMIC_RELEASE, "agent");
        const unsigned old = __hip_atomic_fetch_add(bar + grp * 32, 1u, __ATOMIC_RELAXED, __HIP_MEMORY_SCOPE_AGENT);
        if (old + 1u == k * members) {
            __hip_atomic_fetch_add(bar + 256, 1u, __ATOMIC_RELAXED, __HIP_MEMORY_SCOPE_AGENT);
            while (__hip_atomic_load(bar + 256, __ATOMIC_RELAXED, __HIP_MEMORY_SCOPE_AGENT) < k * 8u) __builtin_amdgcn_s_sleep(1);
            __hip_atomic_store(bar + 288 + grp * 32, k, __ATOMIC_RELAXED, __HIP_MEMORY_SCOPE_AGENT);
        } else {
            while (__hip_atomic_load(bar + 288 + grp * 32, __ATOMIC_RELAXED, __HIP_MEMORY_SCOPE_AGENT) < k) __builtin_amdgcn_s_sleep(1);
        }
        __builtin_amdgcn_fence(__ATOMIC_ACQUIRE, "agent");
    }
    __syncthreads();
}
#define GSYNC() do { asm volatile("s_waitcnt vmcnt(0) lgkmcnt(0)" ::: "memory"); grid.sync(); } while (0)
__global__ void __launch_bounds__(256, 2) mega_kernel(Params p) {
    __shared__ __attribute__((aligned(16))) unsigned char lds[LDS_BYTES];
    cg::grid_group grid = cg::this_grid();
    unsigned bk = 0;
    run_phase(p, 0, 0, lds); GSYNC();
    run_phase(p, 1, 0, lds); fast_grid_barrier(p.bar, ++bk);
    for (int l = 0; l < 4; ++l) {
#pragma unroll 1
        for (int ph = 2; ph <= 8; ++ph) {
            run_phase(p, ph, l, lds);
            if (!(l == 3 && ph == 8)) fast_grid_barrier(p.bar, ++bk);
        }
    }
}

extern "C" void kernel_launch(void* const* d_in, const int* in_sizes, int n_in, void* d_out, int out_size, void* d_ws, size_t ws_size, hipStream_t stream) {
    Params p{};
    p.x = (const float*)d_in[0]; p.c = (const float*)d_in[1]; p.ctx = (const float*)d_in[2]; p.c_ctx = (const float*)d_in[3];
    p.ada_w = (const float*)d_in[4]; p.ada_b = (const float*)d_in[5]; p.norm_w = (const float*)d_in[6]; p.w_in = (const float*)d_in[7];
    p.ret_log_decay = (const float*)d_in[8]; p.ret_gn_w = (const float*)d_in[9]; p.na_rpb = (const float*)d_in[10];
    p.q_norm_w = (const float*)d_in[11]; p.k_norm_w = (const float*)d_in[12]; p.w_ret_o = (const float*)d_in[13];
    p.w_na_o = (const float*)d_in[14]; p.w_gqa_o = (const float*)d_in[15]; p.w_out = (const float*)d_in[16]; p.final_norm_w = (const float*)d_in[17];
    p.out = (float*)d_out;
    unsigned char* ws = (unsigned char*)d_ws;
    size_t off = 0;
    p.P = (bf16_t*)(ws + off); off += (size_t)NROWS * PC * 2;
    p.HX = (bf16_t*)(ws + off); off += (size_t)NROWS * DM * 2;
    p.Wt = (bf16_t*)(ws + off); off += (size_t)WT_TOTAL * 2;
    p.SU = (bf16_t*)(ws + off); off += (size_t)2 * 4 * 4 * 66 * 16384 * 2;
    p.y = (float*)(ws + off); off += (size_t)1024 * 1024 * 4;
    p.mod = (float*)(ws + off); off += (size_t)4 * 5 * 3072 * 4;
    p.rope = (float*)(ws + off); off += (size_t)128 * 16 * 2 * 4 + 256;
    p.bar = (unsigned*)(ws + off); off += 4096;
    off += (size_t)4 * 2 * 64 * 8448 * 2;
    if (off > ws_size) { fprintf(stderr, "workspace too small: need %zu have %zu\n", off, ws_size); return; }
    static int grid_blocks = 0;
    if (!grid_blocks) {
        int dev = 0, cus = 0, per_cu = 0;
        hipGetDevice(&dev);
        hipDeviceGetAttribute(&cus, hipDeviceAttributeMultiprocessorCount, dev);
        hipOccupancyMaxActiveBlocksPerMultiprocessor(&per_cu, mega_kernel, 256, 0);
        if (per_cu > 2) per_cu = 2;
        grid_blocks = cus * per_cu;
    }
    hipMemsetAsync(p.bar, 0, 4096, stream);
    void* args[] = {&p};
    hipError_t e = hipLaunchCooperativeKernel((void*)mega_kernel, dim3(grid_blocks), dim3(256), args, 0, stream);
    if (e != hipSuccess) fprintf(stderr, "cooperative launch failed: %s (grid %d)\n", hipGetErrorString(e), grid_blocks);
}
```

```cpp
#include <hip/hip_runtime.h>
#include <hip/hip_cooperative_groups.h>
#include <cstdio>
#include <cstdint>
namespace cg = cooperative_groups;


typedef unsigned short bf16_t;
typedef short bf16x8 __attribute__((ext_vector_type(8)));
typedef float f32x4 __attribute__((ext_vector_type(4)));
typedef unsigned u32x4 __attribute__((ext_vector_type(4)));
typedef unsigned u32x2 __attribute__((ext_vector_type(2)));

#define DM 1024
#define NTOK 32768
#define NROWS 33792
#define PC 5376
#define INC 8448
#define LOG2E 1.4426950408889634f
#define EPSN 1e-6f
#define LDS_BYTES 73728

#define C_RQ 0
#define C_RK 512
#define C_RV 1024
#define C_RG 1536
#define C_NQ 2048
#define C_NK 2560
#define C_NV 3072
#define C_NG 3584
#define C_GQ 4096
#define C_GK 4608
#define C_GV 4736
#define C_GG 4864
#define C_M  512

#define WT_IN 0
#define WT_RET (8448 * 1024)
#define WT_NA (WT_RET + 1024 * 512)
#define WT_GQA (WT_NA + 1024 * 512)
#define WT_OUT (WT_GQA + 1024 * 512)
#define WT_TOTAL (WT_OUT + 1024 * 1024)

#define VG(p) ((bf16_t*)((unsigned char*)(p).bar + 4096))
struct Params {
    const float *x, *c, *ctx, *c_ctx, *ada_w, *ada_b, *norm_w, *w_in, *ret_log_decay, *ret_gn_w, *na_rpb, *q_norm_w, *k_norm_w,
        *w_ret_o, *w_na_o, *w_gqa_o, *w_out, *final_norm_w;
    float* out;
    bf16_t* P;
    bf16_t* HX;
    bf16_t* Wt;
    bf16_t* SU;
    float* y;
    float* mod;
    float* rope;
    unsigned* bar;
};

__device__ __forceinline__ int tid_opaque() { int t = threadIdx.x; asm volatile("" : "+v"(t)); return t; }
__device__ __forceinline__ float bf2f(bf16_t v) { return __uint_as_float(((unsigned)v) << 16); }
typedef __bf16 bf16x2_t __attribute__((ext_vector_type(2)));
typedef float f32x2_t __attribute__((ext_vector_type(2)));
__device__ __forceinline__ unsigned pk2(float lo, float hi) {
    f32x2_t v = {lo, hi};
    union { bf16x2_t b; unsigned u; } x; x.b = __builtin_convertvector(v, bf16x2_t); return x.u;
}
__device__ __forceinline__ bf16_t f2bf(float f) { return (bf16_t)(pk2(f, 0.f) & 0xffffu); }
__device__ __forceinline__ float lo16(unsigned u) { return __uint_as_float(u << 16); }
__device__ __forceinline__ float hi16(unsigned u) { return __uint_as_float(u & 0xffff0000u); }
__device__ __forceinline__ float ex2(float x) { return __builtin_amdgcn_exp2f(x); }
__device__ __forceinline__ float silu_f(float x) { return x * __builtin_amdgcn_rcpf(1.f + ex2(-x * LOG2E)); }
__device__ __forceinline__ float sigm_f(float x) { return __builtin_amdgcn_rcpf(1.f + ex2(-x * LOG2E)); }
__device__ __forceinline__ f32x4 mfma16(bf16x8 a, bf16x8 b, f32x4 c) { return __builtin_amdgcn_mfma_f32_16x16x32_bf16(a, b, c, 0, 0, 0); }
__device__ __forceinline__ bf16x8 as_bf(u32x4 u) { union { u32x4 a; bf16x8 b; } x; x.a = u; return x.b; }
__device__ __forceinline__ u32x4 as_u(bf16x8 u) { union { u32x4 a; bf16x8 b; } x; x.b = u; return x.a; }
__device__ __forceinline__ u32x4 ldg16(const bf16_t* p) { return *(const u32x4*)p; }

template <int NI>
__device__ __forceinline__ void gemm_core(f32x4 (&acc)[NI][4], const bf16_t* __restrict__ X, int ldx, const bf16_t* __restrict__ W, int ldw, int K, unsigned char* lds) {
    const int t = tid_opaque(), lane = t & 63, w = t >> 6, wm = w >> 1, wn = w & 1;
    bf16_t* Xs = (bf16_t*)lds;
    bf16_t* Ws = Xs + 2 * 128 * 72;
    const int sr = t >> 3, sc = (t & 7) * 8;
    const bf16_t* xg = X + (size_t)sr * ldx + sc;
    const bf16_t* wg = W + (size_t)sr * ldw + sc;
    u32x4 xr[4], wr[NI];
#pragma unroll
    for (int i = 0; i < 4; ++i) xr[i] = ldg16(xg + (size_t)i * 32 * ldx);
#pragma unroll
    for (int i = 0; i < NI; ++i) wr[i] = ldg16(wg + (size_t)i * 32 * ldw);
    __syncthreads();
#pragma unroll
    for (int i = 0; i < 4; ++i) *(u32x4*)(Xs + (sr + i * 32) * 72 + sc) = xr[i];
#pragma unroll
    for (int i = 0; i < NI; ++i) *(u32x4*)(Ws + (sr + i * 32) * 72 + sc) = wr[i];
    __syncthreads();
    const int nk = K >> 6;
    for (int kt = 0; kt < nk; ++kt) {
        const int cur = kt & 1;
        if (kt + 1 < nk) {
            const int ko = (kt + 1) * 64;
#pragma unroll
            for (int i = 0; i < 4; ++i) xr[i] = ldg16(xg + (size_t)i * 32 * ldx + ko);
#pragma unroll
            for (int i = 0; i < NI; ++i) wr[i] = ldg16(wg + (size_t)i * 32 * ldw + ko);
        }
        __builtin_amdgcn_sched_barrier(0);
        const bf16_t* xs = Xs + cur * 128 * 72 + (wm * 64 + (lane & 15)) * 72 + (lane >> 4) * 8;
        const bf16_t* ws = Ws + cur * 128 * 72 + (wn * (NI * 16) + (lane & 15)) * 72 + (lane >> 4) * 8;
#pragma unroll
        for (int ks = 0; ks < 2; ++ks) {
            bf16x8 xf[4], wf[NI];
#pragma unroll
            for (int i = 0; i < 4; ++i) xf[i] = *(const bf16x8*)(xs + i * 16 * 72 + ks * 32);
#pragma unroll
            for (int i = 0; i < NI; ++i) wf[i] = *(const bf16x8*)(ws + i * 16 * 72 + ks * 32);
#pragma unroll
            for (int ni = 0; ni < NI; ++ni)
#pragma unroll
                for (int mi = 0; mi < 4; ++mi) acc[ni][mi] = mfma16(wf[ni], xf[mi], acc[ni][mi]);
        }
        if (kt + 1 < nk) {
            const int nx = cur ^ 1;
#pragma unroll
            for (int i = 0; i < 4; ++i) *(u32x4*)(Xs + nx * 128 * 72 + (sr + i * 32) * 72 + sc) = xr[i];
#pragma unroll
            for (int i = 0; i < NI; ++i) *(u32x4*)(Ws + nx * 128 * 72 + (sr + i * 32) * 72 + sc) = wr[i];
        }
        __syncthreads();
    }
}

__device__ __forceinline__ void gemm_big(f32x4 (&acc)[4][8], const bf16_t* __restrict__ X, int ldx, const bf16_t* __restrict__ W, int ldw, int K, unsigned char* lds) {
    const int t = tid_opaque(), lane = t & 63, w = t >> 6, wm = w >> 1, wn = w & 1;
    bf16_t* Xs = (bf16_t*)lds;
    bf16_t* Ws = Xs + 2 * 256 * 40;
    const int sr = t >> 2, sc = (t & 3) * 8;
    const bf16_t* xg = X + (size_t)sr * ldx + sc;
    const bf16_t* wg = W + (size_t)sr * ldw + sc;
    u32x4 ra[6], rb[6];
#define GB_LOAD(r, ko) do { _Pragma("unroll") for (int i = 0; i < 4; ++i) r[i] = ldg16(xg + (size_t)i * 64 * ldx + (ko)); _Pragma("unroll") for (int i = 0; i < 2; ++i) r[4 + i] = ldg16(wg + (size_t)i * 64 * ldw + (ko)); } while (0)
#define GB_ST1(r, st, i) do { if ((i) < 4) *(u32x4*)(Xs + (st) * 256 * 40 + (sr + (i) * 64) * 40 + sc) = r[i]; else *(u32x4*)(Ws + (st) * 128 * 40 + (sr + ((i) - 4) * 64) * 40 + sc) = r[i]; } while (0)
#define GB_STEP(st, r, dostore) do { \
        const bf16_t* xs = Xs + (st) * 256 * 40 + (wm * 128 + (lane & 15)) * 40 + (lane >> 4) * 8; \
        const bf16_t* ws = Ws + (st) * 128 * 40 + (wn * 64 + (lane & 15)) * 40 + (lane >> 4) * 8; \
        bf16x8 wf[4]; \
        _Pragma("unroll") for (int i = 0; i < 4; ++i) wf[i] = *(const bf16x8*)(ws + i * 16 * 40); \
        _Pragma("unroll") for (int mi = 0; mi < 8; ++mi) { \
            const bf16x8 xf = *(const bf16x8*)(xs + mi * 16 * 40); \
            _Pragma("unroll") for (int ni = 0; ni < 4; ++ni) acc[ni][mi] = mfma16(wf[ni], xf, acc[ni][mi]); \
            if ((dostore) && mi >= 1 && mi <= 6) GB_ST1(r, (st) ^ 1, mi - 1); } } while (0)
    GB_LOAD(ra, 0);
    GB_LOAD(rb, 32);
    __syncthreads();
#pragma unroll
    for (int i = 0; i < 6; ++i) GB_ST1(ra, 0, i);
    __syncthreads();
    const int nk = K >> 5;
    for (int kt = 0; kt < nk; kt += 2) {
        if (kt + 2 < nk) GB_LOAD(ra, (kt + 2) * 32);
        GB_STEP(0, rb, true);
        __syncthreads();
        if (kt + 3 < nk) GB_LOAD(rb, (kt + 3) * 32);
        GB_STEP(1, ra, kt + 2 < nk);
        __syncthreads();
    }
#undef GB_LOAD
#undef GB_ST1
#undef GB_STEP
}

__device__ void adaln_item(const Params& p, int item, unsigned char* lds) {
    const int t = tid_opaque(), lane = t & 63, w = t >> 6;
    const int l = item / 48, cgp = item % 48, j = cgp * 64 + lane;
    float* cs = (float*)lds;
    float* red = (float*)(lds + 20480);
    __syncthreads();
    for (int idx = t; idx < 5120; idx += 256) {
        const int bb = idx >> 10, k = idx & 1023;
        const float v = bb < 4 ? p.c[bb * 1024 + k] : p.c_ctx[k];
        cs[idx] = silu_f(v);
    }
    __syncthreads();
    float a0 = 0.f, a1 = 0.f, a2 = 0.f, a3 = 0.f, a4 = 0.f;
    const float* aw = p.ada_w + ((size_t)l * 1024 + w * 256) * 3072 + j;
    for (int k = 0; k < 256; ++k) {
        const float wv = aw[(size_t)k * 3072];
        const int kk = w * 256 + k;
        a0 += cs[kk] * wv; a1 += cs[1024 + kk] * wv; a2 += cs[2048 + kk] * wv; a3 += cs[3072 + kk] * wv; a4 += cs[4096 + kk] * wv;
    }
    red[(w * 5 + 0) * 64 + lane] = a0; red[(w * 5 + 1) * 64 + lane] = a1; red[(w * 5 + 2) * 64 + lane] = a2;
    red[(w * 5 + 3) * 64 + lane] = a3; red[(w * 5 + 4) * 64 + lane] = a4;
    __syncthreads();
    for (int idx = t; idx < 320; idx += 256) {
        const int bb = idx >> 6, ln = idx & 63;
        float v = p.ada_b[l * 3072 + cgp * 64 + ln];
#pragma unroll
        for (int ww = 0; ww < 4; ++ww) v += red[(ww * 5 + bb) * 64 + ln];
        p.mod[(l * 5 + bb) * 3072 + cgp * 64 + ln] = v;
    }
}

__device__ void transpose_tile(const float* __restrict__ src, int N, bf16_t* __restrict__ dst, int K, int k0, int n0, unsigned char* lds) {
    const int t = tid_opaque();
    bf16_t* T = (bf16_t*)lds;
    __syncthreads();
#pragma unroll
    for (int i = 0; i < 4; ++i) {
        const int k = (t >> 4) + 16 * i, n4 = (t & 15) * 4;
        const f32x4 v = *(const f32x4*)(src + (size_t)(k0 + k) * N + n0 + n4);
        T[(n4 + 0) * 72 + k] = f2bf(v[0]); T[(n4 + 1) * 72 + k] = f2bf(v[1]); T[(n4 + 2) * 72 + k] = f2bf(v[2]); T[(n4 + 3) * 72 + k] = f2bf(v[3]);
    }
    __syncthreads();
#pragma unroll
    for (int i = 0; i < 2; ++i) {
        const int cidx = t + 256 * i, n = cidx >> 3, kc = cidx & 7;
        *(u32x4*)(dst + (size_t)(n0 + n) * K + k0 + kc * 8) = *(const u32x4*)(T + n * 72 + kc * 8);
    }
}

#define NCONV_ITEMS (2112 + 3 * 128 + 256)
__device__ void convert_item(const Params& p, int l, int item, unsigned char* lds) {
    if (item < 2112) {
        const int kt = item / 132, nt = item % 132;
        transpose_tile(p.w_in + (size_t)l * 1024 * INC, INC, p.Wt + WT_IN, 1024, kt * 64, nt * 64, lds);
    } else if (item < 2112 + 384) {
        const int it = item - 2112, which = it / 128, r = it % 128, kt = r / 16, nt = r % 16;
        const float* src = (which == 0 ? p.w_ret_o : which == 1 ? p.w_na_o : p.w_gqa_o) + (size_t)l * 512 * 1024;
        bf16_t* dst = p.Wt + (which == 0 ? WT_RET : which == 1 ? WT_NA : WT_GQA);
        transpose_tile(src, 1024, dst, 512, kt * 64, nt * 64, lds);
    } else {
        const int it = item - 2112 - 384, kt = it / 16, nt = it % 16;
        transpose_tile(p.w_out + (size_t)l * 1024 * 1024, 1024, p.Wt + WT_OUT, 1024, kt * 64, nt * 64, lds);
    }
}

__device__ void rope_table(const Params& p) {
    for (int idx = tid_opaque(); idx < 2048; idx += 256) {
        const int pos = idx >> 4, i = idx & 15;
        const float f = ex2(-(float)i * (13.287712379549449f / 16.f));
        const float ang = (float)pos * f;
        float rev = ang * 0.15915494309189535f;
        rev = rev - rintf(rev);
        p.rope[idx * 2 + 0] = __builtin_amdgcn_cosf(rev);
        p.rope[idx * 2 + 1] = __builtin_amdgcn_sinf(rev);
    }
}

__device__ void phase_p0(const Params& p, unsigned char* lds) {
    const int total = 192 + NCONV_ITEMS + 1;
    for (int item = blockIdx.x; item < total; item += gridDim.x) {
        if (item < 192) adaln_item(p, item, lds);
        else if (item < 192 + NCONV_ITEMS) convert_item(p, 0, item - 192, lds);
        else rope_table(p);
    }
}

__device__ void norm_rows(const Params& p, int lnext, const float* xsrc, const float* ysrc) {
    const int t = tid_opaque(), lane = t & 63, w = t >> 6;
    const int nrows = lnext < 4 ? NROWS : NTOK;
    for (int row = blockIdx.x * 4 + w; row < nrows; row += gridDim.x * 4) {
        const float* src = row < NTOK ? xsrc + (size_t)row * DM : ysrc + (size_t)(row - NTOK) * DM;
        f32x4 v[4];
        float ss = 0.f;
#pragma unroll
        for (int i = 0; i < 4; ++i) { v[i] = *(const f32x4*)(src + i * 256 + lane * 4); ss += v[i][0] * v[i][0] + v[i][1] * v[i][1] + v[i][2] * v[i][2] + v[i][3] * v[i][3]; }
#pragma unroll
        for (int o = 32; o >= 1; o >>= 1) ss += __shfl_xor(ss, o);
        const float rstd = rsqrtf(ss * (1.f / 1024.f) + EPSN);
        if (lnext < 4) {
            const int bb = row < NTOK ? (row >> 13) : 4;
            const float* md = p.mod + (size_t)(lnext * 5 + bb) * 3072;
            const float* nw = p.norm_w + lnext * 1024;
#pragma unroll
            for (int i = 0; i < 4; ++i) {
                const int col = i * 256 + lane * 4;
                const f32x4 nwv = *(const f32x4*)(nw + col), sh = *(const f32x4*)(md + col), scl = *(const f32x4*)(md + 1024 + col);
                f32x4 h = v[i] * rstd * nwv * (scl + 1.f) + sh;
                u32x2 o2; o2.x = pk2(h[0], h[1]); o2.y = pk2(h[2], h[3]);
                *(u32x2*)(p.HX + (size_t)row * DM + col) = o2;
            }
        } else {
#pragma unroll
            for (int i = 0; i < 4; ++i) {
                const int col = i * 256 + lane * 4;
                const f32x4 nwv = *(const f32x4*)(p.final_norm_w + col);
                f32x4 ov = v[i] * rstd * nwv;
                *(f32x4*)(p.out + (size_t)row * DM + col) = ov;
            }
        }
    }
}

__device__ void phase_a(const Params& p, int l, unsigned char* lds) {
    const int t = tid_opaque(), lane = t & 63, w = t >> 6, wm = w >> 1, wn = w & 1;
    const int total = 132 * 42;
    const bool xmap = (gridDim.x & 7) == 0;
    const int per = xmap ? (total + 7) / 8 : total;
    const int lo = xmap ? (int)(blockIdx.x & 7) * per : 0, hi = min(lo + per, total);
    const int step = xmap ? (int)(gridDim.x >> 3) : (int)gridDim.x;
    for (int idx = lo + (xmap ? (int)(blockIdx.x >> 3) : (int)blockIdx.x); idx < hi; idx += step) {
        const int nb = idx / 924, rem = idx - nb * 924;
        const int mt = rem / 7, nt = nb * 7 + (rem - mt * 7);
        f32x4 acc[4][8];
#pragma unroll
        for (int a = 0; a < 4; ++a)
#pragma unroll
            for (int b = 0; b < 8; ++b) acc[a][b] = (f32x4){0.f, 0.f, 0.f, 0.f};
        gemm_big(acc, p.HX + (size_t)mt * 256 * DM, DM, p.Wt + WT_IN + (size_t)nt * 128 * DM, DM, DM, lds);
#pragma unroll
        for (int ni = 0; ni < 4; ++ni)
#pragma unroll
            for (int mi = 0; mi < 8; ++mi) {
                const int n = nt * 128 + wn * 64 + ni * 16 + (lane >> 4) * 4, m = mt * 256 + wm * 128 + mi * 16 + (lane & 15);
                u32x2 o2; o2.x = pk2(acc[ni][mi][0], acc[ni][mi][1]); o2.y = pk2(acc[ni][mi][2], acc[ni][mi][3]);
                *(u32x2*)(p.P + (size_t)m * PC + n) = o2;
            }
    }
}

__device__ __forceinline__ int chunk_row(int b, int cidx) { return cidx < 64 ? b * 8192 + cidx * 128 : NTOK + b * 256 + (cidx - 64) * 128; }

__device__ void ret_state_item(const Params& p, int l, int b, int h, int cidx, unsigned char* lds) {
    const int t = tid_opaque(), lane = t & 63, w = t >> 6, g = lane >> 4, c = lane & 15;
    bf16_t* Ktf = (bf16_t*)lds;
    bf16_t* Vt = Ktf + 128 * 72;
    const float lgf = -__expf(p.ret_log_decay[l * 8 + h]) * LOG2E, lgb = -__expf(p.ret_log_decay[l * 8 + 4 + h]) * LOG2E;
    const float ksc = 0.08838834764831845f;
    const int rowbase = chunk_row(b, cidx);
    for (int dir = 0; dir < 2; ++dir) {
        f32x4 acc[2][8];
#pragma unroll
        for (int i = 0; i < 2; ++i)
#pragma unroll
            for (int d = 0; d < 8; ++d) acc[i][d] = (f32x4){0.f, 0.f, 0.f, 0.f};
        const float lg = dir ? lgb : lgf;
#pragma unroll 1
        for (int half = 0; half < 2; ++half) {
            __syncthreads();
#pragma unroll
            for (int i = 0; i < 4; ++i) {
                const int cc = t + 256 * i, tok = cc & 63, dch = cc >> 6, j = half * 64 + tok;
                const float wgt = ex2(lg * (float)(dir ? j : 127 - j)) * ksc;
                const bf16_t* rp = p.P + (size_t)(rowbase + j) * PC + h * 128 + dch * 8;
                const u32x4 kv = ldg16(rp + C_RK), vv = ldg16(rp + C_RV);
#pragma unroll
                for (int e = 0; e < 4; ++e) {
                    const int r0 = (dch * 8 + 2 * e) * 72 + tok, r1 = r0 + 72;
                    Ktf[r0] = f2bf(lo16(kv[e]) * wgt); Ktf[r1] = f2bf(hi16(kv[e]) * wgt);
                    Vt[r0] = (bf16_t)(vv[e] & 0xffffu); Vt[r1] = (bf16_t)(vv[e] >> 16);
                }
            }
            __syncthreads();
#pragma unroll
            for (int ks = 0; ks < 2; ++ks) {
                bf16x8 kf[2];
#pragma unroll
                for (int i = 0; i < 2; ++i) kf[i] = *(const bf16x8*)(Ktf + (w * 32 + i * 16 + c) * 72 + ks * 32 + g * 8);
#pragma unroll
                for (int d = 0; d < 8; ++d) {
                    const bf16x8 vf = *(const bf16x8*)(Vt + (d * 16 + c) * 72 + ks * 32 + g * 8);
#pragma unroll
                    for (int i = 0; i < 2; ++i) acc[i][d] = mfma16(kf[i], vf, acc[i][d]);
                }
            }
        }
        bf16_t* Sd = p.SU + ((size_t)((dir * 4 + b) * 4 + h) * 66 + cidx) * 16384;
#pragma unroll
        for (int i = 0; i < 2; ++i)
#pragma unroll
            for (int d = 0; d < 8; ++d) {
                const int dk = w * 32 + i * 16 + g * 4, dv = d * 16 + c;
                u32x2 o2; o2.x = pk2(acc[i][d][0], acc[i][d][1]); o2.y = pk2(acc[i][d][2], acc[i][d][3]);
                *(u32x2*)(Sd + dv * 128 + dk) = o2;
            }
    }
}

__device__ void qk_prep_item(const Params& p, int l, int item) {
    const int t = tid_opaque(), tok = t >> 2, sub = t & 3;
    const int row = item * 64 + tok;
    const bool lat = row < NTOK;
    const int tseq = row & 8191, pr = tseq >> 6, pc = tseq & 63;
    for (int hv = sub; hv < 10; hv += 4) {
        bf16_t* ptr = p.P + (size_t)row * PC + (hv < 8 ? C_GQ + hv * 64 : C_GK + (hv - 8) * 64);
        const float* nw = hv < 8 ? p.q_norm_w + l * 64 : p.k_norm_w + l * 64;
        float x[64];
        float ss = 0.f;
#pragma unroll
        for (int i = 0; i < 8; ++i) {
            const u32x4 u = ldg16(ptr + i * 8);
#pragma unroll
            for (int e = 0; e < 4; ++e) { x[i * 8 + 2 * e] = lo16(u[e]); x[i * 8 + 2 * e + 1] = hi16(u[e]); }
        }
#pragma unroll
        for (int d = 0; d < 64; ++d) ss += x[d] * x[d];
        const float rstd = rsqrtf(ss * (1.f / 64.f) + EPSN);
        const float qs = hv < 8 ? 0.125f * LOG2E : 1.f;
#pragma unroll
        for (int d = 0; d < 64; ++d) x[d] = x[d] * (rstd * qs) * nw[d];
        if (lat) {
#pragma unroll
            for (int i = 0; i < 16; ++i) {
                const float cr = p.rope[(pr * 16 + i) * 2], sr = p.rope[(pr * 16 + i) * 2 + 1];
                const float cc = p.rope[(pc * 16 + i) * 2], sc = p.rope[(pc * 16 + i) * 2 + 1];
                const float a = x[i], b2 = x[16 + i], a2 = x[32 + i], b3 = x[48 + i];
                x[i] = a * cr - b2 * sr; x[16 + i] = b2 * cr + a * sr;
                x[32 + i] = a2 * cc - b3 * sc; x[48 + i] = b3 * cc + a2 * sc;
            }
        }
#pragma unroll
        for (int i = 0; i < 8; ++i) {
            u32x4 u;
#pragma unroll
            for (int e = 0; e < 4; ++e) u[e] = pk2(x[i * 8 + 2 * e], x[i * 8 + 2 * e + 1]);
            *(u32x4*)(ptr + i * 8) = u;
        }
    }
    {
        const int b = lat ? (row >> 13) : ((row - NTOK) >> 8);
        const int key = lat ? tseq : 8192 + ((row - NTOK) & 255);
        const bf16_t* vp = p.P + (size_t)row * PC + C_GV + sub * 32;
        bf16_t* dst = VG(p) + ((size_t)(b * 2 + (sub >> 1)) * 64 + (sub & 1) * 32) * 8448 + key;
#pragma unroll
        for (int i = 0; i < 4; ++i) {
            const u32x4 u = ldg16(vp + i * 8);
#pragma unroll
            for (int e = 0; e < 4; ++e) {
                dst[(size_t)(i * 8 + 2 * e) * 8448] = (bf16_t)(u[e] & 0xffffu);
                dst[(size_t)(i * 8 + 2 * e + 1) * 8448] = (bf16_t)(u[e] >> 16);
            }
        }
    }
}

__device__ void phase_b(const Params& p, int l, unsigned char* lds) {
    const int total = 1056 + 528;
    for (int item = blockIdx.x; item < total; item += gridDim.x) {
        if (item < 1056) { const int cidx = item % 66, bh = item / 66; ret_state_item(p, l, bh >> 2, bh & 3, cidx, lds);
        }
        else qk_prep_item(p, l, item - 1056);
    }
}

__device__ void phase_c(const Params& p, int l, bool dostore = true) {
    const int t = tid_opaque();
    for (int item = blockIdx.x; item < 256; item += gridDim.x) {
        const int part = item & 7, dbh = item >> 3, dir = dbh >> 4, h = dbh & 3;
        const float lg = -__expf(p.ret_log_decay[l * 8 + dir * 4 + h]) * LOG2E;
        const float gc = ex2(lg * 128.f);
        bf16_t* base = p.SU + (size_t)dbh * 66 * 16384 + part * 2048 + t * 8;
        float s[8];
#pragma unroll
        for (int e = 0; e < 8; ++e) s[e] = 0.f;
        for (int st0 = 0; st0 < 66; st0 += 11) {
            u32x4 u[11];
#pragma unroll
            for (int q = 0; q < 11; ++q) {
                const int st = st0 + q;
                const int n = dir == 0 ? (st < 2 ? 64 + st : st - 2) : (st < 2 ? 65 - st : 65 - st);
                u[q] = *(const u32x4*)(base + (size_t)n * 16384);
            }
#pragma unroll
            for (int q = 0; q < 11; ++q) {
                const int st = st0 + q;
                const int n = dir == 0 ? (st < 2 ? 64 + st : st - 2) : (st < 2 ? 65 - st : 65 - st);
                u32x4 o;
#pragma unroll
                for (int e = 0; e < 4; ++e) o[e] = pk2(s[2 * e], s[2 * e + 1]);
                if (dostore) *(u32x4*)(base + (size_t)n * 16384) = o;
#pragma unroll
                for (int e = 0; e < 4; ++e) { s[2 * e] = gc * s[2 * e] + lo16(u[q][e]); s[2 * e + 1] = gc * s[2 * e + 1] + hi16(u[q][e]); }
            }
        }
    }
}

template <int MODE>
__device__ void attn_item(const Params& p, int l, int b, int i1, int i2, int i3, unsigned char* lds, bool dostore = true) {
    constexpr int NQB = (MODE == 2) ? 2 : 4, NHQ = NQB / 2;
    const int t = tid_opaque(), lane = t & 63, w = t >> 6, g = lane >> 4, c = lane & 15;
    bf16_t* Ks = (bf16_t*)lds;
    bf16_t* Vt = Ks + 2 * 64 * 72;
    u32x4* Qs = (u32x4*)(lds + 36864) + w * 512;
    float* rpbs = (float*)(lds + 36864 + 32768);
    int qbase, qstep, qcol, kcol, vcol, gcol, ntiles;
    int R0 = 0, c0 = 0, start = 0, bstart = 0, hh = 0;
    if (MODE == 0 || MODE == 1) {
        const int kvh = i1, qt = i2, head = kvh * 4 + w;
        qbase = (MODE == 0 ? b * 8192 : NTOK + b * 256) + qt * 64; qstep = 16;
        qcol = C_GQ + head * 64; kcol = C_GK + kvh * 64; vcol = C_GV + kvh * 64; gcol = C_GG + head * 64;
        ntiles = MODE == 0 ? 132 : 4;
    } else if (MODE == 2) {
        hh = i1; R0 = i2 * 8; c0 = i3 * 16;
        start = min(max(R0 - 4, 0), 112); bstart = min(max(c0 - 8, 0), 32);
        qbase = b * 8192 + (R0 + w * 2) * 64 + c0; qstep = 64;
        qcol = C_NQ + hh * 64; kcol = C_NK + hh * 64; vcol = C_NV + hh * 64; gcol = C_NG + hh * 64;
        ntiles = 12;
    } else {
        hh = i1;
        qbase = NTOK + b * 256 + w * 64; qstep = 16;
        qcol = C_NQ + hh * 64; kcol = C_NK + hh * 64; vcol = C_NV + hh * 64; gcol = C_NG + hh * 64;
        ntiles = 4;
    }
    const float scale = 0.125f * LOG2E;
    f32x4 o[NQB][4];
    float mrun[NQB], lsum[NQB];
#pragma unroll
    for (int qb = 0; qb < NQB; ++qb) {
        mrun[qb] = -INFINITY; lsum[qb] = 0.f;
#pragma unroll
        for (int d = 0; d < 4; ++d) o[qb][d] = (f32x4){0.f, 0.f, 0.f, 0.f};
    }
    const int kkey = t >> 3, kch = (t & 7) * 8;
    const int vkey = t & 63, vch = (t >> 6);
    u32x4 kr[2], vr[2];
    auto load_tile = [&](int tt) {
        int base, rstep;
        if (MODE == 0) { base = tt < 128 ? b * 8192 + tt * 64 : NTOK + b * 256 + (tt - 128) * 64; rstep = 32; }
        else if (MODE == 2) {
            if (tt < 4) { base = NTOK + b * 256 + tt * 64; rstep = 32; }
            else { base = b * 8192 + (start + 2 * (tt - 4)) * 64 + bstart; rstep = 64; }
        } else { base = NTOK + b * 256 + tt * 64; rstep = 32; }
#pragma unroll
        for (int i = 0; i < 2; ++i) {
            const int key = kkey + 32 * i;
            kr[i] = ldg16(p.P + (size_t)(base + (key >> 5) * rstep + (key & 31)) * PC + kcol + kch);
            if (MODE <= 1) vr[i] = ldg16(VG(p) + ((size_t)(b * 2 + i1) * 64 + kkey + 32 * i) * 8448 + (MODE == 0 ? tt * 64 : 8192 + tt * 64) + kch);
            else vr[i] = ldg16(p.P + (size_t)(base + (vkey >> 5) * rstep + (vkey & 31)) * PC + vcol + (vch + 4 * i) * 8);
        }
    };
    auto store_tile = [&](int buf) {
        bf16_t* ks_ = Ks + buf * 64 * 72; bf16_t* vt_ = Vt + buf * 64 * 72;
#pragma unroll
        for (int i = 0; i < 2; ++i) {
            *(u32x4*)(ks_ + (kkey + 32 * i) * 72 + kch) = kr[i];
            if (MODE <= 1) { *(u32x4*)(vt_ + (kkey + 32 * i) * 72 + kch) = vr[i]; continue; }
#pragma unroll
            for (int e = 0; e < 4; ++e) {
                const int d = (vch + 4 * i) * 8 + 2 * e;
                vt_[d * 72 + vkey] = (bf16_t)(vr[i][e] & 0xffffu);
                vt_[(d + 1) * 72 + vkey] = (bf16_t)(vr[i][e] >> 16);
            }
        }
    };
    load_tile(0);
    __syncthreads();
#pragma unroll
    for (int qb = 0; qb < NQB; ++qb)
#pragma unroll
        for (int ks = 0; ks < 2; ++ks) Qs[(qb * 2 + ks) * 64 + lane] = ldg16(p.P + (size_t)(qbase + qb * qstep + c) * PC + qcol + ks * 32 + g * 8);
    if (MODE == 2) for (int idx = t; idx < 465; idx += 256) rpbs[idx] = p.na_rpb[((size_t)l * 8 + hh) * 465 + idx] * LOG2E;
    store_tile(0);
    __syncthreads();
    const int wlo = min(max(R0 + w * 2 - 4, 0), 120), whi = min(max(R0 + w * 2 + 1 - 4, 0), 120) + 7;
    int colterm[8];
    if (MODE == 2) {
        const int qc = c0 + c, cs = min(max(qc - 8, 0), 48);
#pragma unroll
        for (int j = 0; j < 8; ++j) {
            const int kc = bstart + (j >> 2) * 16 + g * 4 + (j & 3);
            colterm[j] = ((unsigned)(kc - cs) < 16u) ? (kc - qc + 15) : -1;
        }
    }
    for (int tt = 0; tt < ntiles; ++tt) {
        const int cur = tt & 1;
        if (tt + 1 < ntiles) load_tile(tt + 1);
        bool skip = false;
        int krow0 = 0;
        if (MODE == 2 && tt >= 4) { krow0 = start + 2 * (tt - 4); skip = (krow0 + 1 < wlo) || (krow0 > whi); }
        if (!skip) {
            const bf16_t* ks_ = Ks + cur * 64 * 72; const bf16_t* vt_ = Vt + cur * 64 * 72;
            f32x4 s[NQB][4];
#pragma unroll
            for (int qq = 0; qq < NQB; ++qq)
#pragma unroll
                for (int kb = 0; kb < 4; ++kb) s[qq][kb] = (f32x4){0.f, 0.f, 0.f, 0.f};
#pragma unroll
            for (int ks = 0; ks < 2; ++ks) {
                bf16x8 qv[NQB];
#pragma unroll
                for (int qq = 0; qq < NQB; ++qq) qv[qq] = as_bf(Qs[(qq * 2 + ks) * 64 + lane]);
#pragma unroll
                for (int kb = 0; kb < 4; ++kb) {
                    const bf16x8 kf = *(const bf16x8*)(ks_ + (kb * 16 + c) * 72 + ks * 32 + g * 8);
#pragma unroll
                    for (int qq = 0; qq < NQB; ++qq) s[qq][kb] = mfma16(kf, qv[qq], s[qq][kb]);
                }
            }
            __builtin_amdgcn_sched_barrier(0);
            bf16x8 pf[NQB][2];
#pragma unroll
            for (int qq = 0; qq < NQB; ++qq) {
                const int qb = qq;
                if (MODE == 2 && tt >= 4) {
                    const int qrow = R0 + w * 2 + qb;
                    const int rs = min(max(qrow - 4, 0), 120);
#pragma unroll
                    for (int kb = 0; kb < 4; ++kb) {
                        const int krow = krow0 + (kb >> 1);
                        const bool rowok = (unsigned)(krow - rs) < 8u;
                        const int ridx = (krow - qrow + 7) * 31;
#pragma unroll
                        for (int r = 0; r < 4; ++r) {
                            const int ct = colterm[(kb & 1) * 4 + r];
                            const bool valid = rowok && ct >= 0;
                            const float bias = rpbs[valid ? ridx + ct : 0];
                            s[qq][kb][r] = valid ? s[qq][kb][r] * scale + bias : -INFINITY;
                        }
                    }
                }
                const bool raw = !(MODE == 2 && tt >= 4);
                float tmax = fmaxf(fmaxf(s[qq][0][0], s[qq][0][1]), fmaxf(s[qq][0][2], s[qq][0][3]));
#pragma unroll
                for (int kb = 1; kb < 4; ++kb) tmax = fmaxf(tmax, fmaxf(fmaxf(s[qq][kb][0], s[qq][kb][1]), fmaxf(s[qq][kb][2], s[qq][kb][3])));
                tmax = fmaxf(tmax, __shfl_xor(tmax, 16)); tmax = fmaxf(tmax, __shfl_xor(tmax, 32));
                const float mn = fmaxf(mrun[qb], raw ? tmax * scale : tmax);
                const float alpha = ex2(mrun[qb] - mn);
                mrun[qb] = mn;
                float psum = 0.f;
#pragma unroll
                for (int kb = 0; kb < 4; ++kb)
#pragma unroll
                    for (int r = 0; r < 4; ++r) { const float pv = raw ? ex2(__builtin_fmaf(s[qq][kb][r], scale, -mn)) : ex2(s[qq][kb][r] - mn); s[qq][kb][r] = pv; psum += pv; }
                lsum[qb] = lsum[qb] * alpha + psum;
                if (__builtin_amdgcn_ballot_w64(alpha != 1.f) != 0ull) {
#pragma unroll
                    for (int d = 0; d < 4; ++d) o[qb][d] = o[qb][d] * alpha;
                }
#pragma unroll
                for (int kk = 0; kk < 2; ++kk) {
                    u32x4 u;
                    u[0] = pk2(s[qq][2 * kk][0], s[qq][2 * kk][1]); u[1] = pk2(s[qq][2 * kk][2], s[qq][2 * kk][3]);
                    u[2] = pk2(s[qq][2 * kk + 1][0], s[qq][2 * kk + 1][1]); u[3] = pk2(s[qq][2 * kk + 1][2], s[qq][2 * kk + 1][3]);
                    pf[qq][kk] = as_bf(u);
                }
            }
            __builtin_amdgcn_sched_barrier(0);
#pragma unroll
            for (int kk = 0; kk < 2; ++kk)
#pragma unroll
                for (int d = 0; d < 4; ++d) {
                    const u32x2 vlo = *(const u32x2*)(vt_ + (d * 16 + c) * 72 + kk * 32 + g * 4);
                    const u32x2 vhi = *(const u32x2*)(vt_ + (d * 16 + c) * 72 + kk * 32 + 16 + g * 4);
                    u32x4 vv; vv[0] = vlo[0]; vv[1] = vlo[1]; vv[2] = vhi[0]; vv[3] = vhi[1];
                    const bf16x8 vf = as_bf(vv);
#pragma unroll
                    for (int qq = 0; qq < NQB; ++qq) o[qq][d] = mfma16(vf, pf[qq][kk], o[qq][d]);
                }
        }
        if (tt + 1 < ntiles) store_tile(cur ^ 1);
        __syncthreads();
    }
    if (dostore)
#pragma unroll
    for (int qb = 0; qb < NQB; ++qb) {
        float ls = lsum[qb];
        ls += __shfl_xor(ls, 16); ls += __shfl_xor(ls, 32);
        const float inv = __builtin_amdgcn_rcpf(ls);
        bf16_t* rowp = p.P + (size_t)(qbase + qb * qstep + c) * PC;
#pragma unroll
        for (int d = 0; d < 4; ++d) {
            const int dd = d * 16 + g * 4;
            const u32x2 gt = *(const u32x2*)(rowp + gcol + dd);
            const float v0 = o[qb][d][0] * inv * silu_f(lo16(gt[0])), v1 = o[qb][d][1] * inv * silu_f(hi16(gt[0]));
            const float v2 = o[qb][d][2] * inv * silu_f(lo16(gt[1])), v3 = o[qb][d][3] * inv * silu_f(hi16(gt[1]));
            u32x2 o2; o2.x = pk2(v0, v1); o2.y = pk2(v2, v3);
            *(u32x2*)(rowp + qcol + dd) = o2;
        }
    }
}

typedef float f32x16 __attribute__((ext_vector_type(16)));
__device__ __forceinline__ f32x16 mfma32(bf16x8 a, bf16x8 b, f32x16 c) { return __builtin_amdgcn_mfma_f32_32x32x16_bf16(a, b, c, 0, 0, 0); }

template <int MODE, bool FIXM>
__device__ void attn_item32(const Params& p, int l, int b, int i1, int i2, unsigned char* lds, float mfix, bool dostore = true) {
    const int t = tid_opaque(), lane = t & 63, w = t >> 6, h = lane >> 5, c = lane & 31;
    bf16_t* Ks = (bf16_t*)lds;
    bf16_t* Vt = Ks + 2 * 64 * 72;
    u32x4* Qs = (u32x4*)(lds + 36864) + w * 512;
    int qbase, qcol, kcol, vcol, gcol, ntiles;
    if (MODE == 0 || MODE == 1) {
        const int kvh = i1, qt = i2, head = kvh * 4 + w;
        qbase = (MODE == 0 ? b * 8192 : NTOK + b * 256) + qt * 64;
        qcol = C_GQ + head * 64; kcol = C_GK + kvh * 64; vcol = C_GV + kvh * 64; gcol = C_GG + head * 64;
        ntiles = MODE == 0 ? 132 : 4;
    } else {
        const int hh = i1;
        qbase = NTOK + b * 256 + w * 64;
        qcol = C_NQ + hh * 64; kcol = C_NK + hh * 64; vcol = C_NV + hh * 64; gcol = C_NG + hh * 64;
        ntiles = 4;
    }
    const float scale = MODE <= 1 ? 1.f : 0.125f * LOG2E;
    f32x16 o[2][2];
    float mrun[2], lsum[2];
#pragma unroll
    for (int qb = 0; qb < 2; ++qb) {
        mrun[qb] = -INFINITY; lsum[qb] = 0.f;
#pragma unroll
        for (int d = 0; d < 2; ++d)
#pragma unroll
            for (int r = 0; r < 16; ++r) o[qb][d][r] = 0.f;
    }
    const int kkey = t >> 3, kch = (t & 7) * 8;
    const int vkey = t & 63, vch = (t >> 6);
    u32x4 kr[2], vr[2];
    auto load_tile = [&](int tt) {
        const int base = MODE == 0 ? (tt < 128 ? b * 8192 + tt * 64 : NTOK + b * 256 + (tt - 128) * 64) : NTOK + b * 256 + tt * 64;
#pragma unroll
        for (int i = 0; i < 2; ++i) {
            kr[i] = ldg16(p.P + (size_t)(base + kkey + 32 * i) * PC + kcol + kch);
            if (MODE <= 1) vr[i] = ldg16(VG(p) + ((size_t)(b * 2 + i1) * 64 + kkey + 32 * i) * 8448 + (MODE == 0 ? tt * 64 : 8192 + tt * 64) + kch);
            else vr[i] = ldg16(p.P + (size_t)(base + vkey) * PC + vcol + (vch + 4 * i) * 8);
        }
    };
    auto store_tile = [&](int buf) {
        bf16_t* ks_ = Ks + buf * 64 * 72; bf16_t* vt_ = Vt + buf * 64 * 72;
#pragma unroll
        for (int i = 0; i < 2; ++i) {
            *(u32x4*)(ks_ + (kkey + 32 * i) * 72 + kch) = kr[i];
            if (MODE <= 1) { *(u32x4*)(vt_ + (kkey + 32 * i) * 72 + kch) = vr[i]; continue; }
#pragma unroll
            for (int e = 0; e < 4; ++e) {
                const int d = (vch + 4 * i) * 8 + 2 * e;
                vt_[d * 72 + vkey] = (bf16_t)(vr[i][e] & 0xffffu);
                vt_[(d + 1) * 72 + vkey] = (bf16_t)(vr[i][e] >> 16);
            }
        }
    };
    load_tile(0);
    __syncthreads();
#pragma unroll
    for (int qb = 0; qb < 2; ++qb)
#pragma unroll
        for (int ks = 0; ks < 4; ++ks) Qs[(qb * 4 + ks) * 64 + lane] = ldg16(p.P + (size_t)(qbase + qb * 32 + c) * PC + qcol + ks * 16 + h * 8);
    store_tile(0);
    __syncthreads();
    for (int tt = 0; tt < ntiles; ++tt) {
        const int cur = tt & 1;
        if (tt + 1 < ntiles) load_tile(tt + 1);
        const bf16_t* ks_ = Ks + cur * 64 * 72; const bf16_t* vt_ = Vt + cur * 64 * 72;
        f32x16 s[2][2];
#pragma unroll
        for (int qb = 0; qb < 2; ++qb)
#pragma unroll
            for (int kb = 0; kb < 2; ++kb)
#pragma unroll
                for (int r = 0; r < 16; ++r) s[qb][kb][r] = FIXM ? -mfix : 0.f;
#pragma unroll
        for (int ks = 0; ks < 4; ++ks) {
            const bf16x8 q0 = as_bf(Qs[ks * 64 + lane]), q1 = as_bf(Qs[(4 + ks) * 64 + lane]);
#pragma unroll
            for (int kb = 0; kb < 2; ++kb) {
                const bf16x8 kf = *(const bf16x8*)(ks_ + (kb * 32 + c) * 72 + ks * 16 + h * 8);
                s[0][kb] = mfma32(kf, q0, s[0][kb]);
                s[1][kb] = mfma32(kf, q1, s[1][kb]);
            }
        }
        bf16x8 pf[2][4];
#pragma unroll
        for (int qb = 0; qb < 2; ++qb) {
            float psum = 0.f;
            if (FIXM) {
#pragma unroll
                for (int kb = 0; kb < 2; ++kb)
#pragma unroll
                    for (int r = 0; r < 16; ++r) { const float pv = ex2(s[qb][kb][r]); s[qb][kb][r] = pv; psum += pv; }
                lsum[qb] += psum;
            } else {
                float tmax = s[qb][0][0];
#pragma unroll
                for (int kb = 0; kb < 2; ++kb)
#pragma unroll
                    for (int r = 0; r < 16; r += 4) tmax = fmaxf(tmax, fmaxf(fmaxf(s[qb][kb][r], s[qb][kb][r + 1]), fmaxf(s[qb][kb][r + 2], s[qb][kb][r + 3])));
                tmax = fmaxf(tmax, __shfl_xor(tmax, 32));
                const float mn = fmaxf(mrun[qb], tmax * scale);
                const float alpha = ex2(mrun[qb] - mn);
                mrun[qb] = mn;
#pragma unroll
                for (int kb = 0; kb < 2; ++kb)
#pragma unroll
                    for (int r = 0; r < 16; ++r) { const float pv = ex2(__builtin_fmaf(s[qb][kb][r], scale, -mn)); s[qb][kb][r] = pv; psum += pv; }
                lsum[qb] = lsum[qb] * alpha + psum;
                if (__builtin_amdgcn_ballot_w64(alpha != 1.f) != 0ull) {
#pragma unroll
                    for (int d = 0; d < 2; ++d)
#pragma unroll
                        for (int r = 0; r < 16; ++r) o[qb][d][r] *= alpha;
                }
            }
#pragma unroll
            for (int kb = 0; kb < 2; ++kb)
#pragma unroll
                for (int st = 0; st < 2; ++st) {
                    u32x4 u;
#pragma unroll
                    for (int e = 0; e < 4; ++e) u[e] = pk2(s[qb][kb][8 * st + 2 * e], s[qb][kb][8 * st + 2 * e + 1]);
                    pf[qb][kb * 2 + st] = as_bf(u);
                }
        }
#pragma unroll
        for (int kk = 0; kk < 4; ++kk)
#pragma unroll
            for (int d = 0; d < 2; ++d) {
                const u32x2 vlo = *(const u32x2*)(vt_ + (d * 32 + c) * 72 + kk * 16 + h * 4);
                const u32x2 vhi = *(const u32x2*)(vt_ + (d * 32 + c) * 72 + kk * 16 + 8 + h * 4);
                u32x4 vv; vv[0] = vlo[0]; vv[1] = vlo[1]; vv[2] = vhi[0]; vv[3] = vhi[1];
                const bf16x8 vf = as_bf(vv);
                o[0][d] = mfma32(vf, pf[0][kk], o[0][d]);
                o[1][d] = mfma32(vf, pf[1][kk], o[1][d]);
            }
        if (tt + 1 < ntiles) store_tile(cur ^ 1);
        __syncthreads();
    }
    if (dostore)
#pragma unroll
    for (int qb = 0; qb < 2; ++qb) {
        float ls = lsum[qb];
        ls += __shfl_xor(ls, 32);
        const float inv = __builtin_amdgcn_rcpf(ls);
        bf16_t* rowp = p.P + (size_t)(qbase + qb * 32 + c) * PC;
#pragma unroll
        for (int d = 0; d < 2; ++d)
#pragma unroll
            for (int rg = 0; rg < 4; ++rg) {
                const int dd = d * 32 + rg * 8 + h * 4;
                const u32x2 gt = *(const u32x2*)(rowp + gcol + dd);
                const float v0 = o[qb][d][rg * 4 + 0] * inv * silu_f(lo16(gt[0])), v1 = o[qb][d][rg * 4 + 1] * inv * silu_f(hi16(gt[0]));
                const float v2 = o[qb][d][rg * 4 + 2] * inv * silu_f(lo16(gt[1])), v3 = o[qb][d][rg * 4 + 3] * inv * silu_f(hi16(gt[1]));
                u32x2 o2; o2.x = pk2(v0, v1); o2.y = pk2(v2, v3);
                *(u32x2*)(rowp + qcol + dd) = o2;
            }
    }
}

__device__ __forceinline__ bf16x8 scale_frag(bf16x8 f, float sc) {
    u32x4 u = as_u(f), r;
#pragma unroll
    for (int e = 0; e < 4; ++e) r[e] = pk2(lo16(u[e]) * sc, hi16(u[e]) * sc);
    return as_bf(r);
}

__device__ void ret_item(const Params& p, int l, int b, int h, int cidx, int hf, unsigned char* lds, bool dostore = true) {
    const int t = tid_opaque(), lane = t & 63, w = t >> 6, g = lane >> 4, c = lane & 15;
    bf16_t* B0 = (bf16_t*)lds;
    bf16_t* B1 = B0 + 128 * 136;
    const float lgf = -__expf(p.ret_log_decay[l * 8 + h]) * LOG2E, lgb = -__expf(p.ret_log_decay[l * 8 + 4 + h]) * LOG2E;
    const float ksc = 0.08838834764831845f;
    const int rowbase = chunk_row(b, cidx);
    const int ti = hf * 64 + w * 16 + c;
    bf16x8 qf[4];
#pragma unroll
    for (int ks = 0; ks < 4; ++ks) qf[ks] = as_bf(ldg16(p.P + (size_t)(rowbase + ti) * PC + C_RQ + h * 128 + ks * 32 + g * 8));
    __syncthreads();
#pragma unroll
    for (int i = 0; i < 8; ++i) {
        const int cc = t + 256 * i;
        { const int r = cc >> 4, ch = cc & 15; *(u32x4*)(B0 + r * 136 + ch * 8) = ldg16(p.P + (size_t)(rowbase + r) * PC + C_RK + h * 128 + ch * 8); }
        { const int tok = cc & 127, ch = cc >> 7;
          const u32x4 vv = ldg16(p.P + (size_t)(rowbase + tok) * PC + C_RV + h * 128 + ch * 8);
#pragma unroll
          for (int e = 0; e < 4; ++e) { B1[(ch * 8 + 2 * e) * 136 + tok] = (bf16_t)(vv[e] & 0xffffu); B1[(ch * 8 + 2 * e + 1) * 136 + tok] = (bf16_t)(vv[e] >> 16); } }
    }
    __syncthreads();
    bf16x8 pf[4];
    {
        f32x4 s[8];
#pragma unroll
        for (int kb = 0; kb < 8; ++kb) s[kb] = (f32x4){0.f, 0.f, 0.f, 0.f};
#pragma unroll
        for (int ks = 0; ks < 4; ++ks)
#pragma unroll
            for (int kb = 0; kb < 8; ++kb) {
                const bf16x8 kf = *(const bf16x8*)(B0 + (kb * 16 + c) * 136 + ks * 32 + g * 8);
                s[kb] = mfma16(kf, qf[ks], s[kb]);
            }
#pragma unroll
        for (int kb = 0; kb < 8; ++kb)
#pragma unroll
            for (int r = 0; r < 4; ++r) {
                const int j = kb * 16 + g * 4 + r, d = ti - j;
                const float wgt = d > 0 ? ex2(lgf * (float)d) : (d < 0 ? ex2(lgb * (float)(-d)) : 2.f);
                s[kb][r] *= wgt * ksc;
            }
#pragma unroll
        for (int kk = 0; kk < 4; ++kk) {
            u32x4 u;
            u[0] = pk2(s[2 * kk][0], s[2 * kk][1]); u[1] = pk2(s[2 * kk][2], s[2 * kk][3]);
            u[2] = pk2(s[2 * kk + 1][0], s[2 * kk + 1][1]); u[3] = pk2(s[2 * kk + 1][2], s[2 * kk + 1][3]);
            pf[kk] = as_bf(u);
        }
    }
    f32x4 o[8];
#pragma unroll
    for (int d = 0; d < 8; ++d) o[d] = (f32x4){0.f, 0.f, 0.f, 0.f};
#pragma unroll
    for (int kk = 0; kk < 4; ++kk)
#pragma unroll
        for (int d = 0; d < 8; ++d) {
            const u32x2 vlo = *(const u32x2*)(B1 + (d * 16 + c) * 136 + kk * 32 + g * 4);
            const u32x2 vhi = *(const u32x2*)(B1 + (d * 16 + c) * 136 + kk * 32 + 16 + g * 4);
            u32x4 vv; vv[0] = vlo[0]; vv[1] = vlo[1]; vv[2] = vhi[0]; vv[3] = vhi[1];
            o[d] = mfma16(as_bf(vv), pf[kk], o[d]);
        }
    __syncthreads();
    {
        const bf16_t* Sf = p.SU + ((size_t)((0 * 4 + b) * 4 + h) * 66 + cidx) * 16384;
        const bf16_t* Sb = p.SU + ((size_t)((1 * 4 + b) * 4 + h) * 66 + cidx) * 16384;
#pragma unroll
        for (int i = 0; i < 8; ++i) {
            const int cc = t + 256 * i, r = cc >> 4, ch = cc & 15;
            *(u32x4*)(B0 + r * 136 + ch * 8) = ldg16(Sf + r * 128 + ch * 8);
            *(u32x4*)(B1 + r * 136 + ch * 8) = ldg16(Sb + r * 128 + ch * 8);
        }
    }
    __syncthreads();
#pragma unroll
    for (int dir = 0; dir < 2; ++dir) {
        const bf16_t* Bd = dir ? B1 : B0;
        const float xi = dir == 0 ? ex2(lgf * (float)(ti + 1)) : ex2(lgb * (float)(128 - ti));
        bf16x8 qs[4];
#pragma unroll
        for (int ks = 0; ks < 4; ++ks) qs[ks] = scale_frag(qf[ks], xi);
#pragma unroll
        for (int ks = 0; ks < 4; ++ks)
#pragma unroll
            for (int d = 0; d < 8; ++d) {
                const bf16x8 sf = *(const bf16x8*)(Bd + (d * 16 + c) * 136 + ks * 32 + g * 8);
                o[d] = mfma16(sf, qs[ks], o[d]);
            }
    }
    if (dostore) {
        float sum = 0.f;
#pragma unroll
        for (int d = 0; d < 8; ++d) sum += (o[d][0] + o[d][1]) + (o[d][2] + o[d][3]);
        sum += __shfl_xor(sum, 16); sum += __shfl_xor(sum, 32);
        const float mu = sum * (1.f / 128.f);
        float var = 0.f;
#pragma unroll
        for (int d = 0; d < 8; ++d)
#pragma unroll
            for (int r = 0; r < 4; ++r) { const float dd = o[d][r] - mu; var += dd * dd; }
        var += __shfl_xor(var, 16); var += __shfl_xor(var, 32);
        const float rstd = rsqrtf(var * (1.f / 128.f) + EPSN);
        bf16_t* rowp = p.P + (size_t)(rowbase + ti) * PC;
#pragma unroll
        for (int d = 0; d < 8; ++d) {
            const int dv = d * 16 + g * 4;
            const f32x4 gn = *(const f32x4*)(p.ret_gn_w + l * 512 + h * 128 + dv);
            const u32x2 gt = *(const u32x2*)(rowp + C_RG + h * 128 + dv);
            const float v0 = (o[d][0] - mu) * rstd * gn[0] * silu_f(lo16(gt[0])), v1 = (o[d][1] - mu) * rstd * gn[1] * silu_f(hi16(gt[0]));
            const float v2 = (o[d][2] - mu) * rstd * gn[2] * silu_f(lo16(gt[1])), v3 = (o[d][3] - mu) * rstd * gn[3] * silu_f(hi16(gt[1]));
            u32x2 o2; o2.x = pk2(v0, v1); o2.y = pk2(v2, v3);
            *(u32x2*)(rowp + C_RQ + h * 128 + dv) = o2;
        }
    }
}

__device__ void phase_d(const Params& p, int l, unsigned char* lds) {
    const bool need_ctx = l < 3;
    const int G = gridDim.x, bid = blockIdx.x;
    const bool small_first = bid >= (G >> 1);
    float mfix;
    {
        const int ln = tid_opaque() & 63;
        float wq = fabsf(p.q_norm_w[l * 64 + ln]), wk = fabsf(p.k_norm_w[l * 64 + ln]);
#pragma unroll
        for (int o = 32; o >= 1; o >>= 1) { wq = fmaxf(wq, __shfl_xor(wq, o)); wk = fmaxf(wk, __shfl_xor(wk, o)); }
        mfix = 64.f * wq * wk * (0.125f * LOG2E);
    }
    const bool usefix = mfix < 40.f;
#pragma unroll 1
    for (int stage = 0; stage < 3; ++stage) {
        const int kind = small_first ? (stage + 1) % 3 : stage;
        if (kind == 0) {
#pragma unroll 1
            for (int it = bid; it < 1024; it += G) {
                if (usefix) attn_item32<0, true>(p, l, it >> 8, (it >> 7) & 1, it & 127, lds, mfix);
                else attn_item32<0, false>(p, l, it >> 8, (it >> 7) & 1, it & 127, lds, 0.f);
            }
        } else if (kind == 1) {
#pragma unroll 1
            for (int it = bid; it < 2048; it += G) {
                attn_item<2>(p, l, it >> 9, (it >> 6) & 7, (it >> 2) & 15, it & 3, lds);
            }
        } else {
            const int nch = need_ctx ? 66 : 64, n_ret = nch * 32;
#pragma unroll 1
            for (int it = G - 1 - bid; it < n_ret; it += G) {
                const int hf = it & 1, it2 = it >> 1;
                const int cidx = it2 % nch, bh = it2 / nch;
                ret_item(p, l, bh >> 2, bh & 3, cidx, hf, lds);
            }
        }
        __syncthreads();
    }
    if (need_ctx) {
#pragma unroll 1
        for (int it = G - 1 - bid; it < 32; it += G) attn_item32<1, false>(p, l, it >> 3, (it >> 2) & 1, it & 3, lds, 0.f);
        __syncthreads();
#pragma unroll 1
        for (int it = G - 1 - bid - 32; it < 32; it += G) { if (it >= 0) attn_item32<3, false>(p, l, it >> 3, it & 7, 0, lds, 0.f); }
    }
}

__device__ __forceinline__ int xcd_tile(int it0) {
    if (gridDim.x != 512 || it0 >= 2048) return it0;
    const int xcd = it0 & 7, j = (it0 >> 3) & 63, r = it0 >> 9;
    const int li = j + 64 * r;
    return ((xcd * 32 + (li >> 3)) << 3) | (li & 7);
}

__device__ void phase_e1(const Params& p, int l, unsigned char* lds) {
    const int t = tid_opaque(), lane = t & 63, w = t >> 6, wm = w >> 1, wn = w & 1;
    const int nmt = l < 3 ? 264 : 256;
    const int total = nmt * 8;
    for (int it0 = blockIdx.x; it0 < total; it0 += gridDim.x) {
        const int item = xcd_tile(it0);
        const int mt = item >> 3, nt = item & 7;
        u32x2 macc[4][4];
#pragma unroll
        for (int a = 0; a < 4; ++a)
#pragma unroll
            for (int b = 0; b < 4; ++b) macc[a][b] = (u32x2){0u, 0u};
#pragma unroll 1
        for (int br = 0; br < 3; ++br) {
            u32x2 sg[4][4];
            {
                f32x4 gacc[4][4];
#pragma unroll
                for (int a = 0; a < 4; ++a)
#pragma unroll
                    for (int b = 0; b < 4; ++b) gacc[a][b] = (f32x4){0.f, 0.f, 0.f, 0.f};
                gemm_core<4>(gacc, p.HX + (size_t)mt * 128 * DM, DM, p.Wt + WT_IN + (size_t)(PC + br * 1024 + nt * 128) * DM, DM, DM, lds);
#pragma unroll
                for (int a = 0; a < 4; ++a)
#pragma unroll
                    for (int b = 0; b < 4; ++b) { sg[a][b].x = pk2(sigm_f(gacc[a][b][0]), sigm_f(gacc[a][b][1])); sg[a][b].y = pk2(sigm_f(gacc[a][b][2]), sigm_f(gacc[a][b][3])); }
            }
            f32x4 pacc[4][4];
#pragma unroll
            for (int a = 0; a < 4; ++a)
#pragma unroll
                for (int b = 0; b < 4; ++b) pacc[a][b] = (f32x4){0.f, 0.f, 0.f, 0.f};
            const int xcol = br == 0 ? C_RQ : (br == 1 ? C_NQ : C_GQ);
            const int woff = br == 0 ? WT_RET : (br == 1 ? WT_NA : WT_GQA);
            gemm_core<4>(pacc, p.P + (size_t)mt * 128 * PC + xcol, PC, p.Wt + woff + (size_t)nt * 128 * 512, 512, 512, lds);
#pragma unroll
            for (int a = 0; a < 4; ++a)
#pragma unroll
                for (int b = 0; b < 4; ++b) {
                    const float m0 = lo16(macc[a][b].x) + lo16(sg[a][b].x) * pacc[a][b][0], m1 = hi16(macc[a][b].x) + hi16(sg[a][b].x) * pacc[a][b][1];
                    const float m2 = lo16(macc[a][b].y) + lo16(sg[a][b].y) * pacc[a][b][2], m3 = hi16(macc[a][b].y) + hi16(sg[a][b].y) * pacc[a][b][3];
                    macc[a][b].x = pk2(m0, m1); macc[a][b].y = pk2(m2, m3);
                }
        }
#pragma unroll
        for (int ni = 0; ni < 4; ++ni)
#pragma unroll
            for (int mi = 0; mi < 4; ++mi) {
                const int n = nt * 128 + wn * 64 + ni * 16 + (lane >> 4) * 4, m = mt * 128 + wm * 64 + mi * 16 + (lane & 15);
                *(u32x2*)(p.P + (size_t)m * PC + C_M + n) = macc[ni][mi];
            }
    }
}

__device__ void phase_e2(const Params& p, int l, unsigned char* lds, bool dostore = true) {
    const int t = tid_opaque(), lane = t & 63, w = t >> 6, wm = w >> 1, wn = w & 1;
    const int nmt = l < 3 ? 264 : 256;
    const int total = nmt * 8;
    const float* xsrc = l == 0 ? p.x : p.out;
    const float* ysrc = l == 0 ? p.ctx : p.y;
    for (int it0 = blockIdx.x; it0 < total; it0 += gridDim.x) {
        const int item = xcd_tile(it0);
        const int mt = item >> 3, nt = item & 7;
        f32x4 acc[4][4];
#pragma unroll
        for (int a = 0; a < 4; ++a)
#pragma unroll
            for (int b = 0; b < 4; ++b) acc[a][b] = (f32x4){0.f, 0.f, 0.f, 0.f};
        gemm_core<4>(acc, p.P + (size_t)mt * 128 * PC + C_M, PC, p.Wt + WT_OUT + (size_t)nt * 128 * DM, DM, DM, lds);
#pragma unroll
        for (int mi = 0; mi < 4; ++mi) {
            const int m = mt * 128 + wm * 64 + mi * 16 + (lane & 15);
            const bool lat = m < NTOK;
            const int bb = lat ? (m >> 13) : 4;
            const float* src = lat ? xsrc + (size_t)m * DM : ysrc + (size_t)(m - NTOK) * DM;
            float* dst = lat ? p.out + (size_t)m * DM : p.y + (size_t)(m - NTOK) * DM;
            const float* gate = p.mod + (size_t)(l * 5 + bb) * 3072 + 2048;
#pragma unroll
            for (int ni = 0; ni < 4; ++ni) {
                const int n = nt * 128 + wn * 64 + ni * 16 + (lane >> 4) * 4;
                const f32x4 xo = *(const f32x4*)(src + n), gv = *(const f32x4*)(gate + n);
                if (dostore) *(f32x4*)(dst + n) = xo + gv * acc[ni][mi];
            }
        }
    }
}

__device__ void phase_e3(const Params& p, int l, unsigned char* lds) {
    norm_rows(p, l + 1, p.out, p.y);
    if (l < 3)
        for (int item = blockIdx.x; item < NCONV_ITEMS; item += gridDim.x) convert_item(p, l + 1, item, lds);
}


__device__ __forceinline__ void run_phase(const Params& p, int ph, int l, unsigned char* lds) {
    switch (ph) {
        case 0: phase_p0(p, lds);
            break;
        case 1: norm_rows(p, 0, p.x, p.ctx); break;
        case 2: phase_a(p, l, lds);
            break;
        case 3: phase_b(p, l, lds); break;
        case 4:
            phase_c(p, l); break;
        case 5: phase_d(p, l, lds); break;
        case 6: phase_e1(p, l, lds);
            break;
        case 7:
            phase_e2(p, l, lds); break;
        default: phase_e3(p, l, lds);
            break;
    }
}

__device__ __forceinline__ void fast_grid_barrier(unsigned* bar, unsigned k) {
    asm volatile("s_waitcnt vmcnt(0) lgkmcnt(0)" ::: "memory");
    __syncthreads();
    if (threadIdx.x == 0) {
        const unsigned grp = blockIdx.x & 7u, members = (gridDim.x - grp + 7u) >> 3;
        __builtin_amdgcn_fence(__ATOMIC_RELEASE, "agent");
        const unsigned old = __hip_atomic_fetch_add(bar + grp * 32, 1u, __ATOMIC_RELAXED, __HIP_MEMORY_SCOPE_AGENT);
        if (old + 1u == k * members) {
            __hip_atomic_fetch_add(bar + 256, 1u, __ATOMIC_RELAXED, __HIP_MEMORY_SCOPE_AGENT);
            while (__hip_atomic_load(bar + 256, __ATOMIC_RELAXED, __HIP_MEMORY_SCOPE_AGENT) < k * 8u) __builtin_amdgcn_s_sleep(1);
            __hip_atomic_store(bar + 288 + grp * 32, k, __ATOMIC_RELAXED, __HIP_MEMORY_SCOPE_AGENT);
        } else {
            while (__hip_atomic_load(bar + 288 + grp * 32, __ATOMIC_RELAXED, __HIP_MEMORY_SCOPE_AGENT) < k) __builtin_amdgcn_s_sleep(1);
        }
        __builtin_amdgcn_fence(__ATOMIC_ACQUIRE, "agent");
    }
    __syncthreads();
}
#define GSYNC() do { asm volatile("s_waitcnt vmcnt(0) lgkmcnt(0)" ::: "memory"); grid.sync(); } while (0)
__global__ void __launch_bounds__(256, 2) mega_kernel(Params p) {
    __shared__ __attribute__((aligned(16))) unsigned char lds[LDS_BYTES];
    cg::grid_group grid = cg::this_grid();
    unsigned bk = 0;
    run_phase(p, 0, 0, lds); GSYNC();
    run_phase(p, 1, 0, lds); fast_grid_barrier(p.bar, ++bk);
    for (int l = 0; l < 4; ++l) {
#pragma unroll 1
        for (int ph = 2; ph <= 8; ++ph) {
            run_phase(p, ph, l, lds);
            if (!(l == 3 && ph == 8)) fast_grid_barrier(p.bar, ++bk);
        }
    }
}

extern "C" void kernel_launch(void* const* d_in, const int* in_sizes, int n_in, void* d_out, int out_size, void* d_ws, size_t ws_size, hipStream_t stream) {
    Params p{};
    p.x = (const float*)d_in[0]; p.c = (const float*)d_in[1]; p.ctx = (const float*)d_in[2]; p.c_ctx = (const float*)d_in[3];
    p.ada_w = (const float*)d_in[4]; p.ada_b = (const float*)d_in[5]; p.norm_w = (const float*)d_in[6]; p.w_in = (const float*)d_in[7];
    p.ret_log_decay = (const float*)d_in[8]; p.ret_gn_w = (const float*)d_in[9]; p.na_rpb = (const float*)d_in[10];
    p.q_norm_w = (const float*)d_in[11]; p.k_norm_w = (const float*)d_in[12]; p.w_ret_o = (const float*)d_in[13];
    p.w_na_o = (const float*)d_in[14]; p.w_gqa_o = (const float*)d_in[15]; p.w_out = (const float*)d_in[16]; p.final_norm_w = (const float*)d_in[17];
    p.out = (float*)d_out;
    unsigned char* ws = (unsigned char*)d_ws;
    size_t off = 0;
    p.P = (bf16_t*)(ws + off); off += (size_t)NROWS * PC * 2;
    p.HX = (bf16_t*)(ws + off); off += (size_t)NROWS * DM * 2;
    p.Wt = (bf16_t*)(ws + off); off += (size_t)WT_TOTAL * 2;
    p.SU = (bf16_t*)(ws + off); off += (size_t)2 * 4 * 4 * 66 * 16384 * 2;
    p.y = (float*)(ws + off); off += (size_t)1024 * 1024 * 4;
    p.mod = (float*)(ws + off); off += (size_t)4 * 5 * 3072 * 4;
    p.rope = (float*)(ws + off); off += (size_t)128 * 16 * 2 * 4 + 256;
    p.bar = (unsigned*)(ws + off); off += 4096;
    off += (size_t)4 * 2 * 64 * 8448 * 2;
    if (off > ws_size) { fprintf(stderr, "workspace too small: need %zu have %zu\n", off, ws_size); return; }
    static int grid_blocks = 0;
    if (!grid_blocks) {
        int dev = 0, cus = 0, per_cu = 0;
        hipGetDevice(&dev);
        hipDeviceGetAttribute(&cus, hipDeviceAttributeMultiprocessorCount, dev);
        hipOccupancyMaxActiveBlocksPerMultiprocessor(&per_cu, mega_kernel, 256, 0);
        if (per_cu > 2) per_cu = 2;
        grid_blocks = cus * per_cu;
    }
    hipMemsetAsync(p.bar, 0, 4096, stream);
    void* args[] = {&p};
    hipError_t e = hipLaunchCooperativeKernel((void*)mega_kernel, dim3(grid_blocks), dim3(256), args, 0, stream);
    if (e != hipSuccess) fprintf(stderr, "cooperative launch failed: %s (grid %d)\n", hipGetErrorString(e), grid_blocks);
}
```

```cpp
#include <hip/hip_runtime.h>
#include <hip/hip_cooperative_groups.h>
#include <cstdio>
#include <cstdint>
namespace cg = cooperative_groups;


typedef unsigned short bf16_t;
typedef short bf16x8 __attribute__((ext_vector_type(8)));
typedef float f32x4 __attribute__((ext_vector_type(4)));
typedef unsigned u32x4 __attribute__((ext_vector_type(4)));
typedef unsigned u32x2 __attribute__((ext_vector_type(2)));

#define DM 1024
#define NTOK 32768
#define NROWS 33792
#define PC 5376
#define INC 8448
#define LOG2E 1.4426950408889634f
#define EPSN 1e-6f
#define LDS_BYTES 73728

#define C_RQ 0
#define C_RK 512
#define C_RV 1024
#define C_RG 1536
#define C_NQ 2048
#define C_NK 2560
#define C_NV 3072
#define C_NG 3584
#define C_GQ 4096
#define C_GK 4608
#define C_GV 4736
#define C_GG 4864
#define C_M  512

#define WT_IN 0
#define WT_RET (8448 * 1024)
#define WT_NA (WT_RET + 1024 * 512)
#define WT_GQA (WT_NA + 1024 * 512)
#define WT_OUT (WT_GQA + 1024 * 512)
#define WT_TOTAL (WT_OUT + 1024 * 1024)

#define VG(p) ((bf16_t*)((unsigned char*)(p).bar + 4096))
struct Params {
    const float *x, *c, *ctx, *c_ctx, *ada_w, *ada_b, *norm_w, *w_in, *ret_log_decay, *ret_gn_w, *na_rpb, *q_norm_w, *k_norm_w,
        *w_ret_o, *w_na_o, *w_gqa_o, *w_out, *final_norm_w;
    float* out;
    bf16_t* P;
    bf16_t* HX;
    bf16_t* Wt;
    bf16_t* SU;
    float* y;
    float* mod;
    float* rope;
    unsigned* bar;
};

__device__ __forceinline__ int tid_opaque() { int t = threadIdx.x; asm volatile("" : "+v"(t)); return t; }
__device__ __forceinline__ float bf2f(bf16_t v) { return __uint_as_float(((unsigned)v) << 16); }
typedef __bf16 bf16x2_t __attribute__((ext_vector_type(2)));
typedef float f32x2_t __attribute__((ext_vector_type(2)));
__device__ __forceinline__ unsigned pk2(float lo, float hi) {
    f32x2_t v = {lo, hi};
    union { bf16x2_t b; unsigned u; } x; x.b = __builtin_convertvector(v, bf16x2_t); return x.u;
}
__device__ __forceinline__ bf16_t f2bf(float f) { return (bf16_t)(pk2(f, 0.f) & 0xffffu); }
__device__ __forceinline__ float lo16(unsigned u) { return __uint_as_float(u << 16); }
__device__ __forceinline__ float hi16(unsigned u) { return __uint_as_float(u & 0xffff0000u); }
__device__ __forceinline__ float ex2(float x) { return __builtin_amdgcn_exp2f(x); }
__device__ __forceinline__ float silu_f(float x) { return x * __builtin_amdgcn_rcpf(1.f + ex2(-x * LOG2E)); }
__device__ __forceinline__ float sigm_f(float x) { return __builtin_amdgcn_rcpf(1.f + ex2(-x * LOG2E)); }
__device__ __forceinline__ f32x4 mfma16(bf16x8 a, bf16x8 b, f32x4 c) { return __builtin_amdgcn_mfma_f32_16x16x32_bf16(a, b, c, 0, 0, 0); }
__device__ __forceinline__ bf16x8 as_bf(u32x4 u) { union { u32x4 a; bf16x8 b; } x; x.a = u; return x.b; }
__device__ __forceinline__ u32x4 as_u(bf16x8 u) { union { u32x4 a; bf16x8 b; } x; x.b = u; return x.a; }
__device__ __forceinline__ u32x4 ldg16(const bf16_t* p) { return *(const u32x4*)p; }

template <int NI>
__device__ __forceinline__ void gemm_core(f32x4 (&acc)[NI][4], const bf16_t* __restrict__ X, int ldx, const bf16_t* __restrict__ W, int ldw, int K, unsigned char* lds) {
    const int t = tid_opaque(), lane = t & 63, w = t >> 6, wm = w >> 1, wn = w & 1;
    bf16_t* Xs = (bf16_t*)lds;
    bf16_t* Ws = Xs + 2 * 128 * 72;
    const int sr = t >> 3, sc = (t & 7) * 8;
    const bf16_t* xg = X + (size_t)sr * ldx + sc;
    const bf16_t* wg = W + (size_t)sr * ldw + sc;
    u32x4 xr[4], wr[NI];
#pragma unroll
    for (int i = 0; i < 4; ++i) xr[i] = ldg16(xg + (size_t)i * 32 * ldx);
#pragma unroll
    for (int i = 0; i < NI; ++i) wr[i] = ldg16(wg + (size_t)i * 32 * ldw);
    __syncthreads();
#pragma unroll
    for (int i = 0; i < 4; ++i) *(u32x4*)(Xs + (sr + i * 32) * 72 + sc) = xr[i];
#pragma unroll
    for (int i = 0; i < NI; ++i) *(u32x4*)(Ws + (sr + i * 32) * 72 + sc) = wr[i];
    __syncthreads();
    const int nk = K >> 6;
    for (int kt = 0; kt < nk; ++kt) {
        const int cur = kt & 1;
        if (kt + 1 < nk) {
            const int ko = (kt + 1) * 64;
#pragma unroll
            for (int i = 0; i < 4; ++i) xr[i] = ldg16(xg + (size_t)i * 32 * ldx + ko);
#pragma unroll
            for (int i = 0; i < NI; ++i) wr[i] = ldg16(wg + (size_t)i * 32 * ldw + ko);
        }
        __builtin_amdgcn_sched_barrier(0);
        const bf16_t* xs = Xs + cur * 128 * 72 + (wm * 64 + (lane & 15)) * 72 + (lane >> 4) * 8;
        const bf16_t* ws = Ws + cur * 128 * 72 + (wn * (NI * 16) + (lane & 15)) * 72 + (lane >> 4) * 8;
#pragma unroll
        for (int ks = 0; ks < 2; ++ks) {
            bf16x8 xf[4], wf[NI];
#pragma unroll
            for (int i = 0; i < 4; ++i) xf[i] = *(const bf16x8*)(xs + i * 16 * 72 + ks * 32);
#pragma unroll
            for (int i = 0; i < NI; ++i) wf[i] = *(const bf16x8*)(ws + i * 16 * 72 + ks * 32);
#pragma unroll
            for (int ni = 0; ni < NI; ++ni)
#pragma unroll
                for (int mi = 0; mi < 4; ++mi) acc[ni][mi] = mfma16(wf[ni], xf[mi], acc[ni][mi]);
        }
        if (kt + 1 < nk) {
            const int nx = cur ^ 1;
#pragma unroll
            for (int i = 0; i < 4; ++i) *(u32x4*)(Xs + nx * 128 * 72 + (sr + i * 32) * 72 + sc) = xr[i];
#pragma unroll
            for (int i = 0; i < NI; ++i) *(u32x4*)(Ws + nx * 128 * 72 + (sr + i * 32) * 72 + sc) = wr[i];
        }
        __syncthreads();
    }
}

__device__ __forceinline__ void gemm_big(f32x4 (&acc)[4][8], const bf16_t* __restrict__ X, int ldx, const bf16_t* __restrict__ W, int ldw, int K, unsigned char* lds) {
    const int t = tid_opaque(), lane = t & 63, w = t >> 6, wm = w >> 1, wn = w & 1;
    bf16_t* Xs = (bf16_t*)lds;
    bf16_t* Ws = Xs + 2 * 256 * 40;
    const int sr = t >> 2, sc = (t & 3) * 8;
    const bf16_t* xg = X + (size_t)sr * ldx + sc;
    const bf16_t* wg = W + (size_t)sr * ldw + sc;
    u32x4 ra[6], rb[6];
#define GB_LOAD(r, ko) do { _Pragma("unroll") for (int i = 0; i < 4; ++i) r[i] = ldg16(xg + (size_t)i * 64 * ldx + (ko)); _Pragma("unroll") for (int i = 0; i < 2; ++i) r[4 + i] = ldg16(wg + (size_t)i * 64 * ldw + (ko)); } while (0)
#define GB_ST1(r, st, i) do { if ((i) < 4) *(u32x4*)(Xs + (st) * 256 * 40 + (sr + (i) * 64) * 40 + sc) = r[i]; else *(u32x4*)(Ws + (st) * 128 * 40 + (sr + ((i) - 4) * 64) * 40 + sc) = r[i]; } while (0)
#define GB_STEP(st, r, dostore) do { \
        const bf16_t* xs = Xs + (st) * 256 * 40 + (wm * 128 + (lane & 15)) * 40 + (lane >> 4) * 8; \
        const bf16_t* ws = Ws + (st) * 128 * 40 + (wn * 64 + (lane & 15)) * 40 + (lane >> 4) * 8; \
        bf16x8 wf[4]; \
        _Pragma("unroll") for (int i = 0; i < 4; ++i) wf[i] = *(const bf16x8*)(ws + i * 16 * 40); \
        _Pragma("unroll") for (int mi = 0; mi < 8; ++mi) { \
            const bf16x8 xf = *(const bf16x8*)(xs + mi * 16 * 40); \
            _Pragma("unroll") for (int ni = 0; ni < 4; ++ni) acc[ni][mi] = mfma16(wf[ni], xf, acc[ni][mi]); \
            if ((dostore) && mi >= 1 && mi <= 6) GB_ST1(r, (st) ^ 1, mi - 1); } } while (0)
    GB_LOAD(ra, 0);
    GB_LOAD(rb, 32);
    __syncthreads();
#pragma unroll
    for (int i = 0; i < 6; ++i) GB_ST1(ra, 0, i);
    __syncthreads();
    const int nk = K >> 5;
    for (int kt = 0; kt < nk; kt += 2) {
        if (kt + 2 < nk) GB_LOAD(ra, (kt + 2) * 32);
        GB_STEP(0, rb, true);
        __syncthreads();
        if (kt + 3 < nk) GB_LOAD(rb, (kt + 3) * 32);
        GB_STEP(1, ra, kt + 2 < nk);
        __syncthreads();
    }
#undef GB_LOAD
#undef GB_ST1
#undef GB_STEP
}

__device__ void adaln_item(const Params& p, int item, unsigned char* lds) {
    const int t = tid_opaque(), lane = t & 63, w = t >> 6;
    const int l = item / 48, cgp = item % 48, j = cgp * 64 + lane;
    float* cs = (float*)lds;
    float* red = (float*)(lds + 20480);
    __syncthreads();
    for (int idx = t; idx < 5120; idx += 256) {
        const int bb = idx >> 10, k = idx & 1023;
        const float v = bb < 4 ? p.c[bb * 1024 + k] : p.c_ctx[k];
        cs[idx] = silu_f(v);
    }
    __syncthreads();
    float a0 = 0.f, a1 = 0.f, a2 = 0.f, a3 = 0.f, a4 = 0.f;
    const float* aw = p.ada_w + ((size_t)l * 1024 + w * 256) * 3072 + j;
    for (int k = 0; k < 256; ++k) {
        const float wv = aw[(size_t)k * 3072];
        const int kk = w * 256 + k;
        a0 += cs[kk] * wv; a1 += cs[1024 + kk] * wv; a2 += cs[2048 + kk] * wv; a3 += cs[3072 + kk] * wv; a4 += cs[4096 + kk] * wv;
    }
    red[(w * 5 + 0) * 64 + lane] = a0; red[(w * 5 + 1) * 64 + lane] = a1; red[(w * 5 + 2) * 64 + lane] = a2;
    red[(w * 5 + 3) * 64 + lane] = a3; red[(w * 5 + 4) * 64 + lane] = a4;
    __syncthreads();
    for (int idx = t; idx < 320; idx += 256) {
        const int bb = idx >> 6, ln = idx & 63;
        float v = p.ada_b[l * 3072 + cgp * 64 + ln];
#pragma unroll
        for (int ww = 0; ww < 4; ++ww) v += red[(ww * 5 + bb) * 64 + ln];
        p.mod[(l * 5 + bb) * 3072 + cgp * 64 + ln] = v;
    }
}

__device__ void transpose_tile(const float* __restrict__ src, int N, bf16_t* __restrict__ dst, int K, int k0, int n0, unsigned char* lds) {
    const int t = tid_opaque();
    bf16_t* T = (bf16_t*)lds;
    __syncthreads();
#pragma unroll
    for (int i = 0; i < 4; ++i) {
        const int k = (t >> 4) + 16 * i, n4 = (t & 15) * 4;
        const f32x4 v = *(const f32x4*)(src + (size_t)(k0 + k) * N + n0 + n4);
        T[(n4 + 0) * 72 + k] = f2bf(v[0]); T[(n4 + 1) * 72 + k] = f2bf(v[1]); T[(n4 + 2) * 72 + k] = f2bf(v[2]); T[(n4 + 3) * 72 + k] = f2bf(v[3]);
    }
    __syncthreads();
#pragma unroll
    for (int i = 0; i < 2; ++i) {
        const int cidx = t + 256 * i, n = cidx >> 3, kc = cidx & 7;
        *(u32x4*)(dst + (size_t)(n0 + n) * K + k0 + kc * 8) = *(const u32x4*)(T + n * 72 + kc * 8);
    }
}

#define NCONV_ITEMS (2112 + 3 * 128 + 256)
__device__ void convert_item(const Params& p, int l, int item, unsigned char* lds) {
    if (item < 2112) {
        const int kt = item / 132, nt = item % 132;
        transpose_tile(p.w_in + (size_t)l * 1024 * INC, INC, p.Wt + WT_IN, 1024, kt * 64, nt * 64, lds);
    } else if (item < 2112 + 384) {
        const int it = item - 2112, which = it / 128, r = it % 128, kt = r / 16, nt = r % 16;
        const float* src = (which == 0 ? p.w_ret_o : which == 1 ? p.w_na_o : p.w_gqa_o) + (size_t)l * 512 * 1024;
        bf16_t* dst = p.Wt + (which == 0 ? WT_RET : which == 1 ? WT_NA : WT_GQA);
        transpose_tile(src, 1024, dst, 512, kt * 64, nt * 64, lds);
    } else {
        const int it = item - 2112 - 384, kt = it / 16, nt = it % 16;
        transpose_tile(p.w_out + (size_t)l * 1024 * 1024, 1024, p.Wt + WT_OUT, 1024, kt * 64, nt * 64, lds);
    }
}

__device__ void rope_table(const Params& p) {
    for (int idx = tid_opaque(); idx < 2048; idx += 256) {
        const int pos = idx >> 4, i = idx & 15;
        const float f = ex2(-(float)i * (13.287712379549449f / 16.f));
        const float ang = (float)pos * f;
        float rev = ang * 0.15915494309189535f;
        rev = rev - rintf(rev);
        p.rope[idx * 2 + 0] = __builtin_amdgcn_cosf(rev);
        p.rope[idx * 2 + 1] = __builtin_amdgcn_sinf(rev);
    }
}

__device__ void phase_p0(const Params& p, unsigned char* lds) {
    const int total = 192 + NCONV_ITEMS + 1;
    for (int item = blockIdx.x; item < total; item += gridDim.x) {
        if (item < 192) adaln_item(p, item, lds);
        else if (item < 192 + NCONV_ITEMS) convert_item(p, 0, item - 192, lds);
        else rope_table(p);
    }
}

__device__ void norm_rows(const Params& p, int lnext, const float* xsrc, const float* ysrc) {
    const int t = tid_opaque(), lane = t & 63, w = t >> 6;
    const int nrows = lnext < 4 ? NROWS : NTOK;
    for (int row = blockIdx.x * 4 + w; row < nrows; row += gridDim.x * 4) {
        const float* src = row < NTOK ? xsrc + (size_t)row * DM : ysrc + (size_t)(row - NTOK) * DM;
        f32x4 v[4];
        float ss = 0.f;
#pragma unroll
        for (int i = 0; i < 4; ++i) { v[i] = *(const f32x4*)(src + i * 256 + lane * 4); ss += v[i][0] * v[i][0] + v[i][1] * v[i][1] + v[i][2] * v[i][2] + v[i][3] * v[i][3]; }
#pragma unroll
        for (int o = 32; o >= 1; o >>= 1) ss += __shfl_xor(ss, o);
        const float rstd = rsqrtf(ss * (1.f / 1024.f) + EPSN);
        if (lnext < 4) {
            const int bb = row < NTOK ? (row >> 13) : 4;
            const float* md = p.mod + (size_t)(lnext * 5 + bb) * 3072;
            const float* nw = p.norm_w + lnext * 1024;
#pragma unroll
            for (int i = 0; i < 4; ++i) {
                const int col = i * 256 + lane * 4;
                const f32x4 nwv = *(const f32x4*)(nw + col), sh = *(const f32x4*)(md + col), scl = *(const f32x4*)(md + 1024 + col);
                f32x4 h = v[i] * rstd * nwv * (scl + 1.f) + sh;
                u32x2 o2; o2.x = pk2(h[0], h[1]); o2.y = pk2(h[2], h[3]);
                *(u32x2*)(p.HX + (size_t)row * DM + col) = o2;
            }
        } else {
#pragma unroll
            for (int i = 0; i < 4; ++i) {
                const int col = i * 256 + lane * 4;
                const f32x4 nwv = *(const f32x4*)(p.final_norm_w + col);
                f32x4 ov = v[i] * rstd * nwv;
                *(f32x4*)(p.out + (size_t)row * DM + col) = ov;
            }
        }
    }
}

__device__ void phase_a(const Params& p, int l, unsigned char* lds) {
    const int t = tid_opaque(), lane = t & 63, w = t >> 6, wm = w >> 1, wn = w & 1;
    const int total = 132 * 42;
    const bool xmap = (gridDim.x & 7) == 0;
    const int per = xmap ? (total + 7) / 8 : total;
    const int lo = xmap ? (int)(blockIdx.x & 7) * per : 0, hi = min(lo + per, total);
    const int step = xmap ? (int)(gridDim.x >> 3) : (int)gridDim.x;
    for (int idx = lo + (xmap ? (int)(blockIdx.x >> 3) : (int)blockIdx.x); idx < hi; idx += step) {
        const int nb = idx / 924, rem = idx - nb * 924;
        const int mt = rem / 7, nt = nb * 7 + (rem - mt * 7);
        f32x4 acc[4][8];
#pragma unroll
        for (int a = 0; a < 4; ++a)
#pragma unroll
            for (int b = 0; b < 8; ++b) acc[a][b] = (f32x4){0.f, 0.f, 0.f, 0.f};
        gemm_big(acc, p.HX + (size_t)mt * 256 * DM, DM, p.Wt + WT_IN + (size_t)nt * 128 * DM, DM, DM, lds);
#pragma unroll
        for (int ni = 0; ni < 4; ++ni)
#pragma unroll
            for (int mi = 0; mi < 8; ++mi) {
                const int n = nt * 128 + wn * 64 + ni * 16 + (lane >> 4) * 4, m = mt * 256 + wm * 128 + mi * 16 + (lane & 15);
                u32x2 o2; o2.x = pk2(acc[ni][mi][0], acc[ni][mi][1]); o2.y = pk2(acc[ni][mi][2], acc[ni][mi][3]);
                *(u32x2*)(p.P + (size_t)m * PC + n) = o2;
            }
    }
}

__device__ __forceinline__ int chunk_row(int b, int cidx) { return cidx < 64 ? b * 8192 + cidx * 128 : NTOK + b * 256 + (cidx - 64) * 128; }

__device__ void ret_state_item(const Params& p, int l, int b, int h, int cidx, unsigned char* lds) {
    const int t = tid_opaque(), lane = t & 63, w = t >> 6, g = lane >> 4, c = lane & 15;
    bf16_t* Ktf = (bf16_t*)lds;
    bf16_t* Vt = Ktf + 128 * 72;
    const float lgf = -__expf(p.ret_log_decay[l * 8 + h]) * LOG2E, lgb = -__expf(p.ret_log_decay[l * 8 + 4 + h]) * LOG2E;
    const float ksc = 0.08838834764831845f;
    const int rowbase = chunk_row(b, cidx);
    for (int dir = 0; dir < 2; ++dir) {
        f32x4 acc[2][8];
#pragma unroll
        for (int i = 0; i < 2; ++i)
#pragma unroll
            for (int d = 0; d < 8; ++d) acc[i][d] = (f32x4){0.f, 0.f, 0.f, 0.f};
        const float lg = dir ? lgb : lgf;
#pragma unroll 1
        for (int half = 0; half < 2; ++half) {
            __syncthreads();
#pragma unroll
            for (int i = 0; i < 4; ++i) {
                const int cc = t + 256 * i, tok = cc & 63, dch = cc >> 6, j = half * 64 + tok;
                const float wgt = ex2(lg * (float)(dir ? j : 127 - j)) * ksc;
                const bf16_t* rp = p.P + (size_t)(rowbase + j) * PC + h * 128 + dch * 8;
                const u32x4 kv = ldg16(rp + C_RK), vv = ldg16(rp + C_RV);
#pragma unroll
                for (int e = 0; e < 4; ++e) {
                    const int r0 = (dch * 8 + 2 * e) * 72 + tok, r1 = r0 + 72;
                    Ktf[r0] = f2bf(lo16(kv[e]) * wgt); Ktf[r1] = f2bf(hi16(kv[e]) * wgt);
                    Vt[r0] = (bf16_t)(vv[e] & 0xffffu); Vt[r1] = (bf16_t)(vv[e] >> 16);
                }
            }
            __syncthreads();
#pragma unroll
            for (int ks = 0; ks < 2; ++ks) {
                bf16x8 kf[2];
#pragma unroll
                for (int i = 0; i < 2; ++i) kf[i] = *(const bf16x8*)(Ktf + (w * 32 + i * 16 + c) * 72 + ks * 32 + g * 8);
#pragma unroll
                for (int d = 0; d < 8; ++d) {
                    const bf16x8 vf = *(const bf16x8*)(Vt + (d * 16 + c) * 72 + ks * 32 + g * 8);
#pragma unroll
                    for (int i = 0; i < 2; ++i) acc[i][d] = mfma16(kf[i], vf, acc[i][d]);
                }
            }
        }
        bf16_t* Sd = p.SU + ((size_t)((dir * 4 + b) * 4 + h) * 66 + cidx) * 16384;
#pragma unroll
        for (int i = 0; i < 2; ++i)
#pragma unroll
            for (int d = 0; d < 8; ++d) {
                const int dk = w * 32 + i * 16 + g * 4, dv = d * 16 + c;
                u32x2 o2; o2.x = pk2(acc[i][d][0], acc[i][d][1]); o2.y = pk2(acc[i][d][2], acc[i][d][3]);
                *(u32x2*)(Sd + dv * 128 + dk) = o2;
            }
    }
}

__device__ void qk_prep_item(const Params& p, int l, int item) {
    const int t = tid_opaque(), tok = t >> 2, sub = t & 3;
    const int row = item * 64 + tok;
    const bool lat = row < NTOK;
    const int tseq = row & 8191, pr = tseq >> 6, pc = tseq & 63;
    for (int hv = sub; hv < 10; hv += 4) {
        bf16_t* ptr = p.P + (size_t)row * PC + (hv < 8 ? C_GQ + hv * 64 : C_GK + (hv - 8) * 64);
        const float* nw = hv < 8 ? p.q_norm_w + l * 64 : p.k_norm_w + l * 64;
        float x[64];
        float ss = 0.f;
#pragma unroll
        for (int i = 0; i < 8; ++i) {
            const u32x4 u = ldg16(ptr + i * 8);
#pragma unroll
            for (int e = 0; e < 4; ++e) { x[i * 8 + 2 * e] = lo16(u[e]); x[i * 8 + 2 * e + 1] = hi16(u[e]); }
        }
#pragma unroll
        for (int d = 0; d < 64; ++d) ss += x[d] * x[d];
        const float rstd = rsqrtf(ss * (1.f / 64.f) + EPSN);
        const float qs = hv < 8 ? 0.125f * LOG2E : 1.f;
#pragma unroll
        for (int d = 0; d < 64; ++d) x[d] = x[d] * (rstd * qs) * nw[d];
        if (lat) {
#pragma unroll
            for (int i = 0; i < 16; ++i) {
                const float cr = p.rope[(pr * 16 + i) * 2], sr = p.rope[(pr * 16 + i) * 2 + 1];
                const float cc = p.rope[(pc * 16 + i) * 2], sc = p.rope[(pc * 16 + i) * 2 + 1];
                const float a = x[i], b2 = x[16 + i], a2 = x[32 + i], b3 = x[48 + i];
                x[i] = a * cr - b2 * sr; x[16 + i] = b2 * cr + a * sr;
                x[32 + i] = a2 * cc - b3 * sc; x[48 + i] = b3 * cc + a2 * sc;
            }
        }
#pragma unroll
        for (int i = 0; i < 8; ++i) {
            u32x4 u;
#pragma unroll
            for (int e = 0; e < 4; ++e) u[e] = pk2(x[i * 8 + 2 * e], x[i * 8 + 2 * e + 1]);
            *(u32x4*)(ptr + i * 8) = u;
        }
    }
    {
        const int b = lat ? (row >> 13) : ((row - NTOK) >> 8);
        const int key = lat ? tseq : 8192 + ((row - NTOK) & 255);
        const bf16_t* vp = p.P + (size_t)row * PC + C_GV + sub * 32;
        bf16_t* dst = VG(p) + ((size_t)(b * 2 + (sub >> 1)) * 64 + (sub & 1) * 32) * 8448 + key;
#pragma unroll
        for (int i = 0; i < 4; ++i) {
            const u32x4 u = ldg16(vp + i * 8);
#pragma unroll
            for (int e = 0; e < 4; ++e) {
                dst[(size_t)(i * 8 + 2 * e) * 8448] = (bf16_t)(u[e] & 0xffffu);
                dst[(size_t)(i * 8 + 2 * e + 1) * 8448] = (bf16_t)(u[e] >> 16);
            }
        }
    }
}

__device__ void phase_b(const Params& p, int l, unsigned char* lds) {
    const int total = 1056 + 528;
    for (int item = blockIdx.x; item < total; item += gridDim.x) {
        if (item < 1056) { const int cidx = item % 66, bh = item / 66; ret_state_item(p, l, bh >> 2, bh & 3, cidx, lds);
        }
        else qk_prep_item(p, l, item - 1056);
    }
}

__device__ void phase_c(const Params& p, int l, bool dostore = true) {
    const int t = tid_opaque();
    for (int item = blockIdx.x; item < 256; item += gridDim.x) {
        const int part = item & 7, dbh = item >> 3, dir = dbh >> 4, h = dbh & 3;
        const float lg = -__expf(p.ret_log_decay[l * 8 + dir * 4 + h]) * LOG2E;
        const float gc = ex2(lg * 128.f);
        bf16_t* base = p.SU + (size_t)dbh * 66 * 16384 + part * 2048 + t * 8;
        float s[8];
#pragma unroll
        for (int e = 0; e < 8; ++e) s[e] = 0.f;
        for (int st0 = 0; st0 < 66; st0 += 11) {
            u32x4 u[11];
#pragma unroll
            for (int q = 0; q < 11; ++q) {
                const int st = st0 + q;
                const int n = dir == 0 ? (st < 2 ? 64 + st : st - 2) : (st < 2 ? 65 - st : 65 - st);
                u[q] = *(const u32x4*)(base + (size_t)n * 16384);
            }
#pragma unroll
            for (int q = 0; q < 11; ++q) {
                const int st = st0 + q;
                const int n = dir == 0 ? (st < 2 ? 64 + st : st - 2) : (st < 2 ? 65 - st : 65 - st);
                u32x4 o;
#pragma unroll
                for (int e = 0; e < 4; ++e) o[e] = pk2(s[2 * e], s[2 * e + 1]);
                if (dostore) *(u32x4*)(base + (size_t)n * 16384) = o;
#pragma unroll
                for (int e = 0; e < 4; ++e) { s[2 * e] = gc * s[2 * e] + lo16(u[q][e]); s[2 * e + 1] = gc * s[2 * e + 1] + hi16(u[q][e]); }
            }
        }
    }
}

template <int MODE>
__device__ void attn_item(const Params& p, int l, int b, int i1, int i2, int i3, unsigned char* lds, bool dostore = true) {
    constexpr int NQB = (MODE == 2) ? 2 : 4, NHQ = NQB / 2;
    const int t = tid_opaque(), lane = t & 63, w = t >> 6, g = lane >> 4, c = lane & 15;
    bf16_t* Ks = (bf16_t*)lds;
    bf16_t* Vt = Ks + 2 * 64 * 72;
    u32x4* Qs = (u32x4*)(lds + 36864) + w * 512;
    float* rpbs = (float*)(lds + 36864 + 32768);
    int qbase, qstep, qcol, kcol, vcol, gcol, ntiles;
    int R0 = 0, c0 = 0, start = 0, bstart = 0, hh = 0;
    if (MODE == 0 || MODE == 1) {
        const int kvh = i1, qt = i2, head = kvh * 4 + w;
        qbase = (MODE == 0 ? b * 8192 : NTOK + b * 256) + qt * 64; qstep = 16;
        qcol = C_GQ + head * 64; kcol = C_GK + kvh * 64; vcol = C_GV + kvh * 64; gcol = C_GG + head * 64;
        ntiles = MODE == 0 ? 132 : 4;
    } else if (MODE == 2) {
        hh = i1; R0 = i2 * 8; c0 = i3 * 16;
        start = min(max(R0 - 4, 0), 112); bstart = min(max(c0 - 8, 0), 32);
        qbase = b * 8192 + (R0 + w * 2) * 64 + c0; qstep = 64;
        qcol = C_NQ + hh * 64; kcol = C_NK + hh * 64; vcol = C_NV + hh * 64; gcol = C_NG + hh * 64;
        ntiles = 12;
    } else {
        hh = i1;
        qbase = NTOK + b * 256 + w * 64; qstep = 16;
        qcol = C_NQ + hh * 64; kcol = C_NK + hh * 64; vcol = C_NV + hh * 64; gcol = C_NG + hh * 64;
        ntiles = 4;
    }
    const float scale = 0.125f * LOG2E;
    f32x4 o[NQB][4];
    float mrun[NQB], lsum[NQB];
#pragma unroll
    for (int qb = 0; qb < NQB; ++qb) {
        mrun[qb] = -INFINITY; lsum[qb] = 0.f;
#pragma unroll
        for (int d = 0; d < 4; ++d) o[qb][d] = (f32x4){0.f, 0.f, 0.f, 0.f};
    }
    const int kkey = t >> 3, kch = (t & 7) * 8;
    const int vkey = t & 63, vch = (t >> 6);
    u32x4 kr[2], vr[2];
    auto load_tile = [&](int tt) {
        int base, rstep;
        if (MODE == 0) { base = tt < 128 ? b * 8192 + tt * 64 : NTOK + b * 256 + (tt - 128) * 64; rstep = 32; }
        else if (MODE == 2) {
            if (tt < 4) { base = NTOK + b * 256 + tt * 64; rstep = 32; }
            else { base = b * 8192 + (start + 2 * (tt - 4)) * 64 + bstart; rstep = 64; }
        } else { base = NTOK + b * 256 + tt * 64; rstep = 32; }
#pragma unroll
        for (int i = 0; i < 2; ++i) {
            const int key = kkey + 32 * i;
            kr[i] = ldg16(p.P + (size_t)(base + (key >> 5) * rstep + (key & 31)) * PC + kcol + kch);
            if (MODE <= 1) vr[i] = ldg16(VG(p) + ((size_t)(b * 2 + i1) * 64 + kkey + 32 * i) * 8448 + (MODE == 0 ? tt * 64 : 8192 + tt * 64) + kch);
            else vr[i] = ldg16(p.P + (size_t)(base + (vkey >> 5) * rstep + (vkey & 31)) * PC + vcol + (vch + 4 * i) * 8);
        }
    };
    auto store_tile = [&](int buf) {
        bf16_t* ks_ = Ks + buf * 64 * 72; bf16_t* vt_ = Vt + buf * 64 * 72;
#pragma unroll
        for (int i = 0; i < 2; ++i) {
            *(u32x4*)(ks_ + (kkey + 32 * i) * 72 + kch) = kr[i];
            if (MODE <= 1) { *(u32x4*)(vt_ + (kkey + 32 * i) * 72 + kch) = vr[i]; continue; }
#pragma unroll
            for (int e = 0; e < 4; ++e) {
                const int d = (vch + 4 * i) * 8 + 2 * e;
                vt_[d * 72 + vkey] = (bf16_t)(vr[i][e] & 0xffffu);
                vt_[(d + 1) * 72 + vkey] = (bf16_t)(vr[i][e] >> 16);
            }
        }
    };
    load_tile(0);
    __syncthreads();
#pragma unroll
    for (int qb = 0; qb < NQB; ++qb)
#pragma unroll
        for (int ks = 0; ks < 2; ++ks) Qs[(qb * 2 + ks) * 64 + lane] = ldg16(p.P + (size_t)(qbase + qb * qstep + c) * PC + qcol + ks * 32 + g * 8);
    if (MODE == 2) for (int idx = t; idx < 465; idx += 256) rpbs[idx] = p.na_rpb[((size_t)l * 8 + hh) * 465 + idx] * LOG2E;
    store_tile(0);
    __syncthreads();
    const int wlo = min(max(R0 + w * 2 - 4, 0), 120), whi = min(max(R0 + w * 2 + 1 - 4, 0), 120) + 7;
    int colterm[8];
    if (MODE == 2) {
        const int qc = c0 + c, cs = min(max(qc - 8, 0), 48);
#pragma unroll
        for (int j = 0; j < 8; ++j) {
            const int kc = bstart + (j >> 2) * 16 + g * 4 + (j & 3);
            colterm[j] = ((unsigned)(kc - cs) < 16u) ? (kc - qc + 15) : -1;
        }
    }
    for (int tt = 0; tt < ntiles; ++tt) {
        const int cur = tt & 1;
        if (tt + 1 < ntiles) load_tile(tt + 1);
        bool skip = false;
        int krow0 = 0;
        if (MODE == 2 && tt >= 4) { krow0 = start + 2 * (tt - 4); skip = (krow0 + 1 < wlo) || (krow0 > whi); }
        if (!skip) {
            const bf16_t* ks_ = Ks + cur * 64 * 72; const bf16_t* vt_ = Vt + cur * 64 * 72;
            f32x4 s[NQB][4];
#pragma unroll
            for (int qq = 0; qq < NQB; ++qq)
#pragma unroll
                for (int kb = 0; kb < 4; ++kb) s[qq][kb] = (f32x4){0.f, 0.f, 0.f, 0.f};
#pragma unroll
            for (int ks = 0; ks < 2; ++ks) {
                bf16x8 qv[NQB];
#pragma unroll
                for (int qq = 0; qq < NQB; ++qq) qv[qq] = as_bf(Qs[(qq * 2 + ks) * 64 + lane]);
#pragma unroll
                for (int kb = 0; kb < 4; ++kb) {
                    const bf16x8 kf = *(const bf16x8*)(ks_ + (kb * 16 + c) * 72 + ks * 32 + g * 8);
#pragma unroll
                    for (int qq = 0; qq < NQB; ++qq) s[qq][kb] = mfma16(kf, qv[qq], s[qq][kb]);
                }
            }
            __builtin_amdgcn_sched_barrier(0);
            bf16x8 pf[NQB][2];
#pragma unroll
            for (int qq = 0; qq < NQB; ++qq) {
                const int qb = qq;
                if (MODE == 2 && tt >= 4) {
                    const int qrow = R0 + w * 2 + qb;
                    const int rs = min(max(qrow - 4, 0), 120);
#pragma unroll
                    for (int kb = 0; kb < 4; ++kb) {
                        const int krow = krow0 + (kb >> 1);
                        const bool rowok = (unsigned)(krow - rs) < 8u;
                        const int ridx = (krow - qrow + 7) * 31;
#pragma unroll
                        for (int r = 0; r < 4; ++r) {
                            const int ct = colterm[(kb & 1) * 4 + r];
                            const bool valid = rowok && ct >= 0;
                            const float bias = rpbs[valid ? ridx + ct : 0];
                            s[qq][kb][r] = valid ? s[qq][kb][r] * scale + bias : -INFINITY;
                        }
                    }
                }
                const bool raw = !(MODE == 2 && tt >= 4);
                float tmax = fmaxf(fmaxf(s[qq][0][0], s[qq][0][1]), fmaxf(s[qq][0][2], s[qq][0][3]));
#pragma unroll
                for (int kb = 1; kb < 4; ++kb) tmax = fmaxf(tmax, fmaxf(fmaxf(s[qq][kb][0], s[qq][kb][1]), fmaxf(s[qq][kb][2], s[qq][kb][3])));
                tmax = fmaxf(tmax, __shfl_xor(tmax, 16)); tmax = fmaxf(tmax, __shfl_xor(tmax, 32));
                const float mn = fmaxf(mrun[qb], raw ? tmax * scale : tmax);
                const float alpha = ex2(mrun[qb] - mn);
                mrun[qb] = mn;
                float psum = 0.f;
#pragma unroll
                for (int kb = 0; kb < 4; ++kb)
#pragma unroll
                    for (int r = 0; r < 4; ++r) { const float pv = raw ? ex2(__builtin_fmaf(s[qq][kb][r], scale, -mn)) : ex2(s[qq][kb][r] - mn); s[qq][kb][r] = pv; psum += pv; }
                lsum[qb] = lsum[qb] * alpha + psum;
                if (__builtin_amdgcn_ballot_w64(alpha != 1.f) != 0ull) {
#pragma unroll
                    for (int d = 0; d < 4; ++d) o[qb][d] = o[qb][d] * alpha;
                }
#pragma unroll
                for (int kk = 0; kk < 2; ++kk) {
                    u32x4 u;
                    u[0] = pk2(s[qq][2 * kk][0], s[qq][2 * kk][1]); u[1] = pk2(s[qq][2 * kk][2], s[qq][2 * kk][3]);
                    u[2] = pk2(s[qq][2 * kk + 1][0], s[qq][2 * kk + 1][1]); u[3] = pk2(s[qq][2 * kk + 1][2], s[qq][2 * kk + 1][3]);
                    pf[qq][kk] = as_bf(u);
                }
            }
            __builtin_amdgcn_sched_barrier(0);
#pragma unroll
            for (int kk = 0; kk < 2; ++kk)
#pragma unroll
                for (int d = 0; d < 4; ++d) {
                    const u32x2 vlo = *(const u32x2*)(vt_ + (d * 16 + c) * 72 + kk * 32 + g * 4);
                    const u32x2 vhi = *(const u32x2*)(vt_ + (d * 16 + c) * 72 + kk * 32 + 16 + g * 4);
                    u32x4 vv; vv[0] = vlo[0]; vv[1] = vlo[1]; vv[2] = vhi[0]; vv[3] = vhi[1];
                    const bf16x8 vf = as_bf(vv);
#pragma unroll
                    for (int qq = 0; qq < NQB; ++qq) o[qq][d] = mfma16(vf, pf[qq][kk], o[qq][d]);
                }
        }
        if (tt + 1 < ntiles) store_tile(cur ^ 1);
        __syncthreads();
    }
    if (dostore)
#pragma unroll
    for (int qb = 0; qb < NQB; ++qb) {
        float ls = lsum[qb];
        ls += __shfl_xor(ls, 16); ls += __shfl_xor(ls, 32);
        const float inv = __builtin_amdgcn_rcpf(ls);
        bf16_t* rowp = p.P + (size_t)(qbase + qb * qstep + c) * PC;
#pragma unroll
        for (int d = 0; d < 4; ++d) {
            const int dd = d * 16 + g * 4;
            const u32x2 gt = *(const u32x2*)(rowp + gcol + dd);
            const float v0 = o[qb][d][0] * inv * silu_f(lo16(gt[0])), v1 = o[qb][d][1] * inv * silu_f(hi16(gt[0]));
            const float v2 = o[qb][d][2] * inv * silu_f(lo16(gt[1])), v3 = o[qb][d][3] * inv * silu_f(hi16(gt[1]));
            u32x2 o2; o2.x = pk2(v0, v1); o2.y = pk2(v2, v3);
            *(u32x2*)(rowp + qcol + dd) = o2;
        }
    }
}

typedef float f32x16 __attribute__((ext_vector_type(16)));
__device__ __forceinline__ f32x16 mfma32(bf16x8 a, bf16x8 b, f32x16 c) { return __builtin_amdgcn_mfma_f32_32x32x16_bf16(a, b, c, 0, 0, 0); }

template <int MODE, bool FIXM>
__device__ void attn_item32(const Params& p, int l, int b, int i1, int i2, unsigned char* lds, float mfix, bool dostore = true) {
    const int t = tid_opaque(), lane = t & 63, w = t >> 6, h = lane >> 5, c = lane & 31;
    bf16_t* Ks = (bf16_t*)lds;
    bf16_t* Vt = Ks + 2 * 64 * 72;
    u32x4* Qs = (u32x4*)(lds + 36864) + w * 512;
    int qbase, qcol, kcol, vcol, gcol, ntiles;
    if (MODE == 0 || MODE == 1) {
        const int kvh = i1, qt = i2, head = kvh * 4 + w;
        qbase = (MODE == 0 ? b * 8192 : NTOK + b * 256) + qt * 64;
        qcol = C_GQ + head * 64; kcol = C_GK + kvh * 64; vcol = C_GV + kvh * 64; gcol = C_GG + head * 64;
        ntiles = MODE == 0 ? 132 : 4;
    } else {
        const int hh = i1;
        qbase = NTOK + b * 256 + w * 64;
        qcol = C_NQ + hh * 64; kcol = C_NK + hh * 64; vcol = C_NV + hh * 64; gcol = C_NG + hh * 64;
        ntiles = 4;
    }
    const float scale = MODE <= 1 ? 1.f : 0.125f * LOG2E;
    f32x16 o[2][2];
    float mrun[2], lsum[2];
#pragma unroll
    for (int qb = 0; qb < 2; ++qb) {
        mrun[qb] = -INFINITY; lsum[qb] = 0.f;
#pragma unroll
        for (int d = 0; d < 2; ++d)
#pragma unroll
            for (int r = 0; r < 16; ++r) o[qb][d][r] = 0.f;
    }
    const int kkey = t >> 3, kch = (t & 7) * 8;
    const int vkey = t & 63, vch = (t >> 6);
    u32x4 kr[2], vr[2];
    auto load_tile = [&](int tt) {
        const int base = MODE == 0 ? (tt < 128 ? b * 8192 + tt * 64 : NTOK + b * 256 + (tt - 128) * 64) : NTOK + b * 256 + tt * 64;
#pragma unroll
        for (int i = 0; i < 2; ++i) {
            kr[i] = ldg16(p.P + (size_t)(base + kkey + 32 * i) * PC + kcol + kch);
            if (MODE <= 1) vr[i] = ldg16(VG(p) + ((size_t)(b * 2 + i1) * 64 + kkey + 32 * i) * 8448 + (MODE == 0 ? tt * 64 : 8192 + tt * 64) + kch);
            else vr[i] = ldg16(p.P + (size_t)(base + vkey) * PC + vcol + (vch + 4 * i) * 8);
        }
    };
    auto store_tile = [&](int buf) {
        bf16_t* ks_ = Ks + buf * 64 * 72; bf16_t* vt_ = Vt + buf * 64 * 72;
#pragma unroll
        for (int i = 0; i < 2; ++i) {
            *(u32x4*)(ks_ + (kkey + 32 * i) * 72 + kch) = kr[i];
            if (MODE <= 1) { *(u32x4*)(vt_ + (kkey + 32 * i) * 72 + kch) = vr[i]; continue; }
#pragma unroll
            for (int e = 0; e < 4; ++e) {
                const int d = (vch + 4 * i) * 8 + 2 * e;
                vt_[d * 72 + vkey] = (bf16_t)(vr[i][e] & 0xffffu);
                vt_[(d + 1) * 72 + vkey] = (bf16_t)(vr[i][e] >> 16);
            }
        }
    };
    load_tile(0);
    __syncthreads();
#pragma unroll
    for (int qb = 0; qb < 2; ++qb)
#pragma unroll
        for (int ks = 0; ks < 4; ++ks) Qs[(qb * 4 + ks) * 64 + lane] = ldg16(p.P + (size_t)(qbase + qb * 32 + c) * PC + qcol + ks * 16 + h * 8);
    store_tile(0);
    __syncthreads();
    for (int tt = 0; tt < ntiles; ++tt) {
        const int cur = tt & 1;
        if (tt + 1 < ntiles) load_tile(tt + 1);
        const bf16_t* ks_ = Ks + cur * 64 * 72; const bf16_t* vt_ = Vt + cur * 64 * 72;
        f32x16 s[2][2];
#pragma unroll
        for (int qb = 0; qb < 2; ++qb)
#pragma unroll
            for (int kb = 0; kb < 2; ++kb)
#pragma unroll
                for (int r = 0; r < 16; ++r) s[qb][kb][r] = FIXM ? -mfix : 0.f;
#pragma unroll
        for (int ks = 0; ks < 4; ++ks) {
            const bf16x8 q0 = as_bf(Qs[ks * 64 + lane]), q1 = as_bf(Qs[(4 + ks) * 64 + lane]);
#pragma unroll
            for (int kb = 0; kb < 2; ++kb) {
                const bf16x8 kf = *(const bf16x8*)(ks_ + (kb * 32 + c) * 72 + ks * 16 + h * 8);
                s[0][kb] = mfma32(kf, q0, s[0][kb]);
                s[1][kb] = mfma32(kf, q1, s[1][kb]);
            }
        }
        bf16x8 pf[2][4];
#pragma unroll
        for (int qb = 0; qb < 2; ++qb) {
            float psum = 0.f;
            if (FIXM) {
#pragma unroll
                for (int kb = 0; kb < 2; ++kb)
#pragma unroll
                    for (int r = 0; r < 16; ++r) { const float pv = ex2(s[qb][kb][r]); s[qb][kb][r] = pv; psum += pv; }
                lsum[qb] += psum;
            } else {
                float tmax = s[qb][0][0];
#pragma unroll
                for (int kb = 0; kb < 2; ++kb)
#pragma unroll
                    for (int r = 0; r < 16; r += 4) tmax = fmaxf(tmax, fmaxf(fmaxf(s[qb][kb][r], s[qb][kb][r + 1]), fmaxf(s[qb][kb][r + 2], s[qb][kb][r + 3])));
                tmax = fmaxf(tmax, __shfl_xor(tmax, 32));
                const float mn = fmaxf(mrun[qb], tmax * scale);
                const float alpha = ex2(mrun[qb] - mn);
                mrun[qb] = mn;
#pragma unroll
                for (int kb = 0; kb < 2; ++kb)
#pragma unroll
                    for (int r = 0; r < 16; ++r) { const float pv = ex2(__builtin_fmaf(s[qb][kb][r], scale, -mn)); s[qb][kb][r] = pv; psum += pv; }
                lsum[qb] = lsum[qb] * alpha + psum;
                if (__builtin_amdgcn_ballot_w64(alpha != 1.f) != 0ull) {
#pragma unroll
                    for (int d = 0; d < 2; ++d)
#pragma unroll
                        for (int r = 0; r < 16; ++r) o[qb][d][r] *= alpha;
                }
            }
#pragma unroll
            for (int kb = 0; kb < 2; ++kb)
#pragma unroll
                for (int st = 0; st < 2; ++st) {
                    u32x4 u;
#pragma unroll
                    for (int e = 0; e < 4; ++e) u[e] = pk2(s[qb][kb][8 * st + 2 * e], s[qb][kb][8 * st + 2 * e + 1]);
                    pf[qb][kb * 2 + st] = as_bf(u);
                }
        }
#pragma unroll
        for (int kk = 0; kk < 4; ++kk)
#pragma unroll
            for (int d = 0; d < 2; ++d) {
                const u32x2 vlo = *(const u32x2*)(vt_ + (d * 32 + c) * 72 + kk * 16 + h * 4);
                const u32x2 vhi = *(const u32x2*)(vt_ + (d * 32 + c) * 72 + kk * 16 + 8 + h * 4);
                u32x4 vv; vv[0] = vlo[0]; vv[1] = vlo[1]; vv[2] = vhi[0]; vv[3] = vhi[1];
                const bf16x8 vf = as_bf(vv);
                o[0][d] = mfma32(vf, pf[0][kk], o[0][d]);
                o[1][d] = mfma32(vf, pf[1][kk], o[1][d]);
            }
        if (tt + 1 < ntiles) store_tile(cur ^ 1);
        __syncthreads();
    }
    if (dostore)
#pragma unroll
    for (int qb = 0; qb < 2; ++qb) {
        float ls = lsum[qb];
        ls += __shfl_xor(ls, 32);
        const float inv = __builtin_amdgcn_rcpf(ls);
        bf16_t* rowp = p.P + (size_t)(qbase + qb * 32 + c) * PC;
#pragma unroll
        for (int d = 0; d < 2; ++d)
#pragma unroll
            for (int rg = 0; rg < 4; ++rg) {
                const int dd = d * 32 + rg * 8 + h * 4;
                const u32x2 gt = *(const u32x2*)(rowp + gcol + dd);
                const float v0 = o[qb][d][rg * 4 + 0] * inv * silu_f(lo16(gt[0])), v1 = o[qb][d][rg * 4 + 1] * inv * silu_f(hi16(gt[0]));
                const float v2 = o[qb][d][rg * 4 + 2] * inv * silu_f(lo16(gt[1])), v3 = o[qb][d][rg * 4 + 3] * inv * silu_f(hi16(gt[1]));
                u32x2 o2; o2.x = pk2(v0, v1); o2.y = pk2(v2, v3);
                *(u32x2*)(rowp + qcol + dd) = o2;
            }
    }
}

__device__ __forceinline__ bf16x8 scale_frag(bf16x8 f, float sc) {
    u32x4 u = as_u(f), r;
#pragma unroll
    for (int e = 0; e < 4; ++e) r[e] = pk2(lo16(u[e]) * sc, hi16(u[e]) * sc);
    return as_bf(r);
}

__device__ void ret_item(const Params& p, int l, int b, int h, int cidx, int hf, unsigned char* lds, bool dostore = true) {
    const int t = tid_opaque(), lane = t & 63, w = t >> 6, g = lane >> 4, c = lane & 15;
    bf16_t* B0 = (bf16_t*)lds;
    bf16_t* B1 = B0 + 128 * 136;
    const float lgf = -__expf(p.ret_log_decay[l * 8 + h]) * LOG2E, lgb = -__expf(p.ret_log_decay[l * 8 + 4 + h]) * LOG2E;
    const float ksc = 0.08838834764831845f;
    const int rowbase = chunk_row(b, cidx);
    const int ti = hf * 64 + w * 16 + c;
    bf16x8 qf[4];
#pragma unroll
    for (int ks = 0; ks < 4; ++ks) qf[ks] = as_bf(ldg16(p.P + (size_t)(rowbase + ti) * PC + C_RQ + h * 128 + ks * 32 + g * 8));
    __syncthreads();
#pragma unroll
    for (int i = 0; i < 8; ++i) {
        const int cc = t + 256 * i;
        { const int r = cc >> 4, ch = cc & 15; *(u32x4*)(B0 + r * 136 + ch * 8) = ldg16(p.P + (size_t)(rowbase + r) * PC + C_RK + h * 128 + ch * 8); }
        { const int tok = cc & 127, ch = cc >> 7;
          const u32x4 vv = ldg16(p.P + (size_t)(rowbase + tok) * PC + C_RV + h * 128 + ch * 8);
#pragma unroll
          for (int e = 0; e < 4; ++e) { B1[(ch * 8 + 2 * e) * 136 + tok] = (bf16_t)(vv[e] & 0xffffu); B1[(ch * 8 + 2 * e + 1) * 136 + tok] = (bf16_t)(vv[e] >> 16); } }
    }
    __syncthreads();
    bf16x8 pf[4];
    {
        f32x4 s[8];
#pragma unroll
        for (int kb = 0; kb < 8; ++kb) s[kb] = (f32x4){0.f, 0.f, 0.f, 0.f};
#pragma unroll
        for (int ks = 0; ks < 4; ++ks)
#pragma unroll
            for (int kb = 0; kb < 8; ++kb) {
                const bf16x8 kf = *(const bf16x8*)(B0 + (kb * 16 + c) * 136 + ks * 32 + g * 8);
                s[kb] = mfma16(kf, qf[ks], s[kb]);
            }
#pragma unroll
        for (int kb = 0; kb < 8; ++kb)
#pragma unroll
            for (int r = 0; r < 4; ++r) {
                const int j = kb * 16 + g * 4 + r, d = ti - j;
                const float wgt = d > 0 ? ex2(lgf * (float)d) : (d < 0 ? ex2(lgb * (float)(-d)) : 2.f);
                s[kb][r] *= wgt * ksc;
            }
#pragma unroll
        for (int kk = 0; kk < 4; ++kk) {
            u32x4 u;
            u[0] = pk2(s[2 * kk][0], s[2 * kk][1]); u[1] = pk2(s[2 * kk][2], s[2 * kk][3]);
            u[2] = pk2(s[2 * kk + 1][0], s[2 * kk + 1][1]); u[3] = pk2(s[2 * kk + 1][2], s[2 * kk + 1][3]);
            pf[kk] = as_bf(u);
        }
    }
    f32x4 o[8];
#pragma unroll
    for (int d = 0; d < 8; ++d) o[d] = (f32x4){0.f, 0.f, 0.f, 0.f};
#pragma unroll
    for (int kk = 0; kk < 4; ++kk)
#pragma unroll
        for (int d = 0; d < 8; ++d) {
            const u32x2 vlo = *(const u32x2*)(B1 + (d * 16 + c) * 136 + kk * 32 + g * 4);
            const u32x2 vhi = *(const u32x2*)(B1 + (d * 16 + c) * 136 + kk * 32 + 16 + g * 4);
            u32x4 vv; vv[0] = vlo[0]; vv[1] = vlo[1]; vv[2] = vhi[0]; vv[3] = vhi[1];
            o[d] = mfma16(as_bf(vv), pf[kk], o[d]);
        }
    __syncthreads();
    {
        const bf16_t* Sf = p.SU + ((size_t)((0 * 4 + b) * 4 + h) * 66 + cidx) * 16384;
        const bf16_t* Sb = p.SU + ((size_t)((1 * 4 + b) * 4 + h) * 66 + cidx) * 16384;
#pragma unroll
        for (int i = 0; i < 8; ++i) {
            const int cc = t + 256 * i, r = cc >> 4, ch = cc & 15;
            *(u32x4*)(B0 + r * 136 + ch * 8) = ldg16(Sf + r * 128 + ch * 8);
            *(u32x4*)(B1 + r * 136 + ch * 8) = ldg16(Sb + r * 128 + ch * 8);
        }
    }
    __syncthreads();
#pragma unroll
    for (int dir = 0; dir < 2; ++dir) {
        const bf16_t* Bd = dir ? B1 : B0;
        const float xi = dir == 0 ? ex2(lgf * (float)(ti + 1)) : ex2(lgb * (float)(128 - ti));
        bf16x8 qs[4];
#pragma unroll
        for (int ks = 0; ks < 4; ++ks) qs[ks] = scale_frag(qf[ks], xi);
#pragma unroll
        for (int ks = 0; ks < 4; ++ks)
#pragma unroll
            for (int d = 0; d < 8; ++d) {
                const bf16x8 sf = *(const bf16x8*)(Bd + (d * 16 + c) * 136 + ks * 32 + g * 8);
                o[d] = mfma16(sf, qs[ks], o[d]);
            }
    }
    if (dostore) {
        float sum = 0.f;
#pragma unroll
        for (int d = 0; d < 8; ++d) sum += (o[d][0] + o[d][1]) + (o[d][2] + o[d][3]);
        sum += __shfl_xor(sum, 16); sum += __shfl_xor(sum, 32);
        const float mu = sum * (1.f / 128.f);
        float var = 0.f;
#pragma unroll
        for (int d = 0; d < 8; ++d)
#pragma unroll
            for (int r = 0; r < 4; ++r) { const float dd = o[d][r] - mu; var += dd * dd; }
        var += __shfl_xor(var, 16); var += __shfl_xor(var, 32);
        const float rstd = rsqrtf(var * (1.f / 128.f) + EPSN);
        bf16_t* rowp = p.P + (size_t)(rowbase + ti) * PC;
#pragma unroll
        for (int d = 0; d < 8; ++d) {
            const int dv = d * 16 + g * 4;
            const f32x4 gn = *(const f32x4*)(p.ret_gn_w + l * 512 + h * 128 + dv);
            const u32x2 gt = *(const u32x2*)(rowp + C_RG + h * 128 + dv);
            const float v0 = (o[d][0] - mu) * rstd * gn[0] * silu_f(lo16(gt[0])), v1 = (o[d][1] - mu) * rstd * gn[1] * silu_f(hi16(gt[0]));
            const float v2 = (o[d][2] - mu) * rstd * gn[2] * silu_f(lo16(gt[1])), v3 = (o[d][3] - mu) * rstd * gn[3] * silu_f(hi16(gt[1]));
            u32x2 o2; o2.x = pk2(v0, v1); o2.y = pk2(v2, v3);
            *(u32x2*)(rowp + C_RQ + h * 128 + dv) = o2;
        }
    }
}

__device__ void phase_d(const Params& p, int l, unsigned char* lds) {
    const bool need_ctx = l < 3;
    const int G = gridDim.x, bid = blockIdx.x;
    const bool small_first = bid >= (G >> 1);
    float mfix;
    {
        const int ln = tid_opaque() & 63;
        float wq = fabsf(p.q_norm_w[l * 64 + ln]), wk = fabsf(p.k_norm_w[l * 64 + ln]);
#pragma unroll
        for (int o = 32; o >= 1; o >>= 1) { wq = fmaxf(wq, __shfl_xor(wq, o)); wk = fmaxf(wk, __shfl_xor(wk, o)); }
        mfix = 64.f * wq * wk * (0.125f * LOG2E);
    }
    const bool usefix = mfix < 40.f;
    {
        phase_c(p, l);
        asm volatile("s_waitcnt vmcnt(0) lgkmcnt(0)" ::: "memory");
        __syncthreads();
        if (threadIdx.x == 0) {
            unsigned mine = 0;
            for (int it = bid; it < 256; it += G) ++mine;
            if (mine) { __builtin_amdgcn_fence(__ATOMIC_RELEASE, "agent"); __hip_atomic_fetch_add(p.bar + 768, mine, __ATOMIC_RELAXED, __HIP_MEMORY_SCOPE_AGENT); }
        }
    }
#pragma unroll 1
    for (int stage = 0; stage < 3; ++stage) {
        const int kind = small_first ? (stage + 1) % 3 : stage;
        if (kind == 0) {
#pragma unroll 1
            for (int it = bid; it < 1024; it += G) {
                if (usefix) attn_item32<0, true>(p, l, it >> 8, (it >> 7) & 1, it & 127, lds, mfix);
                else attn_item32<0, false>(p, l, it >> 8, (it >> 7) & 1, it & 127, lds, 0.f);
            }
        } else if (kind == 1) {
#pragma unroll 1
            for (int it = bid; it < 2048; it += G) {
                attn_item<2>(p, l, it >> 9, (it >> 6) & 7, (it >> 2) & 15, it & 3, lds);
            }
        } else {
            const int nch = need_ctx ? 66 : 64, n_ret = nch * 32;
            if (threadIdx.x == 0) {
                while (__hip_atomic_load(p.bar + 768, __ATOMIC_RELAXED, __HIP_MEMORY_SCOPE_AGENT) < 256u * (unsigned)(l + 1)) __builtin_amdgcn_s_sleep(2);
                __builtin_amdgcn_fence(__ATOMIC_ACQUIRE, "agent");
            }
            __syncthreads();
#pragma unroll 1
            for (int it = G - 1 - bid; it < n_ret; it += G) {
                const int hf = it & 1, it2 = it >> 1;
                const int cidx = it2 % nch, bh = it2 / nch;
                ret_item(p, l, bh >> 2, bh & 3, cidx, hf, lds);
            }
        }
        __syncthreads();
    }
    if (need_ctx) {
#pragma unroll 1
        for (int it = G - 1 - bid; it < 32; it += G) attn_item32<1, false>(p, l, it >> 3, (it >> 2) & 1, it & 3, lds, 0.f);
        __syncthreads();
#pragma unroll 1
        for (int it = G - 1 - bid - 32; it < 32; it += G) { if (it >= 0) attn_item32<3, false>(p, l, it >> 3, it & 7, 0, lds, 0.f); }
    }
}

__device__ __forceinline__ int xcd_tile(int it0) {
    if (gridDim.x != 512 || it0 >= 2048) return it0;
    const int xcd = it0 & 7, j = (it0 >> 3) & 63, r = it0 >> 9;
    const int li = j + 64 * r;
    return ((xcd * 32 + (li >> 3)) << 3) | (li & 7);
}

__device__ void phase_e1(const Params& p, int l, unsigned char* lds) {
    const int t = tid_opaque(), lane = t & 63, w = t >> 6, wm = w >> 1, wn = w & 1;
    const int nmt = l < 3 ? 264 : 256;
    const int total = nmt * 8;
    for (int it0 = blockIdx.x; it0 < total; it0 += gridDim.x) {
        const int item = xcd_tile(it0);
        const int mt = item >> 3, nt = item & 7;
        u32x2 macc[4][4];
#pragma unroll
        for (int a = 0; a < 4; ++a)
#pragma unroll
            for (int b = 0; b < 4; ++b) macc[a][b] = (u32x2){0u, 0u};
#pragma unroll 1
        for (int br = 0; br < 3; ++br) {
            u32x2 sg[4][4];
            {
                f32x4 gacc[4][4];
#pragma unroll
                for (int a = 0; a < 4; ++a)
#pragma unroll
                    for (int b = 0; b < 4; ++b) gacc[a][b] = (f32x4){0.f, 0.f, 0.f, 0.f};
                gemm_core<4>(gacc, p.HX + (size_t)mt * 128 * DM, DM, p.Wt + WT_IN + (size_t)(PC + br * 1024 + nt * 128) * DM, DM, DM, lds);
#pragma unroll
                for (int a = 0; a < 4; ++a)
#pragma unroll
                    for (int b = 0; b < 4; ++b) { sg[a][b].x = pk2(sigm_f(gacc[a][b][0]), sigm_f(gacc[a][b][1])); sg[a][b].y = pk2(sigm_f(gacc[a][b][2]), sigm_f(gacc[a][b][3])); }
            }
            f32x4 pacc[4][4];
#pragma unroll
            for (int a = 0; a < 4; ++a)
#pragma unroll
                for (int b = 0; b < 4; ++b) pacc[a][b] = (f32x4){0.f, 0.f, 0.f, 0.f};
            const int xcol = br == 0 ? C_RQ : (br == 1 ? C_NQ : C_GQ);
            const int woff = br == 0 ? WT_RET : (br == 1 ? WT_NA : WT_GQA);
            gemm_core<4>(pacc, p.P + (size_t)mt * 128 * PC + xcol, PC, p.Wt + woff + (size_t)nt * 128 * 512, 512, 512, lds);
#pragma unroll
            for (int a = 0; a < 4; ++a)
#pragma unroll
                for (int b = 0; b < 4; ++b) {
                    const float m0 = lo16(macc[a][b].x) + lo16(sg[a][b].x) * pacc[a][b][0], m1 = hi16(macc[a][b].x) + hi16(sg[a][b].x) * pacc[a][b][1];
                    const float m2 = lo16(macc[a][b].y) + lo16(sg[a][b].y) * pacc[a][b][2], m3 = hi16(macc[a][b].y) + hi16(sg[a][b].y) * pacc[a][b][3];
                    macc[a][b].x = pk2(m0, m1); macc[a][b].y = pk2(m2, m3);
                }
        }
#pragma unroll
        for (int ni = 0; ni < 4; ++ni)
#pragma unroll
            for (int mi = 0; mi < 4; ++mi) {
                const int n = nt * 128 + wn * 64 + ni * 16 + (lane >> 4) * 4, m = mt * 128 + wm * 64 + mi * 16 + (lane & 15);
                *(u32x2*)(p.P + (size_t)m * PC + C_M + n) = macc[ni][mi];
            }
    }
}

__device__ void phase_e2(const Params& p, int l, unsigned char* lds, bool dostore = true) {
    const int t = tid_opaque(), lane = t & 63, w = t >> 6, wm = w >> 1, wn = w & 1;
    const int nmt = l < 3 ? 264 : 256;
    const int total = nmt * 8;
    const float* xsrc = l == 0 ? p.x : p.out;
    const float* ysrc = l == 0 ? p.ctx : p.y;
    for (int it0 = blockIdx.x; it0 < total; it0 += gridDim.x) {
        const int item = xcd_tile(it0);
        const int mt = item >> 3, nt = item & 7;
        f32x4 acc[4][4];
#pragma unroll
        for (int a = 0; a < 4; ++a)
#pragma unroll
            for (int b = 0; b < 4; ++b) acc[a][b] = (f32x4){0.f, 0.f, 0.f, 0.f};
        gemm_core<4>(acc, p.P + (size_t)mt * 128 * PC + C_M, PC, p.Wt + WT_OUT + (size_t)nt * 128 * DM, DM, DM, lds);
#pragma unroll
        for (int mi = 0; mi < 4; ++mi) {
            const int m = mt * 128 + wm * 64 + mi * 16 + (lane & 15);
            const bool lat = m < NTOK;
            const int bb = lat ? (m >> 13) : 4;
            const float* src = lat ? xsrc + (size_t)m * DM : ysrc + (size_t)(m - NTOK) * DM;
            float* dst = lat ? p.out + (size_t)m * DM : p.y + (size_t)(m - NTOK) * DM;
            const float* gate = p.mod + (size_t)(l * 5 + bb) * 3072 + 2048;
#pragma unroll
            for (int ni = 0; ni < 4; ++ni) {
                const int n = nt * 128 + wn * 64 + ni * 16 + (lane >> 4) * 4;
                const f32x4 xo = *(const f32x4*)(src + n), gv = *(const f32x4*)(gate + n);
                if (dostore) *(f32x4*)(dst + n) = xo + gv * acc[ni][mi];
            }
        }
    }
}

__device__ void phase_e3(const Params& p, int l, unsigned char* lds) {
    norm_rows(p, l + 1, p.out, p.y);
    if (l < 3)
        for (int item = blockIdx.x; item < NCONV_ITEMS; item += gridDim.x) convert_item(p, l + 1, item, lds);
}


__device__ __forceinline__ void run_phase(const Params& p, int ph, int l, unsigned char* lds) {
    switch (ph) {
        case 0: phase_p0(p, lds);
            break;
        case 1: norm_rows(p, 0, p.x, p.ctx); break;
        case 2: phase_a(p, l, lds);
            break;
        case 3: phase_b(p, l, lds); break;
        case 4:
            phase_c(p, l); break;
        case 5: phase_d(p, l, lds); break;
        case 6: phase_e1(p, l, lds);
            break;
        case 7:
            phase_e2(p, l, lds); break;
        default: phase_e3(p, l, lds);
            break;
    }
}

__device__ __forceinline__ void fast_grid_barrier(unsigned* bar, unsigned k) {
    asm volatile("s_waitcnt vmcnt(0) lgkmcnt(0)" ::: "memory");
    __syncthreads();
    if (threadIdx.x == 0) {
        const unsigned grp = blockIdx.x & 7u, members = (gridDim.x - grp + 7u) >> 3;
        __builtin_amdgcn_fence(__ATOMIC_RELEASE, "agent");
        const unsigned old = __hip_atomic_fetch_add(bar + grp * 32, 1u, __ATOMIC_RELAXED, __HIP_MEMORY_SCOPE_AGENT);
        if (old + 1u == k * members) {
            __hip_atomic_fetch_add(bar + 256, 1u, __ATOMIC_RELAXED, __HIP_MEMORY_SCOPE_AGENT);
            while (__hip_atomic_load(bar + 256, __ATOMIC_RELAXED, __HIP_MEMORY_SCOPE_AGENT) < k * 8u) __builtin_amdgcn_s_sleep(1);
            __hip_atomic_store(bar + 288 + grp * 32, k, __ATOMIC_RELAXED, __HIP_MEMORY_SCOPE_AGENT);
        } else {
            while (__hip_atomic_load(bar + 288 + grp * 32, __ATOMIC_RELAXED, __HIP_MEMORY_SCOPE_AGENT) < k) __builtin_amdgcn_s_sleep(1);
        }
        __builtin_amdgcn_fence(__ATOMIC_ACQUIRE, "agent");
    }
    __syncthreads();
}
#define GSYNC() do { asm volatile("s_waitcnt vmcnt(0) lgkmcnt(0)" ::: "memory"); grid.sync(); } while (0)
__global__ void __launch_bounds__(256, 2) mega_kernel(Params p) {
    __shared__ __attribute__((aligned(16))) unsigned char lds[LDS_BYTES];
    cg::grid_group grid = cg::this_grid();
    unsigned bk = 0;
    run_phase(p, 0, 0, lds); GSYNC();
    run_phase(p, 1, 0, lds); fast_grid_barrier(p.bar, ++bk);
    for (int l = 0; l < 4; ++l) {
#pragma unroll 1
        for (int ph = 2; ph <= 8; ++ph) {
            if (ph == 4) continue;
            run_phase(p, ph, l, lds);
            if (!(l == 3 && ph == 8)) fast_grid_barrier(p.bar, ++bk);
        }
    }
}

extern "C" void kernel_launch(void* const* d_in, const int* in_sizes, int n_in, void* d_out, int out_size, void* d_ws, size_t ws_size, hipStream_t stream) {
    Params p{};
    p.x = (const float*)d_in[0]; p.c = (const float*)d_in[1]; p.ctx = (const float*)d_in[2]; p.c_ctx = (const float*)d_in[3];
    p.ada_w = (const float*)d_in[4]; p.ada_b = (const float*)d_in[5]; p.norm_w = (const float*)d_in[6]; p.w_in = (const float*)d_in[7];
    p.ret_log_decay = (const float*)d_in[8]; p.ret_gn_w = (const float*)d_in[9]; p.na_rpb = (const float*)d_in[10];
    p.q_norm_w = (const float*)d_in[11]; p.k_norm_w = (const float*)d_in[12]; p.w_ret_o = (const float*)d_in[13];
    p.w_na_o = (const float*)d_in[14]; p.w_gqa_o = (const float*)d_in[15]; p.w_out = (const float*)d_in[16]; p.final_norm_w = (const float*)d_in[17];
    p.out = (float*)d_out;
    unsigned char* ws = (unsigned char*)d_ws;
    size_t off = 0;
    p.P = (bf16_t*)(ws + off); off += (size_t)NROWS * PC * 2;
    p.HX = (bf16_t*)(ws + off); off += (size_t)NROWS * DM * 2;
    p.Wt = (bf16_t*)(ws + off); off += (size_t)WT_TOTAL * 2;
    p.SU = (bf16_t*)(ws + off); off += (size_t)2 * 4 * 4 * 66 * 16384 * 2;
    p.y = (float*)(ws + off); off += (size_t)1024 * 1024 * 4;
    p.mod = (float*)(ws + off); off += (size_t)4 * 5 * 3072 * 4;
    p.rope = (float*)(ws + off); off += (size_t)128 * 16 * 2 * 4 + 256;
    p.bar = (unsigned*)(ws + off); off += 4096;
    off += (size_t)4 * 2 * 64 * 8448 * 2;
    if (off > ws_size) { fprintf(stderr, "workspace too small: need %zu have %zu\n", off, ws_size); return; }
    static int grid_blocks = 0;
    if (!grid_blocks) {
        int dev = 0, cus = 0, per_cu = 0;
        hipGetDevice(&dev);
        hipDeviceGetAttribute(&cus, hipDeviceAttributeMultiprocessorCount, dev);
        hipOccupancyMaxActiveBlocksPerMultiprocessor(&per_cu, mega_kernel, 256, 0);
        if (per_cu > 2) per_cu = 2;
        grid_blocks = cus * per_cu;
    }
    hipMemsetAsync(p.bar, 0, 4096, stream);
    void* args[] = {&p};
    hipError_t e = hipLaunchCooperativeKernel((void*)mega_kernel, dim3(grid_blocks), dim3(256), args, 0, stream);
    if (e != hipSuccess) fprintf(stderr, "cooperative launch failed: %s (grid %d)\n", hipGetErrorString(e), grid_blocks);
}
```

```cpp
#include <hip/hip_runtime.h>
#include <hip/hip_cooperative_groups.h>
#include <cstdio>
#include <cstdint>
namespace cg = cooperative_groups;


typedef unsigned short bf16_t;
typedef short bf16x8 __attribute__((ext_vector_type(8)));
typedef float f32x4 __attribute__((ext_vector_type(4)));
typedef unsigned u32x4 __attribute__((ext_vector_type(4)));
typedef unsigned u32x2 __attribute__((ext_vector_type(2)));

#define DM 1024
#define NTOK 32768
#define NROWS 33792
#define PC 5376
#define INC 8448
#define LOG2E 1.4426950408889634f
#define EPSN 1e-6f
#define LDS_BYTES 73728

#define C_RQ 0
#define C_RK 512
#define C_RV 1024
#define C_RG 1536
#define C_NQ 2048
#define C_NK 2560
#define C_NV 3072
#define C_NG 3584
#define C_GQ 4096
#define C_GK 4608
#define C_GV 4736
#define C_GG 4864
#define C_M  512

#define WT_IN 0
#define WT_RET (8448 * 1024)
#define WT_NA (WT_RET + 1024 * 512)
#define WT_GQA (WT_NA + 1024 * 512)
#define WT_OUT (WT_GQA + 1024 * 512)
#define WT_TOTAL (WT_OUT + 1024 * 1024)

#define VG(p) ((bf16_t*)((unsigned char*)(p).bar + 4096))
struct Params {
    const float *x, *c, *ctx, *c_ctx, *ada_w, *ada_b, *norm_w, *w_in, *ret_log_decay, *ret_gn_w, *na_rpb, *q_norm_w, *k_norm_w,
        *w_ret_o, *w_na_o, *w_gqa_o, *w_out, *final_norm_w;
    float* out;
    bf16_t* P;
    bf16_t* HX;
    bf16_t* Wt;
    bf16_t* SU;
    float* y;
    float* mod;
    float* rope;
    unsigned* bar;
};

__device__ __forceinline__ int tid_opaque() { int t = threadIdx.x; asm volatile("" : "+v"(t)); return t; }
__device__ __forceinline__ float bf2f(bf16_t v) { return __uint_as_float(((unsigned)v) << 16); }
typedef __bf16 bf16x2_t __attribute__((ext_vector_type(2)));
typedef float f32x2_t __attribute__((ext_vector_type(2)));
__device__ __forceinline__ unsigned pk2(float lo, float hi) {
    f32x2_t v = {lo, hi};
    union { bf16x2_t b; unsigned u; } x; x.b = __builtin_convertvector(v, bf16x2_t); return x.u;
}
__device__ __forceinline__ bf16_t f2bf(float f) { return (bf16_t)(pk2(f, 0.f) & 0xffffu); }
__device__ __forceinline__ float lo16(unsigned u) { return __uint_as_float(u << 16); }
__device__ __forceinline__ float hi16(unsigned u) { return __uint_as_float(u & 0xffff0000u); }
__device__ __forceinline__ float ex2(float x) { return __builtin_amdgcn_exp2f(x); }
__device__ __forceinline__ float silu_f(float x) { return x * __builtin_amdgcn_rcpf(1.f + ex2(-x * LOG2E)); }
__device__ __forceinline__ float sigm_f(float x) { return __builtin_amdgcn_rcpf(1.f + ex2(-x * LOG2E)); }
__device__ __forceinline__ f32x4 mfma16(bf16x8 a, bf16x8 b, f32x4 c) { return __builtin_amdgcn_mfma_f32_16x16x32_bf16(a, b, c, 0, 0, 0); }
__device__ __forceinline__ bf16x8 as_bf(u32x4 u) { union { u32x4 a; bf16x8 b; } x; x.a = u; return x.b; }
__device__ __forceinline__ u32x4 as_u(bf16x8 u) { union { u32x4 a; bf16x8 b; } x; x.b = u; return x.a; }
__device__ __forceinline__ u32x4 ldg16(const bf16_t* p) { return *(const u32x4*)p; }

template <int NI>
__device__ __forceinline__ void gemm_core(f32x4 (&acc)[NI][4], const bf16_t* __restrict__ X, int ldx, const bf16_t* __restrict__ W, int ldw, int K, unsigned char* lds) {
    const int t = tid_opaque(), lane = t & 63, w = t >> 6, wm = w >> 1, wn = w & 1;
    bf16_t* Xs = (bf16_t*)lds;
    bf16_t* Ws = Xs + 2 * 128 * 72;
    const int sr = t >> 3, sc = (t & 7) * 8;
    const bf16_t* xg = X + (size_t)sr * ldx + sc;
    const bf16_t* wg = W + (size_t)sr * ldw + sc;
    u32x4 xr[4], wr[NI];
#pragma unroll
    for (int i = 0; i < 4; ++i) xr[i] = ldg16(xg + (size_t)i * 32 * ldx);
#pragma unroll
    for (int i = 0; i < NI; ++i) wr[i] = ldg16(wg + (size_t)i * 32 * ldw);
    __syncthreads();
#pragma unroll
    for (int i = 0; i < 4; ++i) *(u32x4*)(Xs + (sr + i * 32) * 72 + sc) = xr[i];
#pragma unroll
    for (int i = 0; i < NI; ++i) *(u32x4*)(Ws + (sr + i * 32) * 72 + sc) = wr[i];
    __syncthreads();
    const int nk = K >> 6;
    for (int kt = 0; kt < nk; ++kt) {
        const int cur = kt & 1;
        if (kt + 1 < nk) {
            const int ko = (kt + 1) * 64;
#pragma unroll
            for (int i = 0; i < 4; ++i) xr[i] = ldg16(xg + (size_t)i * 32 * ldx + ko);
#pragma unroll
            for (int i = 0; i < NI; ++i) wr[i] = ldg16(wg + (size_t)i * 32 * ldw + ko);
        }
        __builtin_amdgcn_sched_barrier(0);
        const bf16_t* xs = Xs + cur * 128 * 72 + (wm * 64 + (lane & 15)) * 72 + (lane >> 4) * 8;
        const bf16_t* ws = Ws + cur * 128 * 72 + (wn * (NI * 16) + (lane & 15)) * 72 + (lane >> 4) * 8;
#pragma unroll
        for (int ks = 0; ks < 2; ++ks) {
            bf16x8 xf[4], wf[NI];
#pragma unroll
            for (int i = 0; i < 4; ++i) xf[i] = *(const bf16x8*)(xs + i * 16 * 72 + ks * 32);
#pragma unroll
            for (int i = 0; i < NI; ++i) wf[i] = *(const bf16x8*)(ws + i * 16 * 72 + ks * 32);
#pragma unroll
            for (int ni = 0; ni < NI; ++ni)
#pragma unroll
                for (int mi = 0; mi < 4; ++mi) acc[ni][mi] = mfma16(wf[ni], xf[mi], acc[ni][mi]);
        }
        if (kt + 1 < nk) {
            const int nx = cur ^ 1;
#pragma unroll
            for (int i = 0; i < 4; ++i) *(u32x4*)(Xs + nx * 128 * 72 + (sr + i * 32) * 72 + sc) = xr[i];
#pragma unroll
            for (int i = 0; i < NI; ++i) *(u32x4*)(Ws + nx * 128 * 72 + (sr + i * 32) * 72 + sc) = wr[i];
        }
        __syncthreads();
    }
}

__device__ __forceinline__ void gemm_big(f32x4 (&acc)[4][8], const bf16_t* __restrict__ X, int ldx, const bf16_t* __restrict__ W, int ldw, int K, unsigned char* lds) {
    const int t = tid_opaque(), lane = t & 63, w = t >> 6, wm = w >> 1, wn = w & 1;
    bf16_t* Xs = (bf16_t*)lds;
    bf16_t* Ws = Xs + 2 * 256 * 40;
    const int sr = t >> 2, sc = (t & 3) * 8;
    const bf16_t* xg = X + (size_t)sr * ldx + sc;
    const bf16_t* wg = W + (size_t)sr * ldw + sc;
    u32x4 ra[6], rb[6];
#define GB_LOAD(r, ko) do { _Pragma("unroll") for (int i = 0; i < 4; ++i) r[i] = ldg16(xg + (size_t)i * 64 * ldx + (ko)); _Pragma("unroll") for (int i = 0; i < 2; ++i) r[4 + i] = ldg16(wg + (size_t)i * 64 * ldw + (ko)); } while (0)
#define GB_ST1(r, st, i) do { if ((i) < 4) *(u32x4*)(Xs + (st) * 256 * 40 + (sr + (i) * 64) * 40 + sc) = r[i]; else *(u32x4*)(Ws + (st) * 128 * 40 + (sr + ((i) - 4) * 64) * 40 + sc) = r[i]; } while (0)
#define GB_STEP(st, r, dostore) do { \
        const bf16_t* xs = Xs + (st) * 256 * 40 + (wm * 128 + (lane & 15)) * 40 + (lane >> 4) * 8; \
        const bf16_t* ws = Ws + (st) * 128 * 40 + (wn * 64 + (lane & 15)) * 40 + (lane >> 4) * 8; \
        bf16x8 wf[4]; \
        _Pragma("unroll") for (int i = 0; i < 4; ++i) wf[i] = *(const bf16x8*)(ws + i * 16 * 40); \
        _Pragma("unroll") for (int mi = 0; mi < 8; ++mi) { \
            const bf16x8 xf = *(const bf16x8*)(xs + mi * 16 * 40); \
            _Pragma("unroll") for (int ni = 0; ni < 4; ++ni) acc[ni][mi] = mfma16(wf[ni], xf, acc[ni][mi]); \
            if ((dostore) && mi >= 1 && mi <= 6) GB_ST1(r, (st) ^ 1, mi - 1); } } while (0)
    GB_LOAD(ra, 0);
    GB_LOAD(rb, 32);
    __syncthreads();
#pragma unroll
    for (int i = 0; i < 6; ++i) GB_ST1(ra, 0, i);
    __syncthreads();
    const int nk = K >> 5;
    for (int kt = 0; kt < nk; kt += 2) {
        if (kt + 2 < nk) GB_LOAD(ra, (kt + 2) * 32);
        GB_STEP(0, rb, true);
        __syncthreads();
        if (kt + 3 < nk) GB_LOAD(rb, (kt + 3) * 32);
        GB_STEP(1, ra, kt + 2 < nk);
        __syncthreads();
    }
#undef GB_LOAD
#undef GB_ST1
#undef GB_STEP
}

__device__ void adaln_item(const Params& p, int item, unsigned char* lds) {
    const int t = tid_opaque(), lane = t & 63, w = t >> 6;
    const int l = item / 48, cgp = item % 48, j = cgp * 64 + lane;
    float* cs = (float*)lds;
    float* red = (float*)(lds + 20480);
    __syncthreads();
    for (int idx = t; idx < 5120; idx += 256) {
        const int bb = idx >> 10, k = idx & 1023;
        const float v = bb < 4 ? p.c[bb * 1024 + k] : p.c_ctx[k];
        cs[idx] = silu_f(v);
    }
    __syncthreads();
    float a0 = 0.f, a1 = 0.f, a2 = 0.f, a3 = 0.f, a4 = 0.f;
    const float* aw = p.ada_w + ((size_t)l * 1024 + w * 256) * 3072 + j;
    for (int k = 0; k < 256; ++k) {
        const float wv = aw[(size_t)k * 3072];
        const int kk = w * 256 + k;
        a0 += cs[kk] * wv; a1 += cs[1024 + kk] * wv; a2 += cs[2048 + kk] * wv; a3 += cs[3072 + kk] * wv; a4 += cs[4096 + kk] * wv;
    }
    red[(w * 5 + 0) * 64 + lane] = a0; red[(w * 5 + 1) * 64 + lane] = a1; red[(w * 5 + 2) * 64 + lane] = a2;
    red[(w * 5 + 3) * 64 + lane] = a3; red[(w * 5 + 4) * 64 + lane] = a4;
    __syncthreads();
    for (int idx = t; idx < 320; idx += 256) {
        const int bb = idx >> 6, ln = idx & 63;
        float v = p.ada_b[l * 3072 + cgp * 64 + ln];
#pragma unroll
        for (int ww = 0; ww < 4; ++ww) v += red[(ww * 5 + bb) * 64 + ln];
        p.mod[(l * 5 + bb) * 3072 + cgp * 64 + ln] = v;
    }
}

__device__ void transpose_tile(const float* __restrict__ src, int N, bf16_t* __restrict__ dst, int K, int k0, int n0, unsigned char* lds) {
    const int t = tid_opaque();
    bf16_t* T = (bf16_t*)lds;
    __syncthreads();
#pragma unroll
    for (int i = 0; i < 4; ++i) {
        const int k = (t >> 4) + 16 * i, n4 = (t & 15) * 4;
        const f32x4 v = *(const f32x4*)(src + (size_t)(k0 + k) * N + n0 + n4);
        T[(n4 + 0) * 72 + k] = f2bf(v[0]); T[(n4 + 1) * 72 + k] = f2bf(v[1]); T[(n4 + 2) * 72 + k] = f2bf(v[2]); T[(n4 + 3) * 72 + k] = f2bf(v[3]);
    }
    __syncthreads();
#pragma unroll
    for (int i = 0; i < 2; ++i) {
        const int cidx = t + 256 * i, n = cidx >> 3, kc = cidx & 7;
        *(u32x4*)(dst + (size_t)(n0 + n) * K + k0 + kc * 8) = *(const u32x4*)(T + n * 72 + kc * 8);
    }
}

#define NCONV_ITEMS (2112 + 3 * 128 + 256)
__device__ void convert_item(const Params& p, int l, int item, unsigned char* lds) {
    if (item < 2112) {
        const int kt = item / 132, nt = item % 132;
        transpose_tile(p.w_in + (size_t)l * 1024 * INC, INC, p.Wt + WT_IN, 1024, kt * 64, nt * 64, lds);
    } else if (item < 2112 + 384) {
        const int it = item - 2112, which = it / 128, r = it % 128, kt = r / 16, nt = r % 16;
        const float* src = (which == 0 ? p.w_ret_o : which == 1 ? p.w_na_o : p.w_gqa_o) + (size_t)l * 512 * 1024;
        bf16_t* dst = p.Wt + (which == 0 ? WT_RET : which == 1 ? WT_NA : WT_GQA);
        transpose_tile(src, 1024, dst, 512, kt * 64, nt * 64, lds);
    } else {
        const int it = item - 2112 - 384, kt = it / 16, nt = it % 16;
        transpose_tile(p.w_out + (size_t)l * 1024 * 1024, 1024, p.Wt + WT_OUT, 1024, kt * 64, nt * 64, lds);
    }
}

__device__ void rope_table(const Params& p) {
    for (int idx = tid_opaque(); idx < 2048; idx += 256) {
        const int pos = idx >> 4, i = idx & 15;
        const float f = ex2(-(float)i * (13.287712379549449f / 16.f));
        const float ang = (float)pos * f;
        float rev = ang * 0.15915494309189535f;
        rev = rev - rintf(rev);
        p.rope[idx * 2 + 0] = __builtin_amdgcn_cosf(rev);
        p.rope[idx * 2 + 1] = __builtin_amdgcn_sinf(rev);
    }
}

__device__ void phase_p0(const Params& p, unsigned char* lds) {
    const int total = 192 + NCONV_ITEMS + 1;
    for (int item = blockIdx.x; item < total; item += gridDim.x) {
        if (item < 192) adaln_item(p, item, lds);
        else if (item < 192 + NCONV_ITEMS) convert_item(p, 0, item - 192, lds);
        else rope_table(p);
    }
}

__device__ void norm_rows(const Params& p, int lnext, const float* xsrc, const float* ysrc) {
    const int t = tid_opaque(), lane = t & 63, w = t >> 6;
    const int nrows = lnext < 4 ? NROWS : NTOK;
    for (int row = blockIdx.x * 4 + w; row < nrows; row += gridDim.x * 4) {
        const float* src = row < NTOK ? xsrc + (size_t)row * DM : ysrc + (size_t)(row - NTOK) * DM;
        f32x4 v[4];
        float ss = 0.f;
#pragma unroll
        for (int i = 0; i < 4; ++i) { v[i] = *(const f32x4*)(src + i * 256 + lane * 4); ss += v[i][0] * v[i][0] + v[i][1] * v[i][1] + v[i][2] * v[i][2] + v[i][3] * v[i][3]; }
#pragma unroll
        for (int o = 32; o >= 1; o >>= 1) ss += __shfl_xor(ss, o);
        const float rstd = rsqrtf(ss * (1.f / 1024.f) + EPSN);
        if (lnext < 4) {
            const int bb = row < NTOK ? (row >> 13) : 4;
            const float* md = p.mod + (size_t)(lnext * 5 + bb) * 3072;
            const float* nw = p.norm_w + lnext * 1024;
#pragma unroll
            for (int i = 0; i < 4; ++i) {
                const int col = i * 256 + lane * 4;
                const f32x4 nwv = *(const f32x4*)(nw + col), sh = *(const f32x4*)(md + col), scl = *(const f32x4*)(md + 1024 + col);
                f32x4 h = v[i] * rstd * nwv * (scl + 1.f) + sh;
                u32x2 o2; o2.x = pk2(h[0], h[1]); o2.y = pk2(h[2], h[3]);
                *(u32x2*)(p.HX + (size_t)row * DM + col) = o2;
            }
        } else {
#pragma unroll
            for (int i = 0; i < 4; ++i) {
                const int col = i * 256 + lane * 4;
                const f32x4 nwv = *(const f32x4*)(p.final_norm_w + col);
                f32x4 ov = v[i] * rstd * nwv;
                *(f32x4*)(p.out + (size_t)row * DM + col) = ov;
            }
        }
    }
}

__device__ void phase_a(const Params& p, int l, unsigned char* lds) {
    const int t = tid_opaque(), lane = t & 63, w = t >> 6, wm = w >> 1, wn = w & 1;
    const int total = 132 * 42;
    const bool xmap = (gridDim.x & 7) == 0;
    const int per = xmap ? (total + 7) / 8 : total;
    const int lo = xmap ? (int)(blockIdx.x & 7) * per : 0, hi = min(lo + per, total);
    const int step = xmap ? (int)(gridDim.x >> 3) : (int)gridDim.x;
    for (int idx = lo + (xmap ? (int)(blockIdx.x >> 3) : (int)blockIdx.x); idx < hi; idx += step) {
        const int nb = idx / 924, rem = idx - nb * 924;
        const int mt = rem / 7, nt = nb * 7 + (rem - mt * 7);
        f32x4 acc[4][8];
#pragma unroll
        for (int a = 0; a < 4; ++a)
#pragma unroll
            for (int b = 0; b < 8; ++b) acc[a][b] = (f32x4){0.f, 0.f, 0.f, 0.f};
        gemm_big(acc, p.HX + (size_t)mt * 256 * DM, DM, p.Wt + WT_IN + (size_t)nt * 128 * DM, DM, DM, lds);
#pragma unroll
        for (int ni = 0; ni < 4; ++ni)
#pragma unroll
            for (int mi = 0; mi < 8; ++mi) {
                const int n = nt * 128 + wn * 64 + ni * 16 + (lane >> 4) * 4, m = mt * 256 + wm * 128 + mi * 16 + (lane & 15);
                u32x2 o2; o2.x = pk2(acc[ni][mi][0], acc[ni][mi][1]); o2.y = pk2(acc[ni][mi][2], acc[ni][mi][3]);
                *(u32x2*)(p.P + (size_t)m * PC + n) = o2;
            }
    }
}

__device__ __forceinline__ int chunk_row(int b, int cidx) { return cidx < 64 ? b * 8192 + cidx * 128 : NTOK + b * 256 + (cidx - 64) * 128; }

__device__ void ret_state_item(const Params& p, int l, int b, int h, int cidx, unsigned char* lds) {
    const int t = tid_opaque(), lane = t & 63, w = t >> 6, g = lane >> 4, c = lane & 15;
    bf16_t* Ktf = (bf16_t*)lds;
    bf16_t* Vt = Ktf + 128 * 72;
    const float lgf = -__expf(p.ret_log_decay[l * 8 + h]) * LOG2E, lgb = -__expf(p.ret_log_decay[l * 8 + 4 + h]) * LOG2E;
    const float ksc = 0.08838834764831845f;
    const int rowbase = chunk_row(b, cidx);
    for (int dir = 0; dir < 2; ++dir) {
        f32x4 acc[2][8];
#pragma unroll
        for (int i = 0; i < 2; ++i)
#pragma unroll
            for (int d = 0; d < 8; ++d) acc[i][d] = (f32x4){0.f, 0.f, 0.f, 0.f};
        const float lg = dir ? lgb : lgf;
#pragma unroll 1
        for (int half = 0; half < 2; ++half) {
            __syncthreads();
#pragma unroll
            for (int i = 0; i < 4; ++i) {
                const int cc = t + 256 * i, tok = cc & 63, dch = cc >> 6, j = half * 64 + tok;
                const float wgt = ex2(lg * (float)(dir ? j : 127 - j)) * ksc;
                const bf16_t* rp = p.P + (size_t)(rowbase + j) * PC + h * 128 + dch * 8;
                const u32x4 kv = ldg16(rp + C_RK), vv = ldg16(rp + C_RV);
#pragma unroll
                for (int e = 0; e < 4; ++e) {
                    const int r0 = (dch * 8 + 2 * e) * 72 + tok, r1 = r0 + 72;
                    Ktf[r0] = f2bf(lo16(kv[e]) * wgt); Ktf[r1] = f2bf(hi16(kv[e]) * wgt);
                    Vt[r0] = (bf16_t)(vv[e] & 0xffffu); Vt[r1] = (bf16_t)(vv[e] >> 16);
                }
            }
            __syncthreads();
#pragma unroll
            for (int ks = 0; ks < 2; ++ks) {
                bf16x8 kf[2];
#pragma unroll
                for (int i = 0; i < 2; ++i) kf[i] = *(const bf16x8*)(Ktf + (w * 32 + i * 16 + c) * 72 + ks * 32 + g * 8);
#pragma unroll
                for (int d = 0; d < 8; ++d) {
                    const bf16x8 vf = *(const bf16x8*)(Vt + (d * 16 + c) * 72 + ks * 32 + g * 8);
#pragma unroll
                    for (int i = 0; i < 2; ++i) acc[i][d] = mfma16(kf[i], vf, acc[i][d]);
                }
            }
        }
        bf16_t* Sd = p.SU + ((size_t)((dir * 4 + b) * 4 + h) * 66 + cidx) * 16384;
#pragma unroll
        for (int i = 0; i < 2; ++i)
#pragma unroll
            for (int d = 0; d < 8; ++d) {
                const int dk = w * 32 + i * 16 + g * 4, dv = d * 16 + c;
                u32x2 o2; o2.x = pk2(acc[i][d][0], acc[i][d][1]); o2.y = pk2(acc[i][d][2], acc[i][d][3]);
                *(u32x2*)(Sd + dv * 128 + dk) = o2;
            }
    }
}

__device__ void qk_prep_item(const Params& p, int l, int item) {
    const int t = tid_opaque(), tok = t >> 2, sub = t & 3;
    const int row = item * 64 + tok;
    const bool lat = row < NTOK;
    const int tseq = row & 8191, pr = tseq >> 6, pc = tseq & 63;
    for (int hv = sub; hv < 10; hv += 4) {
        bf16_t* ptr = p.P + (size_t)row * PC + (hv < 8 ? C_GQ + hv * 64 : C_GK + (hv - 8) * 64);
        const float* nw = hv < 8 ? p.q_norm_w + l * 64 : p.k_norm_w + l * 64;
        float x[64];
        float ss = 0.f;
#pragma unroll
        for (int i = 0; i < 8; ++i) {
            const u32x4 u = ldg16(ptr + i * 8);
#pragma unroll
            for (int e = 0; e < 4; ++e) { x[i * 8 + 2 * e] = lo16(u[e]); x[i * 8 + 2 * e + 1] = hi16(u[e]); }
        }
#pragma unroll
        for (int d = 0; d < 64; ++d) ss += x[d] * x[d];
        const float rstd = rsqrtf(ss * (1.f / 64.f) + EPSN);
        const float qs = hv < 8 ? 0.125f * LOG2E : 1.f;
#pragma unroll
        for (int d = 0; d < 64; ++d) x[d] = x[d] * (rstd * qs) * nw[d];
        if (lat) {
#pragma unroll
            for (int i = 0; i < 16; ++i) {
                const float cr = p.rope[(pr * 16 + i) * 2], sr = p.rope[(pr * 16 + i) * 2 + 1];
                const float cc = p.rope[(pc * 16 + i) * 2], sc = p.rope[(pc * 16 + i) * 2 + 1];
                const float a = x[i], b2 = x[16 + i], a2 = x[32 + i], b3 = x[48 + i];
                x[i] = a * cr - b2 * sr; x[16 + i] = b2 * cr + a * sr;
                x[32 + i] = a2 * cc - b3 * sc; x[48 + i] = b3 * cc + a2 * sc;
            }
        }
#pragma unroll
        for (int i = 0; i < 8; ++i) {
            u32x4 u;
#pragma unroll
            for (int e = 0; e < 4; ++e) u[e] = pk2(x[i * 8 + 2 * e], x[i * 8 + 2 * e + 1]);
            *(u32x4*)(ptr + i * 8) = u;
        }
    }
    {
        const int b = lat ? (row >> 13) : ((row - NTOK) >> 8);
        const int key = lat ? tseq : 8192 + ((row - NTOK) & 255);
        const bf16_t* vp = p.P + (size_t)row * PC + C_GV + sub * 32;
        bf16_t* dst = VG(p) + ((size_t)(b * 2 + (sub >> 1)) * 64 + (sub & 1) * 32) * 8448 + key;
#pragma unroll
        for (int i = 0; i < 4; ++i) {
            const u32x4 u = ldg16(vp + i * 8);
#pragma unroll
            for (int e = 0; e < 4; ++e) {
                dst[(size_t)(i * 8 + 2 * e) * 8448] = (bf16_t)(u[e] & 0xffffu);
                dst[(size_t)(i * 8 + 2 * e + 1) * 8448] = (bf16_t)(u[e] >> 16);
            }
        }
    }
}

__device__ void phase_b(const Params& p, int l, unsigned char* lds) {
    const int total = 1056 + 528;
    for (int item = blockIdx.x; item < total; item += gridDim.x) {
        if (item < 1056) { const int cidx = item % 66, bh = item / 66; ret_state_item(p, l, bh >> 2, bh & 3, cidx, lds);
        }
        else qk_prep_item(p, l, item - 1056);
    }
}

__device__ void phase_c(const Params& p, int l, bool dostore = true) {
    const int t = tid_opaque();
    for (int item = blockIdx.x; item < 256; item += gridDim.x) {
        const int part = item & 7, dbh = item >> 3, dir = dbh >> 4, h = dbh & 3;
        const float lg = -__expf(p.ret_log_decay[l * 8 + dir * 4 + h]) * LOG2E;
        const float gc = ex2(lg * 128.f);
        bf16_t* base = p.SU + (size_t)dbh * 66 * 16384 + part * 2048 + t * 8;
        float s[8];
#pragma unroll
        for (int e = 0; e < 8; ++e) s[e] = 0.f;
        for (int st0 = 0; st0 < 66; st0 += 11) {
            u32x4 u[11];
#pragma unroll
            for (int q = 0; q < 11; ++q) {
                const int st = st0 + q;
                const int n = dir == 0 ? (st < 2 ? 64 + st : st - 2) : (st < 2 ? 65 - st : 65 - st);
                u[q] = *(const u32x4*)(base + (size_t)n * 16384);
            }
#pragma unroll
            for (int q = 0; q < 11; ++q) {
                const int st = st0 + q;
                const int n = dir == 0 ? (st < 2 ? 64 + st : st - 2) : (st < 2 ? 65 - st : 65 - st);
                u32x4 o;
#pragma unroll
                for (int e = 0; e < 4; ++e) o[e] = pk2(s[2 * e], s[2 * e + 1]);
                if (dostore) *(u32x4*)(base + (size_t)n * 16384) = o;
#pragma unroll
                for (int e = 0; e < 4; ++e) { s[2 * e] = gc * s[2 * e] + lo16(u[q][e]); s[2 * e + 1] = gc * s[2 * e + 1] + hi16(u[q][e]); }
            }
        }
    }
}

template <int MODE>
__device__ void attn_item(const Params& p, int l, int b, int i1, int i2, int i3, unsigned char* lds, bool dostore = true) {
    constexpr int NQB = (MODE == 2) ? 2 : 4, NHQ = NQB / 2;
    const int t = tid_opaque(), lane = t & 63, w = t >> 6, g = lane >> 4, c = lane & 15;
    bf16_t* Ks = (bf16_t*)lds;
    bf16_t* Vt = Ks + 2 * 64 * 72;
    u32x4* Qs = (u32x4*)(lds + 36864) + w * 512;
    float* rpbs = (float*)(lds + 36864 + 32768);
    int qbase, qstep, qcol, kcol, vcol, gcol, ntiles;
    int R0 = 0, c0 = 0, start = 0, bstart = 0, hh = 0;
    if (MODE == 0 || MODE == 1) {
        const int kvh = i1, qt = i2, head = kvh * 4 + w;
        qbase = (MODE == 0 ? b * 8192 : NTOK + b * 256) + qt * 64; qstep = 16;
        qcol = C_GQ + head * 64; kcol = C_GK + kvh * 64; vcol = C_GV + kvh * 64; gcol = C_GG + head * 64;
        ntiles = MODE == 0 ? 132 : 4;
    } else if (MODE == 2) {
        hh = i1; R0 = i2 * 8; c0 = i3 * 16;
        start = min(max(R0 - 4, 0), 112); bstart = min(max(c0 - 8, 0), 32);
        qbase = b * 8192 + (R0 + w * 2) * 64 + c0; qstep = 64;
        qcol = C_NQ + hh * 64; kcol = C_NK + hh * 64; vcol = C_NV + hh * 64; gcol = C_NG + hh * 64;
        ntiles = 12;
    } else {
        hh = i1;
        qbase = NTOK + b * 256 + w * 64; qstep = 16;
        qcol = C_NQ + hh * 64; kcol = C_NK + hh * 64; vcol = C_NV + hh * 64; gcol = C_NG + hh * 64;
        ntiles = 4;
    }
    const float scale = 0.125f * LOG2E;
    f32x4 o[NQB][4];
    float mrun[NQB], lsum[NQB];
#pragma unroll
    for (int qb = 0; qb < NQB; ++qb) {
        mrun[qb] = -INFINITY; lsum[qb] = 0.f;
#pragma unroll
        for (int d = 0; d < 4; ++d) o[qb][d] = (f32x4){0.f, 0.f, 0.f, 0.f};
    }
    const int kkey = t >> 3, kch = (t & 7) * 8;
    const int vkey = t & 63, vch = (t >> 6);
    u32x4 kr[2], vr[2];
    auto load_tile = [&](int tt) {
        int base, rstep;
        if (MODE == 0) { base = tt < 128 ? b * 8192 + tt * 64 : NTOK + b * 256 + (tt - 128) * 64; rstep = 32; }
        else if (MODE == 2) {
            if (tt < 4) { base = NTOK + b * 256 + tt * 64; rstep = 32; }
            else { base = b * 8192 + (start + 2 * (tt - 4)) * 64 + bstart; rstep = 64; }
        } else { base = NTOK + b * 256 + tt * 64; rstep = 32; }
#pragma unroll
        for (int i = 0; i < 2; ++i) {
            const int key = kkey + 32 * i;
            kr[i] = ldg16(p.P + (size_t)(base + (key >> 5) * rstep + (key & 31)) * PC + kcol + kch);
            if (MODE <= 1) vr[i] = ldg16(VG(p) + ((size_t)(b * 2 + i1) * 64 + kkey + 32 * i) * 8448 + (MODE == 0 ? tt * 64 : 8192 + tt * 64) + kch);
            else vr[i] = ldg16(p.P + (size_t)(base + (vkey >> 5) * rstep + (vkey & 31)) * PC + vcol + (vch + 4 * i) * 8);
        }
    };
    auto store_tile = [&](int buf) {
        bf16_t* ks_ = Ks + buf * 64 * 72; bf16_t* vt_ = Vt + buf * 64 * 72;
#pragma unroll
        for (int i = 0; i < 2; ++i) {
            *(u32x4*)(ks_ + (kkey + 32 * i) * 72 + kch) = kr[i];
            if (MODE <= 1) { *(u32x4*)(vt_ + (kkey + 32 * i) * 72 + kch) = vr[i]; continue; }
#pragma unroll
            for (int e = 0; e < 4; ++e) {
                const int d = (vch + 4 * i) * 8 + 2 * e;
                vt_[d * 72 + vkey] = (bf16_t)(vr[i][e] & 0xffffu);
                vt_[(d + 1) * 72 + vkey] = (bf16_t)(vr[i][e] >> 16);
            }
        }
    };
    load_tile(0);
    __syncthreads();
#pragma unroll
    for (int qb = 0; qb < NQB; ++qb)
#pragma unroll
        for (int ks = 0; ks < 2; ++ks) Qs[(qb * 2 + ks) * 64 + lane] = ldg16(p.P + (size_t)(qbase + qb * qstep + c) * PC + qcol + ks * 32 + g * 8);
    if (MODE == 2) for (int idx = t; idx < 465; idx += 256) rpbs[idx] = p.na_rpb[((size_t)l * 8 + hh) * 465 + idx] * LOG2E;
    store_tile(0);
    __syncthreads();
    const int wlo = min(max(R0 + w * 2 - 4, 0), 120), whi = min(max(R0 + w * 2 + 1 - 4, 0), 120) + 7;
    int colterm[8];
    if (MODE == 2) {
        const int qc = c0 + c, cs = min(max(qc - 8, 0), 48);
#pragma unroll
        for (int j = 0; j < 8; ++j) {
            const int kc = bstart + (j >> 2) * 16 + g * 4 + (j & 3);
            colterm[j] = ((unsigned)(kc - cs) < 16u) ? (kc - qc + 15) : -1;
        }
    }
    for (int tt = 0; tt < ntiles; ++tt) {
        const int cur = tt & 1;
        if (tt + 1 < ntiles) load_tile(tt + 1);
        bool skip = false;
        int krow0 = 0;
        if (MODE == 2 && tt >= 4) { krow0 = start + 2 * (tt - 4); skip = (krow0 + 1 < wlo) || (krow0 > whi); }
        if (!skip) {
            const bf16_t* ks_ = Ks + cur * 64 * 72; const bf16_t* vt_ = Vt + cur * 64 * 72;
            f32x4 s[NQB][4];
#pragma unroll
            for (int qq = 0; qq < NQB; ++qq)
#pragma unroll
                for (int kb = 0; kb < 4; ++kb) s[qq][kb] = (f32x4){0.f, 0.f, 0.f, 0.f};
#pragma unroll
            for (int ks = 0; ks < 2; ++ks) {
                bf16x8 qv[NQB];
#pragma unroll
                for (int qq = 0; qq < NQB; ++qq) qv[qq] = as_bf(Qs[(qq * 2 + ks) * 64 + lane]);
#pragma unroll
                for (int kb = 0; kb < 4; ++kb) {
                    const bf16x8 kf = *(const bf16x8*)(ks_ + (kb * 16 + c) * 72 + ks * 32 + g * 8);
#pragma unroll
                    for (int qq = 0; qq < NQB; ++qq) s[qq][kb] = mfma16(kf, qv[qq], s[qq][kb]);
                }
            }
            __builtin_amdgcn_sched_barrier(0);
            bf16x8 pf[NQB][2];
#pragma unroll
            for (int qq = 0; qq < NQB; ++qq) {
                const int qb = qq;
                if (MODE == 2 && tt >= 4) {
                    const int qrow = R0 + w * 2 + qb;
                    const int rs = min(max(qrow - 4, 0), 120);
#pragma unroll
                    for (int kb = 0; kb < 4; ++kb) {
                        const int krow = krow0 + (kb >> 1);
                        const bool rowok = (unsigned)(krow - rs) < 8u;
                        const int ridx = (krow - qrow + 7) * 31;
#pragma unroll
                        for (int r = 0; r < 4; ++r) {
                            const int ct = colterm[(kb & 1) * 4 + r];
                            const bool valid = rowok && ct >= 0;
                            const float bias = rpbs[valid ? ridx + ct : 0];
                            s[qq][kb][r] = valid ? s[qq][kb][r] * scale + bias : -INFINITY;
                        }
                    }
                }
                const bool raw = !(MODE == 2 && tt >= 4);
                float tmax = fmaxf(fmaxf(s[qq][0][0], s[qq][0][1]), fmaxf(s[qq][0][2], s[qq][0][3]));
#pragma unroll
                for (int kb = 1; kb < 4; ++kb) tmax = fmaxf(tmax, fmaxf(fmaxf(s[qq][kb][0], s[qq][kb][1]), fmaxf(s[qq][kb][2], s[qq][kb][3])));
                tmax = fmaxf(tmax, __shfl_xor(tmax, 16)); tmax = fmaxf(tmax, __shfl_xor(tmax, 32));
                const float mn = fmaxf(mrun[qb], raw ? tmax * scale : tmax);
                const float alpha = ex2(mrun[qb] - mn);
                mrun[qb] = mn;
                float psum = 0.f;
#pragma unroll
                for (int kb = 0; kb < 4; ++kb)
#pragma unroll
                    for (int r = 0; r < 4; ++r) { const float pv = raw ? ex2(__builtin_fmaf(s[qq][kb][r], scale, -mn)) : ex2(s[qq][kb][r] - mn); s[qq][kb][r] = pv; psum += pv; }
                lsum[qb] = lsum[qb] * alpha + psum;
                if (__builtin_amdgcn_ballot_w64(alpha != 1.f) != 0ull) {
#pragma unroll
                    for (int d = 0; d < 4; ++d) o[qb][d] = o[qb][d] * alpha;
                }
#pragma unroll
                for (int kk = 0; kk < 2; ++kk) {
                    u32x4 u;
                    u[0] = pk2(s[qq][2 * kk][0], s[qq][2 * kk][1]); u[1] = pk2(s[qq][2 * kk][2], s[qq][2 * kk][3]);
                    u[2] = pk2(s[qq][2 * kk + 1][0], s[qq][2 * kk + 1][1]); u[3] = pk2(s[qq][2 * kk + 1][2], s[qq][2 * kk + 1][3]);
                    pf[qq][kk] = as_bf(u);
                }
            }
            __builtin_amdgcn_sched_barrier(0);
#pragma unroll
            for (int kk = 0; kk < 2; ++kk)
#pragma unroll
                for (int d = 0; d < 4; ++d) {
                    const u32x2 vlo = *(const u32x2*)(vt_ + (d * 16 + c) * 72 + kk * 32 + g * 4);
                    const u32x2 vhi = *(const u32x2*)(vt_ + (d * 16 + c) * 72 + kk * 32 + 16 + g * 4);
                    u32x4 vv; vv[0] = vlo[0]; vv[1] = vlo[1]; vv[2] = vhi[0]; vv[3] = vhi[1];
                    const bf16x8 vf = as_bf(vv);
#pragma unroll
                    for (int qq = 0; qq < NQB; ++qq) o[qq][d] = mfma16(vf, pf[qq][kk], o[qq][d]);
                }
        }
        if (tt + 1 < ntiles) store_tile(cur ^ 1);
        __syncthreads();
    }
    if (dostore)
#pragma unroll
    for (int qb = 0; qb < NQB; ++qb) {
        float ls = lsum[qb];
        ls += __shfl_xor(ls, 16); ls += __shfl_xor(ls, 32);
        const float inv = __builtin_amdgcn_rcpf(ls);
        bf16_t* rowp = p.P + (size_t)(qbase + qb * qstep + c) * PC;
#pragma unroll
        for (int d = 0; d < 4; ++d) {
            const int dd = d * 16 + g * 4;
            const u32x2 gt = *(const u32x2*)(rowp + gcol + dd);
            const float v0 = o[qb][d][0] * inv * silu_f(lo16(gt[0])), v1 = o[qb][d][1] * inv * silu_f(hi16(gt[0]));
            const float v2 = o[qb][d][2] * inv * silu_f(lo16(gt[1])), v3 = o[qb][d][3] * inv * silu_f(hi16(gt[1]));
            u32x2 o2; o2.x = pk2(v0, v1); o2.y = pk2(v2, v3);
            *(u32x2*)(rowp + qcol + dd) = o2;
        }
    }
}

typedef float f32x16 __attribute__((ext_vector_type(16)));
__device__ __forceinline__ f32x16 mfma32(bf16x8 a, bf16x8 b, f32x16 c) { return __builtin_amdgcn_mfma_f32_32x32x16_bf16(a, b, c, 0, 0, 0); }

template <int MODE, bool FIXM>
__device__ void attn_item32(const Params& p, int l, int b, int i1, int i2, unsigned char* lds, float mfix, bool dostore = true) {
    const int t = tid_opaque(), lane = t & 63, w = t >> 6, h = lane >> 5, c = lane & 31;
    bf16_t* Ks = (bf16_t*)lds;
    bf16_t* Vt = Ks + 2 * 64 * 72;
    u32x4* Qs = (u32x4*)(lds + 36864) + w * 512;
    int qbase, qcol, kcol, vcol, gcol, ntiles;
    if (MODE == 0 || MODE == 1) {
        const int kvh = i1, qt = i2, head = kvh * 4 + w;
        qbase = (MODE == 0 ? b * 8192 : NTOK + b * 256) + qt * 64;
        qcol = C_GQ + head * 64; kcol = C_GK + kvh * 64; vcol = C_GV + kvh * 64; gcol = C_GG + head * 64;
        ntiles = MODE == 0 ? 132 : 4;
    } else {
        const int hh = i1;
        qbase = NTOK + b * 256 + w * 64;
        qcol = C_NQ + hh * 64; kcol = C_NK + hh * 64; vcol = C_NV + hh * 64; gcol = C_NG + hh * 64;
        ntiles = 4;
    }
    const float scale = MODE <= 1 ? 1.f : 0.125f * LOG2E;
    f32x16 o[2][2];
    float mrun[2], lsum[2];
#pragma unroll
    for (int qb = 0; qb < 2; ++qb) {
        mrun[qb] = -INFINITY; lsum[qb] = 0.f;
#pragma unroll
        for (int d = 0; d < 2; ++d)
#pragma unroll
            for (int r = 0; r < 16; ++r) o[qb][d][r] = 0.f;
    }
    const int kkey = t >> 3, kch = (t & 7) * 8;
    const int vkey = t & 63, vch = (t >> 6);
    u32x4 kr[2], vr[2];
    auto load_tile = [&](int tt) {
        const int base = MODE == 0 ? (tt < 128 ? b * 8192 + tt * 64 : NTOK + b * 256 + (tt - 128) * 64) : NTOK + b * 256 + tt * 64;
#pragma unroll
        for (int i = 0; i < 2; ++i) {
            kr[i] = ldg16(p.P + (size_t)(base + kkey + 32 * i) * PC + kcol + kch);
            if (MODE <= 1) vr[i] = ldg16(VG(p) + ((size_t)(b * 2 + i1) * 64 + kkey + 32 * i) * 8448 + (MODE == 0 ? tt * 64 : 8192 + tt * 64) + kch);
            else vr[i] = ldg16(p.P + (size_t)(base + vkey) * PC + vcol + (vch + 4 * i) * 8);
        }
    };
    auto store_tile = [&](int buf) {
        bf16_t* ks_ = Ks + buf * 64 * 72; bf16_t* vt_ = Vt + buf * 64 * 72;
#pragma unroll
        for (int i = 0; i < 2; ++i) {
            *(u32x4*)(ks_ + (kkey + 32 * i) * 72 + kch) = kr[i];
            if (MODE <= 1) { *(u32x4*)(vt_ + (kkey + 32 * i) * 72 + kch) = vr[i]; continue; }
#pragma unroll
            for (int e = 0; e < 4; ++e) {
                const int d = (vch + 4 * i) * 8 + 2 * e;
                vt_[d * 72 + vkey] = (bf16_t)(vr[i][e] & 0xffffu);
                vt_[(d + 1) * 72 + vkey] = (bf16_t)(vr[i][e] >> 16);
            }
        }
    };
    load_tile(0);
    __syncthreads();
#pragma unroll
    for (int qb = 0; qb < 2; ++qb)
#pragma unroll
        for (int ks = 0; ks < 4; ++ks) Qs[(qb * 4 + ks) * 64 + lane] = ldg16(p.P + (size_t)(qbase + qb * 32 + c) * PC + qcol + ks * 16 + h * 8);
    store_tile(0);
    __syncthreads();
    for (int tt = 0; tt < ntiles; ++tt) {
        const int cur = tt & 1;
        if (tt + 1 < ntiles) load_tile(tt + 1);
        const bf16_t* ks_ = Ks + cur * 64 * 72; const bf16_t* vt_ = Vt + cur * 64 * 72;
        f32x16 s[2][2];
#pragma unroll
        for (int qb = 0; qb < 2; ++qb)
#pragma unroll
            for (int kb = 0; kb < 2; ++kb)
#pragma unroll
                for (int r = 0; r < 16; ++r) s[qb][kb][r] = FIXM ? -mfix : 0.f;
#pragma unroll
        for (int ks = 0; ks < 4; ++ks) {
            const bf16x8 q0 = as_bf(Qs[ks * 64 + lane]), q1 = as_bf(Qs[(4 + ks) * 64 + lane]);
#pragma unroll
            for (int kb = 0; kb < 2; ++kb) {
                const bf16x8 kf = *(const bf16x8*)(ks_ + (kb * 32 + c) * 72 + ks * 16 + h * 8);
                s[0][kb] = mfma32(kf, q0, s[0][kb]);
                s[1][kb] = mfma32(kf, q1, s[1][kb]);
            }
        }
        bf16x8 pf[2][4];
#pragma unroll
        for (int qb = 0; qb < 2; ++qb) {
            float psum = 0.f;
            if (FIXM) {
#pragma unroll
                for (int kb = 0; kb < 2; ++kb)
#pragma unroll
                    for (int r = 0; r < 16; ++r) { const float pv = ex2(s[qb][kb][r]); s[qb][kb][r] = pv; psum += pv; }
                lsum[qb] += psum;
            } else {
                float tmax = s[qb][0][0];
#pragma unroll
                for (int kb = 0; kb < 2; ++kb)
#pragma unroll
                    for (int r = 0; r < 16; r += 4) tmax = fmaxf(tmax, fmaxf(fmaxf(s[qb][kb][r], s[qb][kb][r + 1]), fmaxf(s[qb][kb][r + 2], s[qb][kb][r + 3])));
                tmax = fmaxf(tmax, __shfl_xor(tmax, 32));
                const float mn = fmaxf(mrun[qb], tmax * scale);
                const float alpha = ex2(mrun[qb] - mn);
                mrun[qb] = mn;
#pragma unroll
                for (int kb = 0; kb < 2; ++kb)
#pragma unroll
                    for (int r = 0; r < 16; ++r) { const float pv = ex2(__builtin_fmaf(s[qb][kb][r], scale, -mn)); s[qb][kb][r] = pv; psum += pv; }
                lsum[qb] = lsum[qb] * alpha + psum;
                if (__builtin_amdgcn_ballot_w64(alpha != 1.f) != 0ull) {
#pragma unroll
                    for (int d = 0; d < 2; ++d)
#pragma unroll
                        for (int r = 0; r < 16; ++r) o[qb][d][r] *= alpha;
                }
            }
#pragma unroll
            for (int kb = 0; kb < 2; ++kb)
#pragma unroll
                for (int st = 0; st < 2; ++st) {
                    u32x4 u;
#pragma unroll
                    for (int e = 0; e < 4; ++e) u[e] = pk2(s[qb][kb][8 * st + 2 * e], s[qb][kb][8 * st + 2 * e + 1]);
                    pf[qb][kb * 2 + st] = as_bf(u);
                }
        }
#pragma unroll
        for (int kk = 0; kk < 4; ++kk)
#pragma unroll
            for (int d = 0; d < 2; ++d) {
                const u32x2 vlo = *(const u32x2*)(vt_ + (d * 32 + c) * 72 + kk * 16 + h * 4);
                const u32x2 vhi = *(const u32x2*)(vt_ + (d * 32 + c) * 72 + kk * 16 + 8 + h * 4);
                u32x4 vv; vv[0] = vlo[0]; vv[1] = vlo[1]; vv[2] = vhi[0]; vv[3] = vhi[1];
                const bf16x8 vf = as_bf(vv);
                o[0][d] = mfma32(vf, pf[0][kk], o[0][d]);
                o[1][d] = mfma32(vf, pf[1][kk], o[1][d]);
            }
        if (tt + 1 < ntiles) store_tile(cur ^ 1);
        __syncthreads();
    }
    if (dostore)
#pragma unroll
    for (int qb = 0; qb < 2; ++qb) {
        float ls = lsum[qb];
        ls += __shfl_xor(ls, 32);
        const float inv = __builtin_amdgcn_rcpf(ls);
        bf16_t* rowp = p.P + (size_t)(qbase + qb * 32 + c) * PC;
#pragma unroll
        for (int d = 0; d < 2; ++d)
#pragma unroll
            for (int rg = 0; rg < 4; ++rg) {
                const int dd = d * 32 + rg * 8 + h * 4;
                const u32x2 gt = *(const u32x2*)(rowp + gcol + dd);
                const float v0 = o[qb][d][rg * 4 + 0] * inv * silu_f(lo16(gt[0])), v1 = o[qb][d][rg * 4 + 1] * inv * silu_f(hi16(gt[0]));
                const float v2 = o[qb][d][rg * 4 + 2] * inv * silu_f(lo16(gt[1])), v3 = o[qb][d][rg * 4 + 3] * inv * silu_f(hi16(gt[1]));
                u32x2 o2; o2.x = pk2(v0, v1); o2.y = pk2(v2, v3);
                *(u32x2*)(rowp + qcol + dd) = o2;
            }
    }
}

__device__ __forceinline__ bf16x8 scale_frag(bf16x8 f, float sc) {
    u32x4 u = as_u(f), r;
#pragma unroll
    for (int e = 0; e < 4; ++e) r[e] = pk2(lo16(u[e]) * sc, hi16(u[e]) * sc);
    return as_bf(r);
}

__device__ void ret_item(const Params& p, int l, int b, int h, int cidx, int hf, unsigned char* lds, bool dostore = true) {
    const int t = tid_opaque(), lane = t & 63, w = t >> 6, g = lane >> 4, c = lane & 15;
    bf16_t* B0 = (bf16_t*)lds;
    bf16_t* B1 = B0 + 128 * 136;
    const float lgf = -__expf(p.ret_log_decay[l * 8 + h]) * LOG2E, lgb = -__expf(p.ret_log_decay[l * 8 + 4 + h]) * LOG2E;
    const float ksc = 0.08838834764831845f;
    const int rowbase = chunk_row(b, cidx);
    const int ti = hf * 64 + w * 16 + c;
    bf16x8 qf[4];
#pragma unroll
    for (int ks = 0; ks < 4; ++ks) qf[ks] = as_bf(ldg16(p.P + (size_t)(rowbase + ti) * PC + C_RQ + h * 128 + ks * 32 + g * 8));
    __syncthreads();
#pragma unroll
    for (int i = 0; i < 8; ++i) {
        const int cc = t + 256 * i;
        { const int r = cc >> 4, ch = cc & 15; *(u32x4*)(B0 + r * 136 + ch * 8) = ldg16(p.P + (size_t)(rowbase + r) * PC + C_RK + h * 128 + ch * 8); }
        { const int tok = cc & 127, ch = cc >> 7;
          const u32x4 vv = ldg16(p.P + (size_t)(rowbase + tok) * PC + C_RV + h * 128 + ch * 8);
#pragma unroll
          for (int e = 0; e < 4; ++e) { B1[(ch * 8 + 2 * e) * 136 + tok] = (bf16_t)(vv[e] & 0xffffu); B1[(ch * 8 + 2 * e + 1) * 136 + tok] = (bf16_t)(vv[e] >> 16); } }
    }
    __syncthreads();
    bf16x8 pf[4];
    {
        f32x4 s[8];
#pragma unroll
        for (int kb = 0; kb < 8; ++kb) s[kb] = (f32x4){0.f, 0.f, 0.f, 0.f};
#pragma unroll
        for (int ks = 0; ks < 4; ++ks)
#pragma unroll
            for (int kb = 0; kb < 8; ++kb) {
                const bf16x8 kf = *(const bf16x8*)(B0 + (kb * 16 + c) * 136 + ks * 32 + g * 8);
                s[kb] = mfma16(kf, qf[ks], s[kb]);
            }
#pragma unroll
        for (int kb = 0; kb < 8; ++kb)
#pragma unroll
            for (int r = 0; r < 4; ++r) {
                const int j = kb * 16 + g * 4 + r, d = ti - j;
                const float wgt = d > 0 ? ex2(lgf * (float)d) : (d < 0 ? ex2(lgb * (float)(-d)) : 2.f);
                s[kb][r] *= wgt * ksc;
            }
#pragma unroll
        for (int kk = 0; kk < 4; ++kk) {
            u32x4 u;
            u[0] = pk2(s[2 * kk][0], s[2 * kk][1]); u[1] = pk2(s[2 * kk][2], s[2 * kk][3]);
            u[2] = pk2(s[2 * kk + 1][0], s[2 * kk + 1][1]); u[3] = pk2(s[2 * kk + 1][2], s[2 * kk + 1][3]);
            pf[kk] = as_bf(u);
        }
    }
    f32x4 o[8];
#pragma unroll
    for (int d = 0; d < 8; ++d) o[d] = (f32x4){0.f, 0.f, 0.f, 0.f};
#pragma unroll
    for (int kk = 0; kk < 4; ++kk)
#pragma unroll
        for (int d = 0; d < 8; ++d) {
            const u32x2 vlo = *(const u32x2*)(B1 + (d * 16 + c) * 136 + kk * 32 + g * 4);
            const u32x2 vhi = *(const u32x2*)(B1 + (d * 16 + c) * 136 + kk * 32 + 16 + g * 4);
            u32x4 vv; vv[0] = vlo[0]; vv[1] = vlo[1]; vv[2] = vhi[0]; vv[3] = vhi[1];
            o[d] = mfma16(as_bf(vv), pf[kk], o[d]);
        }
    __syncthreads();
    {
        const bf16_t* Sf = p.SU + ((size_t)((0 * 4 + b) * 4 + h) * 66 + cidx) * 16384;
        const bf16_t* Sb = p.SU + ((size_t)((1 * 4 + b) * 4 + h) * 66 + cidx) * 16384;
#pragma unroll
        for (int i = 0; i < 8; ++i) {
            const int cc = t + 256 * i, r = cc >> 4, ch = cc & 15;
            *(u32x4*)(B0 + r * 136 + ch * 8) = ldg16(Sf + r * 128 + ch * 8);
            *(u32x4*)(B1 + r * 136 + ch * 8) = ldg16(Sb + r * 128 + ch * 8);
        }
    }
    __syncthreads();
#pragma unroll
    for (int dir = 0; dir < 2; ++dir) {
        const bf16_t* Bd = dir ? B1 : B0;
        const float xi = dir == 0 ? ex2(lgf * (float)(ti + 1)) : ex2(lgb * (float)(128 - ti));
        bf16x8 qs[4];
#pragma unroll
        for (int ks = 0; ks < 4; ++ks) qs[ks] = scale_frag(qf[ks], xi);
#pragma unroll
        for (int ks = 0; ks < 4; ++ks)
#pragma unroll
            for (int d = 0; d < 8; ++d) {
                const bf16x8 sf = *(const bf16x8*)(Bd + (d * 16 + c) * 136 + ks * 32 + g * 8);
                o[d] = mfma16(sf, qs[ks], o[d]);
            }
    }
    if (dostore) {
        float sum = 0.f;
#pragma unroll
        for (int d = 0; d < 8; ++d) sum += (o[d][0] + o[d][1]) + (o[d][2] + o[d][3]);
        sum += __shfl_xor(sum, 16); sum += __shfl_xor(sum, 32);
        const float mu = sum * (1.f / 128.f);
        float var = 0.f;
#pragma unroll
        for (int d = 0; d < 8; ++d)
#pragma unroll
            for (int r = 0; r < 4; ++r) { const float dd = o[d][r] - mu; var += dd * dd; }
        var += __shfl_xor(var, 16); var += __shfl_xor(var, 32);
        const float rstd = rsqrtf(var * (1.f / 128.f) + EPSN);
        bf16_t* rowp = p.P + (size_t)(rowbase + ti) * PC;
#pragma unroll
        for (int d = 0; d < 8; ++d) {
            const int dv = d * 16 + g * 4;
            const f32x4 gn = *(const f32x4*)(p.ret_gn_w + l * 512 + h * 128 + dv);
            const u32x2 gt = *(const u32x2*)(rowp + C_RG + h * 128 + dv);
            const float v0 = (o[d][0] - mu) * rstd * gn[0] * silu_f(lo16(gt[0])), v1 = (o[d][1] - mu) * rstd * gn[1] * silu_f(hi16(gt[0]));
            const float v2 = (o[d][2] - mu) * rstd * gn[2] * silu_f(lo16(gt[1])), v3 = (o[d][3] - mu) * rstd * gn[3] * silu_f(hi16(gt[1]));
            u32x2 o2; o2.x = pk2(v0, v1); o2.y = pk2(v2, v3);
            *(u32x2*)(rowp + C_RQ + h * 128 + dv) = o2;
        }
    }
}

__device__ void phase_d(const Params& p, int l, unsigned char* lds) {
    const bool need_ctx = l < 3;
    const int G = gridDim.x, bid = blockIdx.x;
    const bool small_first = bid >= (G >> 1);
    float mfix;
    {
        const int ln = tid_opaque() & 63;
        float wq = fabsf(p.q_norm_w[l * 64 + ln]), wk = fabsf(p.k_norm_w[l * 64 + ln]);
#pragma unroll
        for (int o = 32; o >= 1; o >>= 1) { wq = fmaxf(wq, __shfl_xor(wq, o)); wk = fmaxf(wk, __shfl_xor(wk, o)); }
        mfix = 64.f * wq * wk * (0.125f * LOG2E);
    }
    const bool usefix = mfix < 40.f;
    {
        phase_c(p, l);
        asm volatile("s_waitcnt vmcnt(0) lgkmcnt(0)" ::: "memory");
        __syncthreads();
        if (threadIdx.x == 0) {
            unsigned mine = 0;
            for (int it = bid; it < 256; it += G) ++mine;
            if (mine) { __builtin_amdgcn_fence(__ATOMIC_RELEASE, "agent"); __hip_atomic_fetch_add(p.bar + 768, mine, __ATOMIC_RELAXED, __HIP_MEMORY_SCOPE_AGENT); }
        }
    }
#pragma unroll 1
    for (int stage = 0; stage < 3; ++stage) {
        const int kind = small_first ? (stage + 1) % 3 : stage;
        if (kind == 0) {
#pragma unroll 1
            for (int it = bid; it < 1024; it += G) {
                if (usefix) attn_item32<0, true>(p, l, it >> 8, (it >> 7) & 1, it & 127, lds, mfix);
                else attn_item32<0, false>(p, l, it >> 8, (it >> 7) & 1, it & 127, lds, 0.f);
            }
        } else if (kind == 1) {
#pragma unroll 1
            for (int it = bid; it < 2048; it += G) {
                attn_item<2>(p, l, it >> 9, (it >> 6) & 7, (it >> 2) & 15, it & 3, lds);
            }
        } else {
            const int nch = need_ctx ? 66 : 64, n_ret = nch * 32;
            if (threadIdx.x == 0) {
                while (__hip_atomic_load(p.bar + 768, __ATOMIC_RELAXED, __HIP_MEMORY_SCOPE_AGENT) < 256u * (unsigned)(l + 1)) __builtin_amdgcn_s_sleep(2);
                __builtin_amdgcn_fence(__ATOMIC_ACQUIRE, "agent");
            }
            __syncthreads();
#pragma unroll 1
            for (int it = G - 1 - bid; it < n_ret; it += G) {
                const int hf = it & 1, it2 = it >> 1;
                const int cidx = it2 % nch, bh = it2 / nch;
                ret_item(p, l, bh >> 2, bh & 3, cidx, hf, lds);
            }
        }
        __syncthreads();
    }
    if (need_ctx) {
#pragma unroll 1
        for (int it = G - 1 - bid; it < 32; it += G) attn_item32<1, false>(p, l, it >> 3, (it >> 2) & 1, it & 3, lds, 0.f);
        __syncthreads();
#pragma unroll 1
        for (int it = G - 1 - bid - 32; it < 32; it += G) { if (it >= 0) attn_item32<3, false>(p, l, it >> 3, it & 7, 0, lds, 0.f); }
    }
}

__device__ __forceinline__ int xcd_tile(int it0) {
    if (gridDim.x != 512 || it0 >= 2048) return it0;
    const int xcd = it0 & 7, j = (it0 >> 3) & 63, r = it0 >> 9;
    const int li = j + 64 * r;
    return ((xcd * 32 + (li >> 3)) << 3) | (li & 7);
}

__device__ void phase_e1(const Params& p, int l, unsigned char* lds) {
    const int t = tid_opaque(), lane = t & 63, w = t >> 6, wm = w >> 1, wn = w & 1;
    const int nmt = l < 3 ? 264 : 256;
    const int total = nmt * 8;
    for (int it0 = blockIdx.x; it0 < total; it0 += gridDim.x) {
        const int item = xcd_tile(it0);
        const int mt = item >> 3, nt = item & 7;
        u32x2 macc[4][4];
#pragma unroll
        for (int a = 0; a < 4; ++a)
#pragma unroll
            for (int b = 0; b < 4; ++b) macc[a][b] = (u32x2){0u, 0u};
#pragma unroll 1
        for (int br = 0; br < 3; ++br) {
            u32x2 sg[4][4];
            {
                f32x4 gacc[4][4];
#pragma unroll
                for (int a = 0; a < 4; ++a)
#pragma unroll
                    for (int b = 0; b < 4; ++b) gacc[a][b] = (f32x4){0.f, 0.f, 0.f, 0.f};
                gemm_core<4>(gacc, p.HX + (size_t)mt * 128 * DM, DM, p.Wt + WT_IN + (size_t)(PC + br * 1024 + nt * 128) * DM, DM, DM, lds);
#pragma unroll
                for (int a = 0; a < 4; ++a)
#pragma unroll
                    for (int b = 0; b < 4; ++b) { sg[a][b].x = pk2(sigm_f(gacc[a][b][0]), sigm_f(gacc[a][b][1])); sg[a][b].y = pk2(sigm_f(gacc[a][b][2]), sigm_f(gacc[a][b][3])); }
            }
            f32x4 pacc[4][4];
#pragma unroll
            for (int a = 0; a < 4; ++a)
#pragma unroll
                for (int b = 0; b < 4; ++b) pacc[a][b] = (f32x4){0.f, 0.f, 0.f, 0.f};
            const int xcol = br == 0 ? C_RQ : (br == 1 ? C_NQ : C_GQ);
            const int woff = br == 0 ? WT_RET : (br == 1 ? WT_NA : WT_GQA);
            gemm_core<4>(pacc, p.P + (size_t)mt * 128 * PC + xcol, PC, p.Wt + woff + (size_t)nt * 128 * 512, 512, 512, lds);
#pragma unroll
            for (int a = 0; a < 4; ++a)
#pragma unroll
                for (int b = 0; b < 4; ++b) {
                    const float m0 = lo16(macc[a][b].x) + lo16(sg[a][b].x) * pacc[a][b][0], m1 = hi16(macc[a][b].x) + hi16(sg[a][b].x) * pacc[a][b][1];
                    const float m2 = lo16(macc[a][b].y) + lo16(sg[a][b].y) * pacc[a][b][2], m3 = hi16(macc[a][b].y) + hi16(sg[a][b].y) * pacc[a][b][3];
                    macc[a][b].x = pk2(m0, m1); macc[a][b].y = pk2(m2, m3);
                }
        }
#pragma unroll
        for (int ni = 0; ni < 4; ++ni)
#pragma unroll
            for (int mi = 0; mi < 4; ++mi) {
                const int n = nt * 128 + wn * 64 + ni * 16 + (lane >> 4) * 4, m = mt * 128 + wm * 64 + mi * 16 + (lane & 15);
                *(u32x2*)(p.P + (size_t)m * PC + C_M + n) = macc[ni][mi];
            }
    }
}

__device__ void phase_e2(const Params& p, int l, unsigned char* lds, bool dostore = true) {
    const int t = tid_opaque(), lane = t & 63, w = t >> 6, wm = w >> 1, wn = w & 1;
    const int nmt = l < 3 ? 264 : 256;
    const int total = nmt * 8;
    const float* xsrc = l == 0 ? p.x : p.out;
    const float* ysrc = l == 0 ? p.ctx : p.y;
    for (int it0 = blockIdx.x; it0 < total; it0 += gridDim.x) {
        const int item = xcd_tile(it0);
        const int mt = item >> 3, nt = item & 7;
        f32x4 acc[4][4];
#pragma unroll
        for (int a = 0; a < 4; ++a)
#pragma unroll
            for (int b = 0; b < 4; ++b) acc[a][b] = (f32x4){0.f, 0.f, 0.f, 0.f};
        gemm_core<4>(acc, p.P + (size_t)mt * 128 * PC + C_M, PC, p.Wt + WT_OUT + (size_t)nt * 128 * DM, DM, DM, lds);
#pragma unroll
        for (int mi = 0; mi < 4; ++mi) {
            const int m = mt * 128 + wm * 64 + mi * 16 + (lane & 15);
            const bool lat = m < NTOK;
            const int bb = lat ? (m >> 13) : 4;
            const float* src = lat ? xsrc + (size_t)m * DM : ysrc + (size_t)(m - NTOK) * DM;
            float* dst = lat ? p.out + (size_t)m * DM : p.y + (size_t)(m - NTOK) * DM;
            const float* gate = p.mod + (size_t)(l * 5 + bb) * 3072 + 2048;
#pragma unroll
            for (int ni = 0; ni < 4; ++ni) {
                const int n = nt * 128 + wn * 64 + ni * 16 + (lane >> 4) * 4;
                const f32x4 xo = *(const f32x4*)(src + n), gv = *(const f32x4*)(gate + n);
                if (dostore) *(f32x4*)(dst + n) = xo + gv * acc[ni][mi];
            }
        }
    }
}

__device__ void phase_e3(const Params& p, int l, unsigned char* lds) {
    norm_rows(p, l + 1, p.out, p.y);
    if (l < 3)
        for (int item = blockIdx.x; item < NCONV_ITEMS; item += gridDim.x) convert_item(p, l + 1, item, lds);
}


__device__ __forceinline__ void run_phase(const Params& p, int ph, int l, unsigned char* lds) {
    switch (ph) {
        case 0: phase_p0(p, lds);
            break;
        case 1: norm_rows(p, 0, p.x, p.ctx); break;
        case 2: phase_a(p, l, lds);
            break;
        case 3: phase_b(p, l, lds); break;
        case 4:
            phase_c(p, l); break;
        case 5: phase_d(p, l, lds); break;
        case 6: phase_e1(p, l, lds);
            break;
        case 7:
            phase_e2(p, l, lds); break;
        default: phase_e3(p, l, lds);
            break;
    }
}

__device__ __forceinline__ void fast_grid_barrier(unsigned* bar, unsigned k) {
    asm volatile("s_waitcnt vmcnt(0) lgkmcnt(0)" ::: "memory");
    __syncthreads();
    if (threadIdx.x == 0) {
        const unsigned grp = blockIdx.x & 7u, members = (gridDim.x - grp + 7u) >> 3;
        __builtin_amdgcn_fence(__ATOMIC_RELEASE, "agent");
        const unsigned old = __hip_atomic_fetch_add(bar + grp * 32, 1u, __ATOMIC_RELAXED, __HIP_MEMORY_SCOPE_AGENT);
        if (old + 1u == k * members) {
            __hip_atomic_fetch_add(bar + 256, 1u, __ATOMIC_RELAXED, __HIP_MEMORY_SCOPE_AGENT);
            while (__hip_atomic_load(bar + 256, __ATOMIC_RELAXED, __HIP_MEMORY_SCOPE_AGENT) < k * 8u) __builtin_amdgcn_s_sleep(1);
            __hip_atomic_store(bar + 288 + grp * 32, k, __ATOMIC_RELAXED, __HIP_MEMORY_SCOPE_AGENT);
        } else {
            while (__hip_atomic_load(bar + 288 + grp * 32, __ATOMIC_RELAXED, __HIP_MEMORY_SCOPE_AGENT) < k) __builtin_amdgcn_s_sleep(1);
        }
        __builtin_amdgcn_fence(__ATOMIC_ACQUIRE, "agent");
    }
    __syncthreads();
}
#define GSYNC() do { asm volatile("s_waitcnt vmcnt(0) lgkmcnt(0)" ::: "memory"); grid.sync(); } while (0)
__global__ void __launch_bounds__(256, 2) mega_kernel(Params p) {
    __shared__ __attribute__((aligned(16))) unsigned char lds[LDS_BYTES];
    cg::grid_group grid = cg::this_grid();
    unsigned bk = 0;
    run_phase(p, 0, 0, lds);
    if (p.out == nullptr) GSYNC();
    fast_grid_barrier(p.bar, ++bk);
    run_phase(p, 1, 0, lds); fast_grid_barrier(p.bar, ++bk);
    for (int l = 0; l < 4; ++l) {
#pragma unroll 1
        for (int ph = 2; ph <= 8; ++ph) {
            if (ph == 4) continue;
            run_phase(p, ph, l, lds);
            if (!(l == 3 && ph == 8)) fast_grid_barrier(p.bar, ++bk);
        }
    }
}

extern "C" void kernel_launch(void* const* d_in, const int* in_sizes, int n_in, void* d_out, int out_size, void* d_ws, size_t ws_size, hipStream_t stream) {
    Params p{};
    p.x = (const float*)d_in[0]; p.c = (const float*)d_in[1]; p.ctx = (const float*)d_in[2]; p.c_ctx = (const float*)d_in[3];
    p.ada_w = (const float*)d_in[4]; p.ada_b = (const float*)d_in[5]; p.norm_w = (const float*)d_in[6]; p.w_in = (const float*)d_in[7];
    p.ret_log_decay = (const float*)d_in[8]; p.ret_gn_w = (const float*)d_in[9]; p.na_rpb = (const float*)d_in[10];
    p.q_norm_w = (const float*)d_in[11]; p.k_norm_w = (const float*)d_in[12]; p.w_ret_o = (const float*)d_in[13];
    p.w_na_o = (const float*)d_in[14]; p.w_gqa_o = (const float*)d_in[15]; p.w_out = (const float*)d_in[16]; p.final_norm_w = (const float*)d_in[17];
    p.out = (float*)d_out;
    unsigned char* ws = (unsigned char*)d_ws;
    size_t off = 0;
    p.P = (bf16_t*)(ws + off); off += (size_t)NROWS * PC * 2;
    p.HX = (bf16_t*)(ws + off); off += (size_t)NROWS * DM * 2;
    p.Wt = (bf16_t*)(ws + off); off += (size_t)WT_TOTAL * 2;
    p.SU = (bf16_t*)(ws + off); off += (size_t)2 * 4 * 4 * 66 * 16384 * 2;
    p.y = (float*)(ws + off); off += (size_t)1024 * 1024 * 4;
    p.mod = (float*)(ws + off); off += (size_t)4 * 5 * 3072 * 4;
    p.rope = (float*)(ws + off); off += (size_t)128 * 16 * 2 * 4 + 256;
    p.bar = (unsigned*)(ws + off); off += 4096;
    off += (size_t)4 * 2 * 64 * 8448 * 2;
    if (off > ws_size) { fprintf(stderr, "workspace too small: need %zu have %zu\n", off, ws_size); return; }
    static int grid_blocks = 0;
    if (!grid_blocks) {
        int dev = 0, cus = 0, per_cu = 0;
        hipGetDevice(&dev);
        hipDeviceGetAttribute(&cus, hipDeviceAttributeMultiprocessorCount, dev);
        hipOccupancyMaxActiveBlocksPerMultiprocessor(&per_cu, mega_kernel, 256, 0);
        if (per_cu > 2) per_cu = 2;
        grid_blocks = cus * per_cu;
    }
    hipMemsetAsync(p.bar, 0, 4096, stream);
    void* args[] = {&p};
    hipError_t e = hipLaunchCooperativeKernel((void*)mega_kernel, dim3(grid_blocks), dim3(256), args, 0, stream);
    if (e != hipSuccess) fprintf(stderr, "cooperative launch failed: %s (grid %d)\n", hipGetErrorString(e), grid_blocks);
}
```

```cpp
#include <hip/hip_runtime.h>
#include <hip/hip_cooperative_groups.h>
#include <cstdio>
#include <cstdint>
namespace cg = cooperative_groups;


typedef unsigned short bf16_t;
typedef short bf16x8 __attribute__((ext_vector_type(8)));
typedef float f32x4 __attribute__((ext_vector_type(4)));
typedef unsigned u32x4 __attribute__((ext_vector_type(4)));
typedef unsigned u32x2 __attribute__((ext_vector_type(2)));

#define DM 1024
#define NTOK 32768
#define NROWS 33792
#define PC 5376
#define INC 8448
#define LOG2E 1.4426950408889634f
#define EPSN 1e-6f
#define LDS_BYTES 73728

#define C_RQ 0
#define C_RK 512
#define C_RV 1024
#define C_RG 1536
#define C_NQ 2048
#define C_NK 2560
#define C_NV 3072
#define C_NG 3584
#define C_GQ 4096
#define C_GK 4608
#define C_GV 4736
#define C_GG 4864
#define C_M  512

#define WT_IN 0
#define WT_RET (8448 * 1024)
#define WT_NA (WT_RET + 1024 * 512)
#define WT_GQA (WT_NA + 1024 * 512)
#define WT_OUT (WT_GQA + 1024 * 512)
#define WT_TOTAL (WT_OUT + 1024 * 1024)

#define VG(p) ((bf16_t*)((unsigned char*)(p).bar + 4096))
struct Params {
    const float *x, *c, *ctx, *c_ctx, *ada_w, *ada_b, *norm_w, *w_in, *ret_log_decay, *ret_gn_w, *na_rpb, *q_norm_w, *k_norm_w,
        *w_ret_o, *w_na_o, *w_gqa_o, *w_out, *final_norm_w;
    float* out;
    bf16_t* P;
    bf16_t* HX;
    bf16_t* Wt;
    bf16_t* SU;
    float* y;
    float* mod;
    float* rope;
    unsigned* bar;
};

__device__ __forceinline__ int tid_opaque() { int t = threadIdx.x; asm volatile("" : "+v"(t)); return t; }
__device__ __forceinline__ float bf2f(bf16_t v) { return __uint_as_float(((unsigned)v) << 16); }
typedef __bf16 bf16x2_t __attribute__((ext_vector_type(2)));
typedef float f32x2_t __attribute__((ext_vector_type(2)));
__device__ __forceinline__ unsigned pk2(float lo, float hi) {
    f32x2_t v = {lo, hi};
    union { bf16x2_t b; unsigned u; } x; x.b = __builtin_convertvector(v, bf16x2_t); return x.u;
}
__device__ __forceinline__ bf16_t f2bf(float f) { return (bf16_t)(pk2(f, 0.f) & 0xffffu); }
__device__ __forceinline__ float lo16(unsigned u) { return __uint_as_float(u << 16); }
__device__ __forceinline__ float hi16(unsigned u) { return __uint_as_float(u & 0xffff0000u); }
__device__ __forceinline__ float ex2(float x) { return __builtin_amdgcn_exp2f(x); }
__device__ __forceinline__ float silu_f(float x) { return x * __builtin_amdgcn_rcpf(1.f + ex2(-x * LOG2E)); }
__device__ __forceinline__ float sigm_f(float x) { return __builtin_amdgcn_rcpf(1.f + ex2(-x * LOG2E)); }
__device__ __forceinline__ f32x4 mfma16(bf16x8 a, bf16x8 b, f32x4 c) { return __builtin_amdgcn_mfma_f32_16x16x32_bf16(a, b, c, 0, 0, 0); }
__device__ __forceinline__ bf16x8 as_bf(u32x4 u) { union { u32x4 a; bf16x8 b; } x; x.a = u; return x.b; }
__device__ __forceinline__ u32x4 as_u(bf16x8 u) { union { u32x4 a; bf16x8 b; } x; x.b = u; return x.a; }
__device__ __forceinline__ u32x4 ldg16(const bf16_t* p) { return *(const u32x4*)p; }

template <int NI>
__device__ __forceinline__ void gemm_core(f32x4 (&acc)[NI][4], const bf16_t* __restrict__ X, int ldx, const bf16_t* __restrict__ W, int ldw, int K, unsigned char* lds) {
    const int t = tid_opaque(), lane = t & 63, w = t >> 6, wm = w >> 1, wn = w & 1;
    bf16_t* Xs = (bf16_t*)lds;
    bf16_t* Ws = Xs + 2 * 128 * 72;
    const int sr = t >> 3, sc = (t & 7) * 8;
    const bf16_t* xg = X + (size_t)sr * ldx + sc;
    const bf16_t* wg = W + (size_t)sr * ldw + sc;
    u32x4 xr[4], wr[NI];
#pragma unroll
    for (int i = 0; i < 4; ++i) xr[i] = ldg16(xg + (size_t)i * 32 * ldx);
#pragma unroll
    for (int i = 0; i < NI; ++i) wr[i] = ldg16(wg + (size_t)i * 32 * ldw);
    __syncthreads();
#pragma unroll
    for (int i = 0; i < 4; ++i) *(u32x4*)(Xs + (sr + i * 32) * 72 + sc) = xr[i];
#pragma unroll
    for (int i = 0; i < NI; ++i) *(u32x4*)(Ws + (sr + i * 32) * 72 + sc) = wr[i];
    __syncthreads();
    const int nk = K >> 6;
    for (int kt = 0; kt < nk; ++kt) {
        const int cur = kt & 1;
        if (kt + 1 < nk) {
            const int ko = (kt + 1) * 64;
#pragma unroll
            for (int i = 0; i < 4; ++i) xr[i] = ldg16(xg + (size_t)i * 32 * ldx + ko);
#pragma unroll
            for (int i = 0; i < NI; ++i) wr[i] = ldg16(wg + (size_t)i * 32 * ldw + ko);
        }
        __builtin_amdgcn_sched_barrier(0);
        const bf16_t* xs = Xs + cur * 128 * 72 + (wm * 64 + (lane & 15)) * 72 + (lane >> 4) * 8;
        const bf16_t* ws = Ws + cur * 128 * 72 + (wn * (NI * 16) + (lane & 15)) * 72 + (lane >> 4) * 8;
#pragma unroll
        for (int ks = 0; ks < 2; ++ks) {
            bf16x8 xf[4], wf[NI];
#pragma unroll
            for (int i = 0; i < 4; ++i) xf[i] = *(const bf16x8*)(xs + i * 16 * 72 + ks * 32);
#pragma unroll
            for (int i = 0; i < NI; ++i) wf[i] = *(const bf16x8*)(ws + i * 16 * 72 + ks * 32);
#pragma unroll
            for (int ni = 0; ni < NI; ++ni)
#pragma unroll
                for (int mi = 0; mi < 4; ++mi) acc[ni][mi] = mfma16(wf[ni], xf[mi], acc[ni][mi]);
        }
        if (kt + 1 < nk) {
            const int nx = cur ^ 1;
#pragma unroll
            for (int i = 0; i < 4; ++i) *(u32x4*)(Xs + nx * 128 * 72 + (sr + i * 32) * 72 + sc) = xr[i];
#pragma unroll
            for (int i = 0; i < NI; ++i) *(u32x4*)(Ws + nx * 128 * 72 + (sr + i * 32) * 72 + sc) = wr[i];
        }
        __syncthreads();
    }
}

__device__ __forceinline__ void gemm_big(f32x4 (&acc)[4][8], const bf16_t* __restrict__ X, int ldx, const bf16_t* __restrict__ W, int ldw, int K, unsigned char* lds) {
    const int t = tid_opaque(), lane = t & 63, w = t >> 6, wm = w >> 1, wn = w & 1;
    bf16_t* Xs = (bf16_t*)lds;
    bf16_t* Ws = Xs + 2 * 256 * 40;
    const int sr = t >> 2, sc = (t & 3) * 8;
    const bf16_t* xg = X + (size_t)sr * ldx + sc;
    const bf16_t* wg = W + (size_t)sr * ldw + sc;
    u32x4 ra[6], rb[6];
#define GB_LOAD(r, ko) do { _Pragma("unroll") for (int i = 0; i < 4; ++i) r[i] = ldg16(xg + (size_t)i * 64 * ldx + (ko)); _Pragma("unroll") for (int i = 0; i < 2; ++i) r[4 + i] = ldg16(wg + (size_t)i * 64 * ldw + (ko)); } while (0)
#define GB_ST1(r, st, i) do { if ((i) < 4) *(u32x4*)(Xs + (st) * 256 * 40 + (sr + (i) * 64) * 40 + sc) = r[i]; else *(u32x4*)(Ws + (st) * 128 * 40 + (sr + ((i) - 4) * 64) * 40 + sc) = r[i]; } while (0)
#define GB_STEP(st, r, dostore) do { \
        const bf16_t* xs = Xs + (st) * 256 * 40 + (wm * 128 + (lane & 15)) * 40 + (lane >> 4) * 8; \
        const bf16_t* ws = Ws + (st) * 128 * 40 + (wn * 64 + (lane & 15)) * 40 + (lane >> 4) * 8; \
        bf16x8 wf[4]; \
        _Pragma("unroll") for (int i = 0; i < 4; ++i) wf[i] = *(const bf16x8*)(ws + i * 16 * 40); \
        _Pragma("unroll") for (int mi = 0; mi < 8; ++mi) { \
            const bf16x8 xf = *(const bf16x8*)(xs + mi * 16 * 40); \
            _Pragma("unroll") for (int ni = 0; ni < 4; ++ni) acc[ni][mi] = mfma16(wf[ni], xf, acc[ni][mi]); \
            if ((dostore) && mi >= 1 && mi <= 6) GB_ST1(r, (st) ^ 1, mi - 1); } } while (0)
    GB_LOAD(ra, 0);
    GB_LOAD(rb, 32);
    __syncthreads();
#pragma unroll
    for (int i = 0; i < 6; ++i) GB_ST1(ra, 0, i);
    __syncthreads();
    const int nk = K >> 5;
    for (int kt = 0; kt < nk; kt += 2) {
        if (kt + 2 < nk) GB_LOAD(ra, (kt + 2) * 32);
        GB_STEP(0, rb, true);
        __syncthreads();
        if (kt + 3 < nk) GB_LOAD(rb, (kt + 3) * 32);
        GB_STEP(1, ra, kt + 2 < nk);
        __syncthreads();
    }
#undef GB_LOAD
#undef GB_ST1
#undef GB_STEP
}

__device__ void adaln_item(const Params& p, int item, unsigned char* lds) {
    const int t = tid_opaque(), lane = t & 63, w = t >> 6;
    const int l = item / 48, cgp = item % 48, j = cgp * 64 + lane;
    float* cs = (float*)lds;
    float* red = (float*)(lds + 20480);
    __syncthreads();
    for (int idx = t; idx < 5120; idx += 256) {
        const int bb = idx >> 10, k = idx & 1023;
        const float v = bb < 4 ? p.c[bb * 1024 + k] : p.c_ctx[k];
        cs[idx] = silu_f(v);
    }
    __syncthreads();
    float a0 = 0.f, a1 = 0.f, a2 = 0.f, a3 = 0.f, a4 = 0.f;
    const float* aw = p.ada_w + ((size_t)l * 1024 + w * 256) * 3072 + j;
#pragma unroll 32
    for (int k = 0; k < 256; ++k) {
        const float wv = aw[(size_t)k * 3072];
        const int kk = w * 256 + k;
        a0 += cs[kk] * wv; a1 += cs[1024 + kk] * wv; a2 += cs[2048 + kk] * wv; a3 += cs[3072 + kk] * wv; a4 += cs[4096 + kk] * wv;
    }
    red[(w * 5 + 0) * 64 + lane] = a0; red[(w * 5 + 1) * 64 + lane] = a1; red[(w * 5 + 2) * 64 + lane] = a2;
    red[(w * 5 + 3) * 64 + lane] = a3; red[(w * 5 + 4) * 64 + lane] = a4;
    __syncthreads();
    for (int idx = t; idx < 320; idx += 256) {
        const int bb = idx >> 6, ln = idx & 63;
        float v = p.ada_b[l * 3072 + cgp * 64 + ln];
#pragma unroll
        for (int ww = 0; ww < 4; ++ww) v += red[(ww * 5 + bb) * 64 + ln];
        p.mod[(l * 5 + bb) * 3072 + cgp * 64 + ln] = v;
    }
}

__device__ void transpose_tile(const float* __restrict__ src, int N, bf16_t* __restrict__ dst, int K, int k0, int n0, unsigned char* lds) {
    const int t = tid_opaque();
    bf16_t* T = (bf16_t*)lds;
    __syncthreads();
#pragma unroll
    for (int i = 0; i < 4; ++i) {
        const int k = (t >> 4) + 16 * i, n4 = (t & 15) * 4;
        const f32x4 v = *(const f32x4*)(src + (size_t)(k0 + k) * N + n0 + n4);
        T[(n4 + 0) * 72 + k] = f2bf(v[0]); T[(n4 + 1) * 72 + k] = f2bf(v[1]); T[(n4 + 2) * 72 + k] = f2bf(v[2]); T[(n4 + 3) * 72 + k] = f2bf(v[3]);
    }
    __syncthreads();
#pragma unroll
    for (int i = 0; i < 2; ++i) {
        const int cidx = t + 256 * i, n = cidx >> 3, kc = cidx & 7;
        *(u32x4*)(dst + (size_t)(n0 + n) * K + k0 + kc * 8) = *(const u32x4*)(T + n * 72 + kc * 8);
    }
}

#define NCONV_ITEMS (2112 + 3 * 128 + 256)
__device__ void convert_item(const Params& p, int l, int item, unsigned char* lds) {
    if (item < 2112) {
        const int kt = item / 132, nt = item % 132;
        transpose_tile(p.w_in + (size_t)l * 1024 * INC, INC, p.Wt + WT_IN, 1024, kt * 64, nt * 64, lds);
    } else if (item < 2112 + 384) {
        const int it = item - 2112, which = it / 128, r = it % 128, kt = r / 16, nt = r % 16;
        const float* src = (which == 0 ? p.w_ret_o : which == 1 ? p.w_na_o : p.w_gqa_o) + (size_t)l * 512 * 1024;
        bf16_t* dst = p.Wt + (which == 0 ? WT_RET : which == 1 ? WT_NA : WT_GQA);
        transpose_tile(src, 1024, dst, 512, kt * 64, nt * 64, lds);
    } else {
        const int it = item - 2112 - 384, kt = it / 16, nt = it % 16;
        transpose_tile(p.w_out + (size_t)l * 1024 * 1024, 1024, p.Wt + WT_OUT, 1024, kt * 64, nt * 64, lds);
    }
}

__device__ void rope_table(const Params& p) {
    for (int idx = tid_opaque(); idx < 2048; idx += 256) {
        const int pos = idx >> 4, i = idx & 15;
        const float f = ex2(-(float)i * (13.287712379549449f / 16.f));
        const float ang = (float)pos * f;
        float rev = ang * 0.15915494309189535f;
        rev = rev - rintf(rev);
        p.rope[idx * 2 + 0] = __builtin_amdgcn_cosf(rev);
        p.rope[idx * 2 + 1] = __builtin_amdgcn_sinf(rev);
    }
}

__device__ void phase_p0(const Params& p, unsigned char* lds) {
    const int total = 192 + NCONV_ITEMS + 1;
    for (int item = blockIdx.x; item < total; item += gridDim.x) {
        if (item < 192) adaln_item(p, item, lds);
        else if (item < 192 + NCONV_ITEMS) convert_item(p, 0, item - 192, lds);
        else rope_table(p);
    }
}

__device__ void norm_rows(const Params& p, int lnext, const float* xsrc, const float* ysrc) {
    const int t = tid_opaque(), lane = t & 63, w = t >> 6;
    const int nrows = lnext < 4 ? NROWS : NTOK;
    for (int row = blockIdx.x * 4 + w; row < nrows; row += gridDim.x * 4) {
        const float* src = row < NTOK ? xsrc + (size_t)row * DM : ysrc + (size_t)(row - NTOK) * DM;
        f32x4 v[4];
        float ss = 0.f;
#pragma unroll
        for (int i = 0; i < 4; ++i) { v[i] = *(const f32x4*)(src + i * 256 + lane * 4); ss += v[i][0] * v[i][0] + v[i][1] * v[i][1] + v[i][2] * v[i][2] + v[i][3] * v[i][3]; }
#pragma unroll
        for (int o = 32; o >= 1; o >>= 1) ss += __shfl_xor(ss, o);
        const float rstd = rsqrtf(ss * (1.f / 1024.f) + EPSN);
        if (lnext < 4) {
            const int bb = row < NTOK ? (row >> 13) : 4;
            const float* md = p.mod + (size_t)(lnext * 5 + bb) * 3072;
            const float* nw = p.norm_w + lnext * 1024;
#pragma unroll
            for (int i = 0; i < 4; ++i) {
                const int col = i * 256 + lane * 4;
                const f32x4 nwv = *(const f32x4*)(nw + col), sh = *(const f32x4*)(md + col), scl = *(const f32x4*)(md + 1024 + col);
                f32x4 h = v[i] * rstd * nwv * (scl + 1.f) + sh;
                u32x2 o2; o2.x = pk2(h[0], h[1]); o2.y = pk2(h[2], h[3]);
                *(u32x2*)(p.HX + (size_t)row * DM + col) = o2;
            }
        } else {
#pragma unroll
            for (int i = 0; i < 4; ++i) {
                const int col = i * 256 + lane * 4;
                const f32x4 nwv = *(const f32x4*)(p.final_norm_w + col);
                f32x4 ov = v[i] * rstd * nwv;
                *(f32x4*)(p.out + (size_t)row * DM + col) = ov;
            }
        }
    }
}

__device__ void phase_a(const Params& p, int l, unsigned char* lds) {
    const int t = tid_opaque(), lane = t & 63, w = t >> 6, wm = w >> 1, wn = w & 1;
    const int total = 132 * 42;
    const bool xmap = (gridDim.x & 7) == 0;
    const int per = xmap ? (total + 7) / 8 : total;
    const int lo = xmap ? (int)(blockIdx.x & 7) * per : 0, hi = min(lo + per, total);
    const int step = xmap ? (int)(gridDim.x >> 3) : (int)gridDim.x;
    for (int idx = lo + (xmap ? (int)(blockIdx.x >> 3) : (int)blockIdx.x); idx < hi; idx += step) {
        const int nb = idx / 924, rem = idx - nb * 924;
        const int mt = rem / 7, nt = nb * 7 + (rem - mt * 7);
        f32x4 acc[4][8];
#pragma unroll
        for (int a = 0; a < 4; ++a)
#pragma unroll
            for (int b = 0; b < 8; ++b) acc[a][b] = (f32x4){0.f, 0.f, 0.f, 0.f};
        gemm_big(acc, p.HX + (size_t)mt * 256 * DM, DM, p.Wt + WT_IN + (size_t)nt * 128 * DM, DM, DM, lds);
#pragma unroll
        for (int ni = 0; ni < 4; ++ni)
#pragma unroll
            for (int mi = 0; mi < 8; ++mi) {
                const int n = nt * 128 + wn * 64 + ni * 16 + (lane >> 4) * 4, m = mt * 256 + wm * 128 + mi * 16 + (lane & 15);
                u32x2 o2; o2.x = pk2(acc[ni][mi][0], acc[ni][mi][1]); o2.y = pk2(acc[ni][mi][2], acc[ni][mi][3]);
                *(u32x2*)(p.P + (size_t)m * PC + n) = o2;
            }
    }
}

__device__ __forceinline__ int chunk_row(int b, int cidx) { return cidx < 64 ? b * 8192 + cidx * 128 : NTOK + b * 256 + (cidx - 64) * 128; }

__device__ void ret_state_item(const Params& p, int l, int b, int h, int cidx, unsigned char* lds) {
    const int t = tid_opaque(), lane = t & 63, w = t >> 6, g = lane >> 4, c = lane & 15;
    bf16_t* Ktf = (bf16_t*)lds;
    bf16_t* Vt = Ktf + 128 * 72;
    const float lgf = -__expf(p.ret_log_decay[l * 8 + h]) * LOG2E, lgb = -__expf(p.ret_log_decay[l * 8 + 4 + h]) * LOG2E;
    const float ksc = 0.08838834764831845f;
    const int rowbase = chunk_row(b, cidx);
    for (int dir = 0; dir < 2; ++dir) {
        f32x4 acc[2][8];
#pragma unroll
        for (int i = 0; i < 2; ++i)
#pragma unroll
            for (int d = 0; d < 8; ++d) acc[i][d] = (f32x4){0.f, 0.f, 0.f, 0.f};
        const float lg = dir ? lgb : lgf;
#pragma unroll 1
        for (int half = 0; half < 2; ++half) {
            __syncthreads();
#pragma unroll
            for (int i = 0; i < 4; ++i) {
                const int cc = t + 256 * i, tok = cc & 63, dch = cc >> 6, j = half * 64 + tok;
                const float wgt = ex2(lg * (float)(dir ? j : 127 - j)) * ksc;
                const bf16_t* rp = p.P + (size_t)(rowbase + j) * PC + h * 128 + dch * 8;
                const u32x4 kv = ldg16(rp + C_RK), vv = ldg16(rp + C_RV);
#pragma unroll
                for (int e = 0; e < 4; ++e) {
                    const int r0 = (dch * 8 + 2 * e) * 72 + tok, r1 = r0 + 72;
                    Ktf[r0] = f2bf(lo16(kv[e]) * wgt); Ktf[r1] = f2bf(hi16(kv[e]) * wgt);
                    Vt[r0] = (bf16_t)(vv[e] & 0xffffu); Vt[r1] = (bf16_t)(vv[e] >> 16);
                }
            }
            __syncthreads();
#pragma unroll
            for (int ks = 0; ks < 2; ++ks) {
                bf16x8 kf[2];
#pragma unroll
                for (int i = 0; i < 2; ++i) kf[i] = *(const bf16x8*)(Ktf + (w * 32 + i * 16 + c) * 72 + ks * 32 + g * 8);
#pragma unroll
                for (int d = 0; d < 8; ++d) {
                    const bf16x8 vf = *(const bf16x8*)(Vt + (d * 16 + c) * 72 + ks * 32 + g * 8);
#pragma unroll
                    for (int i = 0; i < 2; ++i) acc[i][d] = mfma16(kf[i], vf, acc[i][d]);
                }
            }
        }
        bf16_t* Sd = p.SU + ((size_t)((dir * 4 + b) * 4 + h) * 66 + cidx) * 16384;
#pragma unroll
        for (int i = 0; i < 2; ++i)
#pragma unroll
            for (int d = 0; d < 8; ++d) {
                const int dk = w * 32 + i * 16 + g * 4, dv = d * 16 + c;
                u32x2 o2; o2.x = pk2(acc[i][d][0], acc[i][d][1]); o2.y = pk2(acc[i][d][2], acc[i][d][3]);
                *(u32x2*)(Sd + dv * 128 + dk) = o2;
            }
    }
}

__device__ void qk_prep_item(const Params& p, int l, int item) {
    const int t = tid_opaque(), tok = t >> 2, sub = t & 3;
    const int row = item * 64 + tok;
    const bool lat = row < NTOK;
    const int tseq = row & 8191, pr = tseq >> 6, pc = tseq & 63;
    for (int hv = sub; hv < 10; hv += 4) {
        bf16_t* ptr = p.P + (size_t)row * PC + (hv < 8 ? C_GQ + hv * 64 : C_GK + (hv - 8) * 64);
        const float* nw = hv < 8 ? p.q_norm_w + l * 64 : p.k_norm_w + l * 64;
        float x[64];
        float ss = 0.f;
#pragma unroll
        for (int i = 0; i < 8; ++i) {
            const u32x4 u = ldg16(ptr + i * 8);
#pragma unroll
            for (int e = 0; e < 4; ++e) { x[i * 8 + 2 * e] = lo16(u[e]); x[i * 8 + 2 * e + 1] = hi16(u[e]); }
        }
#pragma unroll
        for (int d = 0; d < 64; ++d) ss += x[d] * x[d];
        const float rstd = rsqrtf(ss * (1.f / 64.f) + EPSN);
        const float qs = hv < 8 ? 0.125f * LOG2E : 1.f;
#pragma unroll
        for (int d = 0; d < 64; ++d) x[d] = x[d] * (rstd * qs) * nw[d];
        if (lat) {
#pragma unroll
            for (int i = 0; i < 16; ++i) {
                const float cr = p.rope[(pr * 16 + i) * 2], sr = p.rope[(pr * 16 + i) * 2 + 1];
                const float cc = p.rope[(pc * 16 + i) * 2], sc = p.rope[(pc * 16 + i) * 2 + 1];
                const float a = x[i], b2 = x[16 + i], a2 = x[32 + i], b3 = x[48 + i];
                x[i] = a * cr - b2 * sr; x[16 + i] = b2 * cr + a * sr;
                x[32 + i] = a2 * cc - b3 * sc; x[48 + i] = b3 * cc + a2 * sc;
            }
        }
#pragma unroll
        for (int i = 0; i < 8; ++i) {
            u32x4 u;
#pragma unroll
            for (int e = 0; e < 4; ++e) u[e] = pk2(x[i * 8 + 2 * e], x[i * 8 + 2 * e + 1]);
            *(u32x4*)(ptr + i * 8) = u;
        }
    }
    {
        const int b = lat ? (row >> 13) : ((row - NTOK) >> 8);
        const int key = lat ? tseq : 8192 + ((row - NTOK) & 255);
        const bf16_t* vp = p.P + (size_t)row * PC + C_GV + sub * 32;
        bf16_t* dst = VG(p) + ((size_t)(b * 2 + (sub >> 1)) * 64 + (sub & 1) * 32) * 8448 + key;
#pragma unroll
        for (int i = 0; i < 4; ++i) {
            const u32x4 u = ldg16(vp + i * 8);
#pragma unroll
            for (int e = 0; e < 4; ++e) {
                dst[(size_t)(i * 8 + 2 * e) * 8448] = (bf16_t)(u[e] & 0xffffu);
                dst[(size_t)(i * 8 + 2 * e + 1) * 8448] = (bf16_t)(u[e] >> 16);
            }
        }
    }
}

__device__ void phase_b(const Params& p, int l, unsigned char* lds) {
    const int total = 1056 + 528;
    for (int item = blockIdx.x; item < total; item += gridDim.x) {
        if (item < 1056) { const int cidx = item % 66, bh = item / 66; ret_state_item(p, l, bh >> 2, bh & 3, cidx, lds);
        }
        else qk_prep_item(p, l, item - 1056);
    }
}

__device__ void phase_c(const Params& p, int l, bool dostore = true) {
    const int t = tid_opaque();
    for (int item = blockIdx.x; item < 256; item += gridDim.x) {
        const int part = item & 7, dbh = item >> 3, dir = dbh >> 4, h = dbh & 3;
        const float lg = -__expf(p.ret_log_decay[l * 8 + dir * 4 + h]) * LOG2E;
        const float gc = ex2(lg * 128.f);
        bf16_t* base = p.SU + (size_t)dbh * 66 * 16384 + part * 2048 + t * 8;
        float s[8];
#pragma unroll
        for (int e = 0; e < 8; ++e) s[e] = 0.f;
        for (int st0 = 0; st0 < 66; st0 += 11) {
            u32x4 u[11];
#pragma unroll
            for (int q = 0; q < 11; ++q) {
                const int st = st0 + q;
                const int n = dir == 0 ? (st < 2 ? 64 + st : st - 2) : (st < 2 ? 65 - st : 65 - st);
                u[q] = *(const u32x4*)(base + (size_t)n * 16384);
            }
#pragma unroll
            for (int q = 0; q < 11; ++q) {
                const int st = st0 + q;
                const int n = dir == 0 ? (st < 2 ? 64 + st : st - 2) : (st < 2 ? 65 - st : 65 - st);
                u32x4 o;
#pragma unroll
                for (int e = 0; e < 4; ++e) o[e] = pk2(s[2 * e], s[2 * e + 1]);
                if (dostore) *(u32x4*)(base + (size_t)n * 16384) = o;
#pragma unroll
                for (int e = 0; e < 4; ++e) { s[2 * e] = gc * s[2 * e] + lo16(u[q][e]); s[2 * e + 1] = gc * s[2 * e + 1] + hi16(u[q][e]); }
            }
        }
    }
}

template <int MODE>
__device__ void attn_item(const Params& p, int l, int b, int i1, int i2, int i3, unsigned char* lds, bool dostore = true) {
    constexpr int NQB = (MODE == 2) ? 2 : 4, NHQ = NQB / 2;
    const int t = tid_opaque(), lane = t & 63, w = t >> 6, g = lane >> 4, c = lane & 15;
    bf16_t* Ks = (bf16_t*)lds;
    bf16_t* Vt = Ks + 2 * 64 * 72;
    u32x4* Qs = (u32x4*)(lds + 36864) + w * 512;
    float* rpbs = (float*)(lds + 36864 + 32768);
    int qbase, qstep, qcol, kcol, vcol, gcol, ntiles;
    int R0 = 0, c0 = 0, start = 0, bstart = 0, hh = 0;
    if (MODE == 0 || MODE == 1) {
        const int kvh = i1, qt = i2, head = kvh * 4 + w;
        qbase = (MODE == 0 ? b * 8192 : NTOK + b * 256) + qt * 64; qstep = 16;
        qcol = C_GQ + head * 64; kcol = C_GK + kvh * 64; vcol = C_GV + kvh * 64; gcol = C_GG + head * 64;
        ntiles = MODE == 0 ? 132 : 4;
    } else if (MODE == 2) {
        hh = i1; R0 = i2 * 8; c0 = i3 * 16;
        start = min(max(R0 - 4, 0), 112); bstart = min(max(c0 - 8, 0), 32);
        qbase = b * 8192 + (R0 + w * 2) * 64 + c0; qstep = 64;
        qcol = C_NQ + hh * 64; kcol = C_NK + hh * 64; vcol = C_NV + hh * 64; gcol = C_NG + hh * 64;
        ntiles = 12;
    } else {
        hh = i1;
        qbase = NTOK + b * 256 + w * 64; qstep = 16;
        qcol = C_NQ + hh * 64; kcol = C_NK + hh * 64; vcol = C_NV + hh * 64; gcol = C_NG + hh * 64;
        ntiles = 4;
    }
    const float scale = 0.125f * LOG2E;
    f32x4 o[NQB][4];
    float mrun[NQB], lsum[NQB];
#pragma unroll
    for (int qb = 0; qb < NQB; ++qb) {
        mrun[qb] = -INFINITY; lsum[qb] = 0.f;
#pragma unroll
        for (int d = 0; d < 4; ++d) o[qb][d] = (f32x4){0.f, 0.f, 0.f, 0.f};
    }
    const int kkey = t >> 3, kch = (t & 7) * 8;
    const int vkey = t & 63, vch = (t >> 6);
    u32x4 kr[2], vr[2];
    auto load_tile = [&](int tt) {
        int base, rstep;
        if (MODE == 0) { base = tt < 128 ? b * 8192 + tt * 64 : NTOK + b * 256 + (tt - 128) * 64; rstep = 32; }
        else if (MODE == 2) {
            if (tt < 4) { base = NTOK + b * 256 + tt * 64; rstep = 32; }
            else { base = b * 8192 + (start + 2 * (tt - 4)) * 64 + bstart; rstep = 64; }
        } else { base = NTOK + b * 256 + tt * 64; rstep = 32; }
#pragma unroll
        for (int i = 0; i < 2; ++i) {
            const int key = kkey + 32 * i;
            kr[i] = ldg16(p.P + (size_t)(base + (key >> 5) * rstep + (key & 31)) * PC + kcol + kch);
            if (MODE <= 1) vr[i] = ldg16(VG(p) + ((size_t)(b * 2 + i1) * 64 + kkey + 32 * i) * 8448 + (MODE == 0 ? tt * 64 : 8192 + tt * 64) + kch);
            else vr[i] = ldg16(p.P + (size_t)(base + (vkey >> 5) * rstep + (vkey & 31)) * PC + vcol + (vch + 4 * i) * 8);
        }
    };
    auto store_tile = [&](int buf) {
        bf16_t* ks_ = Ks + buf * 64 * 72; bf16_t* vt_ = Vt + buf * 64 * 72;
#pragma unroll
        for (int i = 0; i < 2; ++i) {
            *(u32x4*)(ks_ + (kkey + 32 * i) * 72 + kch) = kr[i];
            if (MODE <= 1) { *(u32x4*)(vt_ + (kkey + 32 * i) * 72 + kch) = vr[i]; continue; }
#pragma unroll
            for (int e = 0; e < 4; ++e) {
                const int d = (vch + 4 * i) * 8 + 2 * e;
                vt_[d * 72 + vkey] = (bf16_t)(vr[i][e] & 0xffffu);
                vt_[(d + 1) * 72 + vkey] = (bf16_t)(vr[i][e] >> 16);
            }
        }
    };
    load_tile(0);
    __syncthreads();
#pragma unroll
    for (int qb = 0; qb < NQB; ++qb)
#pragma unroll
        for (int ks = 0; ks < 2; ++ks) Qs[(qb * 2 + ks) * 64 + lane] = ldg16(p.P + (size_t)(qbase + qb * qstep + c) * PC + qcol + ks * 32 + g * 8);
    if (MODE == 2) for (int idx = t; idx < 465; idx += 256) rpbs[idx] = p.na_rpb[((size_t)l * 8 + hh) * 465 + idx] * LOG2E;
    store_tile(0);
    __syncthreads();
    const int wlo = min(max(R0 + w * 2 - 4, 0), 120), whi = min(max(R0 + w * 2 + 1 - 4, 0), 120) + 7;
    int colterm[8];
    if (MODE == 2) {
        const int qc = c0 + c, cs = min(max(qc - 8, 0), 48);
#pragma unroll
        for (int j = 0; j < 8; ++j) {
            const int kc = bstart + (j >> 2) * 16 + g * 4 + (j & 3);
            colterm[j] = ((unsigned)(kc - cs) < 16u) ? (kc - qc + 15) : -1;
        }
    }
    for (int tt = 0; tt < ntiles; ++tt) {
        const int cur = tt & 1;
        if (tt + 1 < ntiles) load_tile(tt + 1);
        bool skip = false;
        int krow0 = 0;
        if (MODE == 2 && tt >= 4) { krow0 = start + 2 * (tt - 4); skip = (krow0 + 1 < wlo) || (krow0 > whi); }
        if (!skip) {
            const bf16_t* ks_ = Ks + cur * 64 * 72; const bf16_t* vt_ = Vt + cur * 64 * 72;
            f32x4 s[NQB][4];
#pragma unroll
            for (int qq = 0; qq < NQB; ++qq)
#pragma unroll
                for (int kb = 0; kb < 4; ++kb) s[qq][kb] = (f32x4){0.f, 0.f, 0.f, 0.f};
#pragma unroll
            for (int ks = 0; ks < 2; ++ks) {
                bf16x8 qv[NQB];
#pragma unroll
                for (int qq = 0; qq < NQB; ++qq) qv[qq] = as_bf(Qs[(qq * 2 + ks) * 64 + lane]);
#pragma unroll
                for (int kb = 0; kb < 4; ++kb) {
                    const bf16x8 kf = *(const bf16x8*)(ks_ + (kb * 16 + c) * 72 + ks * 32 + g * 8);
#pragma unroll
                    for (int qq = 0; qq < NQB; ++qq) s[qq][kb] = mfma16(kf, qv[qq], s[qq][kb]);
                }
            }
            __builtin_amdgcn_sched_barrier(0);
            bf16x8 pf[NQB][2];
#pragma unroll
            for (int qq = 0; qq < NQB; ++qq) {
                const int qb = qq;
                if (MODE == 2 && tt >= 4) {
                    const int qrow = R0 + w * 2 + qb;
                    const int rs = min(max(qrow - 4, 0), 120);
#pragma unroll
                    for (int kb = 0; kb < 4; ++kb) {
                        const int krow = krow0 + (kb >> 1);
                        const bool rowok = (unsigned)(krow - rs) < 8u;
                        const int ridx = (krow - qrow + 7) * 31;
#pragma unroll
                        for (int r = 0; r < 4; ++r) {
                            const int ct = colterm[(kb & 1) * 4 + r];
                            const bool valid = rowok && ct >= 0;
                            const float bias = rpbs[valid ? ridx + ct : 0];
                            s[qq][kb][r] = valid ? s[qq][kb][r] * scale + bias : -INFINITY;
                        }
                    }
                }
                const bool raw = !(MODE == 2 && tt >= 4);
                float tmax = fmaxf(fmaxf(s[qq][0][0], s[qq][0][1]), fmaxf(s[qq][0][2], s[qq][0][3]));
#pragma unroll
                for (int kb = 1; kb < 4; ++kb) tmax = fmaxf(tmax, fmaxf(fmaxf(s[qq][kb][0], s[qq][kb][1]), fmaxf(s[qq][kb][2], s[qq][kb][3])));
                tmax = fmaxf(tmax, __shfl_xor(tmax, 16)); tmax = fmaxf(tmax, __shfl_xor(tmax, 32));
                const float mn = fmaxf(mrun[qb], raw ? tmax * scale : tmax);
                const float alpha = ex2(mrun[qb] - mn);
                mrun[qb] = mn;
                float psum = 0.f;
#pragma unroll
                for (int kb = 0; kb < 4; ++kb)
#pragma unroll
                    for (int r = 0; r < 4; ++r) { const float pv = raw ? ex2(__builtin_fmaf(s[qq][kb][r], scale, -mn)) : ex2(s[qq][kb][r] - mn); s[qq][kb][r] = pv; psum += pv; }
                lsum[qb] = lsum[qb] * alpha + psum;
                if (__builtin_amdgcn_ballot_w64(alpha != 1.f) != 0ull) {
#pragma unroll
                    for (int d = 0; d < 4; ++d) o[qb][d] = o[qb][d] * alpha;
                }
#pragma unroll
                for (int kk = 0; kk < 2; ++kk) {
                    u32x4 u;
                    u[0] = pk2(s[qq][2 * kk][0], s[qq][2 * kk][1]); u[1] = pk2(s[qq][2 * kk][2], s[qq][2 * kk][3]);
                    u[2] = pk2(s[qq][2 * kk + 1][0], s[qq][2 * kk + 1][1]); u[3] = pk2(s[qq][2 * kk + 1][2], s[qq][2 * kk + 1][3]);
                    pf[qq][kk] = as_bf(u);
                }
            }
            __builtin_amdgcn_sched_barrier(0);
#pragma unroll
            for (int kk = 0; kk < 2; ++kk)
#pragma unroll
                for (int d = 0; d < 4; ++d) {
                    const u32x2 vlo = *(const u32x2*)(vt_ + (d * 16 + c) * 72 + kk * 32 + g * 4);
                    const u32x2 vhi = *(const u32x2*)(vt_ + (d * 16 + c) * 72 + kk * 32 + 16 + g * 4);
                    u32x4 vv; vv[0] = vlo[0]; vv[1] = vlo[1]; vv[2] = vhi[0]; vv[3] = vhi[1];
                    const bf16x8 vf = as_bf(vv);
#pragma unroll
                    for (int qq = 0; qq < NQB; ++qq) o[qq][d] = mfma16(vf, pf[qq][kk], o[qq][d]);
                }
        }
        if (tt + 1 < ntiles) store_tile(cur ^ 1);
        __syncthreads();
    }
    if (dostore)
#pragma unroll
    for (int qb = 0; qb < NQB; ++qb) {
        float ls = lsum[qb];
        ls += __shfl_xor(ls, 16); ls += __shfl_xor(ls, 32);
        const float inv = __builtin_amdgcn_rcpf(ls);
        bf16_t* rowp = p.P + (size_t)(qbase + qb * qstep + c) * PC;
#pragma unroll
        for (int d = 0; d < 4; ++d) {
            const int dd = d * 16 + g * 4;
            const u32x2 gt = *(const u32x2*)(rowp + gcol + dd);
            const float v0 = o[qb][d][0] * inv * silu_f(lo16(gt[0])), v1 = o[qb][d][1] * inv * silu_f(hi16(gt[0]));
            const float v2 = o[qb][d][2] * inv * silu_f(lo16(gt[1])), v3 = o[qb][d][3] * inv * silu_f(hi16(gt[1]));
            u32x2 o2; o2.x = pk2(v0, v1); o2.y = pk2(v2, v3);
            *(u32x2*)(rowp + qcol + dd) = o2;
        }
    }
}

typedef float f32x16 __attribute__((ext_vector_type(16)));
__device__ __forceinline__ f32x16 mfma32(bf16x8 a, bf16x8 b, f32x16 c) { return __builtin_amdgcn_mfma_f32_32x32x16_bf16(a, b, c, 0, 0, 0); }

template <int MODE, bool FIXM>
__device__ void attn_item32(const Params& p, int l, int b, int i1, int i2, unsigned char* lds, float mfix, bool dostore = true) {
    const int t = tid_opaque(), lane = t & 63, w = t >> 6, h = lane >> 5, c = lane & 31;
    bf16_t* Ks = (bf16_t*)lds;
    bf16_t* Vt = Ks + 2 * 64 * 72;
    u32x4* Qs = (u32x4*)(lds + 36864) + w * 512;
    int qbase, qcol, kcol, vcol, gcol, ntiles;
    if (MODE == 0 || MODE == 1) {
        const int kvh = i1, qt = i2, head = kvh * 4 + w;
        qbase = (MODE == 0 ? b * 8192 : NTOK + b * 256) + qt * 64;
        qcol = C_GQ + head * 64; kcol = C_GK + kvh * 64; vcol = C_GV + kvh * 64; gcol = C_GG + head * 64;
        ntiles = MODE == 0 ? 132 : 4;
    } else {
        const int hh = i1;
        qbase = NTOK + b * 256 + w * 64;
        qcol = C_NQ + hh * 64; kcol = C_NK + hh * 64; vcol = C_NV + hh * 64; gcol = C_NG + hh * 64;
        ntiles = 4;
    }
    const float scale = MODE <= 1 ? 1.f : 0.125f * LOG2E;
    f32x16 o[2][2];
    float mrun[2], lsum[2];
#pragma unroll
    for (int qb = 0; qb < 2; ++qb) {
        mrun[qb] = -INFINITY; lsum[qb] = 0.f;
#pragma unroll
        for (int d = 0; d < 2; ++d)
#pragma unroll
            for (int r = 0; r < 16; ++r) o[qb][d][r] = 0.f;
    }
    const int kkey = t >> 3, kch = (t & 7) * 8;
    const int vkey = t & 63, vch = (t >> 6);
    u32x4 kr[2], vr[2];
    auto load_tile = [&](int tt) {
        const int base = MODE == 0 ? (tt < 128 ? b * 8192 + tt * 64 : NTOK + b * 256 + (tt - 128) * 64) : NTOK + b * 256 + tt * 64;
#pragma unroll
        for (int i = 0; i < 2; ++i) {
            kr[i] = ldg16(p.P + (size_t)(base + kkey + 32 * i) * PC + kcol + kch);
            if (MODE <= 1) vr[i] = ldg16(VG(p) + ((size_t)(b * 2 + i1) * 64 + kkey + 32 * i) * 8448 + (MODE == 0 ? tt * 64 : 8192 + tt * 64) + kch);
            else vr[i] = ldg16(p.P + (size_t)(base + vkey) * PC + vcol + (vch + 4 * i) * 8);
        }
    };
    auto store_tile = [&](int buf) {
        bf16_t* ks_ = Ks + buf * 64 * 72; bf16_t* vt_ = Vt + buf * 64 * 72;
#pragma unroll
        for (int i = 0; i < 2; ++i) {
            *(u32x4*)(ks_ + (kkey + 32 * i) * 72 + kch) = kr[i];
            if (MODE <= 1) { *(u32x4*)(vt_ + (kkey + 32 * i) * 72 + kch) = vr[i]; continue; }
#pragma unroll
            for (int e = 0; e < 4; ++e) {
                const int d = (vch + 4 * i) * 8 + 2 * e;
                vt_[d * 72 + vkey] = (bf16_t)(vr[i][e] & 0xffffu);
                vt_[(d + 1) * 72 + vkey] = (bf16_t)(vr[i][e] >> 16);
            }
        }
    };
    load_tile(0);
    __syncthreads();
#pragma unroll
    for (int qb = 0; qb < 2; ++qb)
#pragma unroll
        for (int ks = 0; ks < 4; ++ks) Qs[(qb * 4 + ks) * 64 + lane] = ldg16(p.P + (size_t)(qbase + qb * 32 + c) * PC + qcol + ks * 16 + h * 8);
    store_tile(0);
    __syncthreads();
    for (int tt = 0; tt < ntiles; ++tt) {
        const int cur = tt & 1;
        if (tt + 1 < ntiles) load_tile(tt + 1);
        const bf16_t* ks_ = Ks + cur * 64 * 72; const bf16_t* vt_ = Vt + cur * 64 * 72;
        f32x16 s[2][2];
#pragma unroll
        for (int qb = 0; qb < 2; ++qb)
#pragma unroll
            for (int kb = 0; kb < 2; ++kb)
#pragma unroll
                for (int r = 0; r < 16; ++r) s[qb][kb][r] = FIXM ? -mfix : 0.f;
#pragma unroll
        for (int ks = 0; ks < 4; ++ks) {
            const bf16x8 q0 = as_bf(Qs[ks * 64 + lane]), q1 = as_bf(Qs[(4 + ks) * 64 + lane]);
#pragma unroll
            for (int kb = 0; kb < 2; ++kb) {
                const bf16x8 kf = *(const bf16x8*)(ks_ + (kb * 32 + c) * 72 + ks * 16 + h * 8);
                s[0][kb] = mfma32(kf, q0, s[0][kb]);
                s[1][kb] = mfma32(kf, q1, s[1][kb]);
            }
        }
        bf16x8 pf[2][4];
#pragma unroll
        for (int qb = 0; qb < 2; ++qb) {
            float psum = 0.f;
            if (FIXM) {
#pragma unroll
                for (int kb = 0; kb < 2; ++kb)
#pragma unroll
                    for (int r = 0; r < 16; ++r) { const float pv = ex2(s[qb][kb][r]); s[qb][kb][r] = pv; psum += pv; }
                lsum[qb] += psum;
            } else {
                float tmax = s[qb][0][0];
#pragma unroll
                for (int kb = 0; kb < 2; ++kb)
#pragma unroll
                    for (int r = 0; r < 16; r += 4) tmax = fmaxf(tmax, fmaxf(fmaxf(s[qb][kb][r], s[qb][kb][r + 1]), fmaxf(s[qb][kb][r + 2], s[qb][kb][r + 3])));
                tmax = fmaxf(tmax, __shfl_xor(tmax, 32));
                const float mn = fmaxf(mrun[qb], tmax * scale);
                const float alpha = ex2(mrun[qb] - mn);
                mrun[qb] = mn;
#pragma unroll
                for (int kb = 0; kb < 2; ++kb)
#pragma unroll
                    for (int r = 0; r < 16; ++r) { const float pv = ex2(__builtin_fmaf(s[qb][kb][r], scale, -mn)); s[qb][kb][r] = pv; psum += pv; }
                lsum[qb] = lsum[qb] * alpha + psum;
                if (__builtin_amdgcn_ballot_w64(alpha != 1.f) != 0ull) {
#pragma unroll
                    for (int d = 0; d < 2; ++d)
#pragma unroll
                        for (int r = 0; r < 16; ++r) o[qb][d][r] *= alpha;
                }
            }
#pragma unroll
            for (int kb = 0; kb < 2; ++kb)
#pragma unroll
                for (int st = 0; st < 2; ++st) {
                    u32x4 u;
#pragma unroll
                    for (int e = 0; e < 4; ++e) u[e] = pk2(s[qb][kb][8 * st + 2 * e], s[qb][kb][8 * st + 2 * e + 1]);
                    pf[qb][kb * 2 + st] = as_bf(u);
                }
        }
#pragma unroll
        for (int kk = 0; kk < 4; ++kk)
#pragma unroll
            for (int d = 0; d < 2; ++d) {
                const u32x2 vlo = *(const u32x2*)(vt_ + (d * 32 + c) * 72 + kk * 16 + h * 4);
                const u32x2 vhi = *(const u32x2*)(vt_ + (d * 32 + c) * 72 + kk * 16 + 8 + h * 4);
                u32x4 vv; vv[0] = vlo[0]; vv[1] = vlo[1]; vv[2] = vhi[0]; vv[3] = vhi[1];
                const bf16x8 vf = as_bf(vv);
                o[0][d] = mfma32(vf, pf[0][kk], o[0][d]);
                o[1][d] = mfma32(vf, pf[1][kk], o[1][d]);
            }
        if (tt + 1 < ntiles) store_tile(cur ^ 1);
        __syncthreads();
    }
    if (dostore)
#pragma unroll
    for (int qb = 0; qb < 2; ++qb) {
        float ls = lsum[qb];
        ls += __shfl_xor(ls, 32);
        const float inv = __builtin_amdgcn_rcpf(ls);
        bf16_t* rowp = p.P + (size_t)(qbase + qb * 32 + c) * PC;
#pragma unroll
        for (int d = 0; d < 2; ++d)
#pragma unroll
            for (int rg = 0; rg < 4; ++rg) {
                const int dd = d * 32 + rg * 8 + h * 4;
                const u32x2 gt = *(const u32x2*)(rowp + gcol + dd);
                const float v0 = o[qb][d][rg * 4 + 0] * inv * silu_f(lo16(gt[0])), v1 = o[qb][d][rg * 4 + 1] * inv * silu_f(hi16(gt[0]));
                const float v2 = o[qb][d][rg * 4 + 2] * inv * silu_f(lo16(gt[1])), v3 = o[qb][d][rg * 4 + 3] * inv * silu_f(hi16(gt[1]));
                u32x2 o2; o2.x = pk2(v0, v1); o2.y = pk2(v2, v3);
                *(u32x2*)(rowp + qcol + dd) = o2;
            }
    }
}

__device__ __forceinline__ bf16x8 scale_frag(bf16x8 f, float sc) {
    u32x4 u = as_u(f), r;
#pragma unroll
    for (int e = 0; e < 4; ++e) r[e] = pk2(lo16(u[e]) * sc, hi16(u[e]) * sc);
    return as_bf(r);
}

__device__ void ret_item(const Params& p, int l, int b, int h, int cidx, int hf, unsigned char* lds, bool dostore = true) {
    const int t = tid_opaque(), lane = t & 63, w = t >> 6, g = lane >> 4, c = lane & 15;
    bf16_t* B0 = (bf16_t*)lds;
    bf16_t* B1 = B0 + 128 * 136;
    const float lgf = -__expf(p.ret_log_decay[l * 8 + h]) * LOG2E, lgb = -__expf(p.ret_log_decay[l * 8 + 4 + h]) * LOG2E;
    const float ksc = 0.08838834764831845f;
    const int rowbase = chunk_row(b, cidx);
    const int ti = hf * 64 + w * 16 + c;
    bf16x8 qf[4];
#pragma unroll
    for (int ks = 0; ks < 4; ++ks) qf[ks] = as_bf(ldg16(p.P + (size_t)(rowbase + ti) * PC + C_RQ + h * 128 + ks * 32 + g * 8));
    __syncthreads();
#pragma unroll
    for (int i = 0; i < 8; ++i) {
        const int cc = t + 256 * i;
        { const int r = cc >> 4, ch = cc & 15; *(u32x4*)(B0 + r * 136 + ch * 8) = ldg16(p.P + (size_t)(rowbase + r) * PC + C_RK + h * 128 + ch * 8); }
        { const int tok = cc & 127, ch = cc >> 7;
          const u32x4 vv = ldg16(p.P + (size_t)(rowbase + tok) * PC + C_RV + h * 128 + ch * 8);
#pragma unroll
          for (int e = 0; e < 4; ++e) { B1[(ch * 8 + 2 * e) * 136 + tok] = (bf16_t)(vv[e] & 0xffffu); B1[(ch * 8 + 2 * e + 1) * 136 + tok] = (bf16_t)(vv[e] >> 16); } }
    }
    __syncthreads();
    bf16x8 pf[4];
    {
        f32x4 s[8];
#pragma unroll
        for (int kb = 0; kb < 8; ++kb) s[kb] = (f32x4){0.f, 0.f, 0.f, 0.f};
#pragma unroll
        for (int ks = 0; ks < 4; ++ks)
#pragma unroll
            for (int kb = 0; kb < 8; ++kb) {
                const bf16x8 kf = *(const bf16x8*)(B0 + (kb * 16 + c) * 136 + ks * 32 + g * 8);
                s[kb] = mfma16(kf, qf[ks], s[kb]);
            }
#pragma unroll
        for (int kb = 0; kb < 8; ++kb)
#pragma unroll
            for (int r = 0; r < 4; ++r) {
                const int j = kb * 16 + g * 4 + r, d = ti - j;
                const float wgt = d > 0 ? ex2(lgf * (float)d) : (d < 0 ? ex2(lgb * (float)(-d)) : 2.f);
                s[kb][r] *= wgt * ksc;
            }
#pragma unroll
        for (int kk = 0; kk < 4; ++kk) {
            u32x4 u;
            u[0] = pk2(s[2 * kk][0], s[2 * kk][1]); u[1] = pk2(s[2 * kk][2], s[2 * kk][3]);
            u[2] = pk2(s[2 * kk + 1][0], s[2 * kk + 1][1]); u[3] = pk2(s[2 * kk + 1][2], s[2 * kk + 1][3]);
            pf[kk] = as_bf(u);
        }
    }
    f32x4 o[8];
#pragma unroll
    for (int d = 0; d < 8; ++d) o[d] = (f32x4){0.f, 0.f, 0.f, 0.f};
#pragma unroll
    for (int kk = 0; kk < 4; ++kk)
#pragma unroll
        for (int d = 0; d < 8; ++d) {
            const u32x2 vlo = *(const u32x2*)(B1 + (d * 16 + c) * 136 + kk * 32 + g * 4);
            const u32x2 vhi = *(const u32x2*)(B1 + (d * 16 + c) * 136 + kk * 32 + 16 + g * 4);
            u32x4 vv; vv[0] = vlo[0]; vv[1] = vlo[1]; vv[2] = vhi[0]; vv[3] = vhi[1];
            o[d] = mfma16(as_bf(vv), pf[kk], o[d]);
        }
    __syncthreads();
    {
        const bf16_t* Sf = p.SU + ((size_t)((0 * 4 + b) * 4 + h) * 66 + cidx) * 16384;
        const bf16_t* Sb = p.SU + ((size_t)((1 * 4 + b) * 4 + h) * 66 + cidx) * 16384;
#pragma unroll
        for (int i = 0; i < 8; ++i) {
            const int cc = t + 256 * i, r = cc >> 4, ch = cc & 15;
            *(u32x4*)(B0 + r * 136 + ch * 8) = ldg16(Sf + r * 128 + ch * 8);
            *(u32x4*)(B1 + r * 136 + ch * 8) = ldg16(Sb + r * 128 + ch * 8);
        }
    }
    __syncthreads();
#pragma unroll
    for (int dir = 0; dir < 2; ++dir) {
        const bf16_t* Bd = dir ? B1 : B0;
        const float xi = dir == 0 ? ex2(lgf * (float)(ti + 1)) : ex2(lgb * (float)(128 - ti));
        bf16x8 qs[4];
#pragma unroll
        for (int ks = 0; ks < 4; ++ks) qs[ks] = scale_frag(qf[ks], xi);
#pragma unroll
        for (int ks = 0; ks < 4; ++ks)
#pragma unroll
            for (int d = 0; d < 8; ++d) {
                const bf16x8 sf = *(const bf16x8*)(Bd + (d * 16 + c) * 136 + ks * 32 + g * 8);
                o[d] = mfma16(sf, qs[ks], o[d]);
            }
    }
    if (dostore) {
        float sum = 0.f;
#pragma unroll
        for (int d = 0; d < 8; ++d) sum += (o[d][0] + o[d][1]) + (o[d][2] + o[d][3]);
        sum += __shfl_xor(sum, 16); sum += __shfl_xor(sum, 32);
        const float mu = sum * (1.f / 128.f);
        float var = 0.f;
#pragma unroll
        for (int d = 0; d < 8; ++d)
#pragma unroll
            for (int r = 0; r < 4; ++r) { const float dd = o[d][r] - mu; var += dd * dd; }
        var += __shfl_xor(var, 16); var += __shfl_xor(var, 32);
        const float rstd = rsqrtf(var * (1.f / 128.f) + EPSN);
        bf16_t* rowp = p.P + (size_t)(rowbase + ti) * PC;
#pragma unroll
        for (int d = 0; d < 8; ++d) {
            const int dv = d * 16 + g * 4;
            const f32x4 gn = *(const f32x4*)(p.ret_gn_w + l * 512 + h * 128 + dv);
            const u32x2 gt = *(const u32x2*)(rowp + C_RG + h * 128 + dv);
            const float v0 = (o[d][0] - mu) * rstd * gn[0] * silu_f(lo16(gt[0])), v1 = (o[d][1] - mu) * rstd * gn[1] * silu_f(hi16(gt[0]));
            const float v2 = (o[d][2] - mu) * rstd * gn[2] * silu_f(lo16(gt[1])), v3 = (o[d][3] - mu) * rstd * gn[3] * silu_f(hi16(gt[1]));
            u32x2 o2; o2.x = pk2(v0, v1); o2.y = pk2(v2, v3);
            *(u32x2*)(rowp + C_RQ + h * 128 + dv) = o2;
        }
    }
}

__device__ void phase_d(const Params& p, int l, unsigned char* lds) {
    const bool need_ctx = l < 3;
    const int G = gridDim.x, bid = blockIdx.x;
    const bool small_first = bid >= (G >> 1);
    float mfix;
    {
        const int ln = tid_opaque() & 63;
        float wq = fabsf(p.q_norm_w[l * 64 + ln]), wk = fabsf(p.k_norm_w[l * 64 + ln]);
#pragma unroll
        for (int o = 32; o >= 1; o >>= 1) { wq = fmaxf(wq, __shfl_xor(wq, o)); wk = fmaxf(wk, __shfl_xor(wk, o)); }
        mfix = 64.f * wq * wk * (0.125f * LOG2E);
    }
    const bool usefix = mfix < 40.f;
    {
        phase_c(p, l);
        asm volatile("s_waitcnt vmcnt(0) lgkmcnt(0)" ::: "memory");
        __syncthreads();
        if (threadIdx.x == 0) {
            unsigned mine = 0;
            for (int it = bid; it < 256; it += G) ++mine;
            if (mine) { __builtin_amdgcn_fence(__ATOMIC_RELEASE, "agent"); __hip_atomic_fetch_add(p.bar + 768, mine, __ATOMIC_RELAXED, __HIP_MEMORY_SCOPE_AGENT); }
        }
    }
#pragma unroll 1
    for (int stage = 0; stage < 3; ++stage) {
        const int kind = small_first ? (stage + 1) % 3 : stage;
        if (kind == 0) {
#pragma unroll 1
            for (int it = bid; it < 1024; it += G) {
                if (usefix) attn_item32<0, true>(p, l, it >> 8, (it >> 7) & 1, it & 127, lds, mfix);
                else attn_item32<0, false>(p, l, it >> 8, (it >> 7) & 1, it & 127, lds, 0.f);
            }
        } else if (kind == 1) {
#pragma unroll 1
            for (int it = bid; it < 2048; it += G) {
                attn_item<2>(p, l, it >> 9, (it >> 6) & 7, (it >> 2) & 15, it & 3, lds);
            }
        } else {
            const int nch = need_ctx ? 66 : 64, n_ret = nch * 32;
            if (threadIdx.x == 0) {
                while (__hip_atomic_load(p.bar + 768, __ATOMIC_RELAXED, __HIP_MEMORY_SCOPE_AGENT) < 256u * (unsigned)(l + 1)) __builtin_amdgcn_s_sleep(2);
                __builtin_amdgcn_fence(__ATOMIC_ACQUIRE, "agent");
            }
            __syncthreads();
#pragma unroll 1
            for (int it = G - 1 - bid; it < n_ret; it += G) {
                const int hf = it & 1, it2 = it >> 1;
                const int cidx = it2 % nch, bh = it2 / nch;
                ret_item(p, l, bh >> 2, bh & 3, cidx, hf, lds);
            }
        }
        __syncthreads();
    }
    if (need_ctx) {
#pragma unroll 1
        for (int it = G - 1 - bid; it < 32; it += G) attn_item32<1, false>(p, l, it >> 3, (it >> 2) & 1, it & 3, lds, 0.f);
        __syncthreads();
#pragma unroll 1
        for (int it = G - 1 - bid - 32; it < 32; it += G) { if (it >= 0) attn_item32<3, false>(p, l, it >> 3, it & 7, 0, lds, 0.f); }
    }
}

__device__ __forceinline__ int xcd_tile(int it0) {
    if (gridDim.x != 512 || it0 >= 2048) return it0;
    const int xcd = it0 & 7, j = (it0 >> 3) & 63, r = it0 >> 9;
    const int li = j + 64 * r;
    return ((xcd * 32 + (li >> 3)) << 3) | (li & 7);
}

__device__ void phase_e1(const Params& p, int l, unsigned char* lds) {
    const int t = tid_opaque(), lane = t & 63, w = t >> 6, wm = w >> 1, wn = w & 1;
    const int nmt = l < 3 ? 264 : 256;
    const int total = nmt * 8;
    for (int it0 = blockIdx.x; it0 < total; it0 += gridDim.x) {
        const int item = xcd_tile(it0);
        const int mt = item >> 3, nt = item & 7;
        u32x2 macc[4][4];
#pragma unroll
        for (int a = 0; a < 4; ++a)
#pragma unroll
            for (int b = 0; b < 4; ++b) macc[a][b] = (u32x2){0u, 0u};
#pragma unroll 1
        for (int br = 0; br < 3; ++br) {
            u32x2 sg[4][4];
            {
                f32x4 gacc[4][4];
#pragma unroll
                for (int a = 0; a < 4; ++a)
#pragma unroll
                    for (int b = 0; b < 4; ++b) gacc[a][b] = (f32x4){0.f, 0.f, 0.f, 0.f};
                gemm_core<4>(gacc, p.HX + (size_t)mt * 128 * DM, DM, p.Wt + WT_IN + (size_t)(PC + br * 1024 + nt * 128) * DM, DM, DM, lds);
#pragma unroll
                for (int a = 0; a < 4; ++a)
#pragma unroll
                    for (int b = 0; b < 4; ++b) { sg[a][b].x = pk2(sigm_f(gacc[a][b][0]), sigm_f(gacc[a][b][1])); sg[a][b].y = pk2(sigm_f(gacc[a][b][2]), sigm_f(gacc[a][b][3])); }
            }
            f32x4 pacc[4][4];
#pragma unroll
            for (int a = 0; a < 4; ++a)
#pragma unroll
                for (int b = 0; b < 4; ++b) pacc[a][b] = (f32x4){0.f, 0.f, 0.f, 0.f};
            const int xcol = br == 0 ? C_RQ : (br == 1 ? C_NQ : C_GQ);
            const int woff = br == 0 ? WT_RET : (br == 1 ? WT_NA : WT_GQA);
            gemm_core<4>(pacc, p.P + (size_t)mt * 128 * PC + xcol, PC, p.Wt + woff + (size_t)nt * 128 * 512, 512, 512, lds);
#pragma unroll
            for (int a = 0; a < 4; ++a)
#pragma unroll
                for (int b = 0; b < 4; ++b) {
                    const float m0 = lo16(macc[a][b].x) + lo16(sg[a][b].x) * pacc[a][b][0], m1 = hi16(macc[a][b].x) + hi16(sg[a][b].x) * pacc[a][b][1];
                    const float m2 = lo16(macc[a][b].y) + lo16(sg[a][b].y) * pacc[a][b][2], m3 = hi16(macc[a][b].y) + hi16(sg[a][b].y) * pacc[a][b][3];
                    macc[a][b].x = pk2(m0, m1); macc[a][b].y = pk2(m2, m3);
                }
        }
#pragma unroll
        for (int ni = 0; ni < 4; ++ni)
#pragma unroll
            for (int mi = 0; mi < 4; ++mi) {
                const int n = nt * 128 + wn * 64 + ni * 16 + (lane >> 4) * 4, m = mt * 128 + wm * 64 + mi * 16 + (lane & 15);
                *(u32x2*)(p.P + (size_t)m * PC + C_M + n) = macc[ni][mi];
            }
    }
}

__device__ void phase_e2(const Params& p, int l, unsigned char* lds, bool dostore = true) {
    const int t = tid_opaque(), lane = t & 63, w = t >> 6, wm = w >> 1, wn = w & 1;
    const int nmt = l < 3 ? 264 : 256;
    const int total = nmt * 8;
    const float* xsrc = l == 0 ? p.x : p.out;
    const float* ysrc = l == 0 ? p.ctx : p.y;
    for (int it0 = blockIdx.x; it0 < total; it0 += gridDim.x) {
        const int item = xcd_tile(it0);
        const int mt = item >> 3, nt = item & 7;
        f32x4 acc[4][4];
#pragma unroll
        for (int a = 0; a < 4; ++a)
#pragma unroll
            for (int b = 0; b < 4; ++b) acc[a][b] = (f32x4){0.f, 0.f, 0.f, 0.f};
        gemm_core<4>(acc, p.P + (size_t)mt * 128 * PC + C_M, PC, p.Wt + WT_OUT + (size_t)nt * 128 * DM, DM, DM, lds);
#pragma unroll
        for (int mi = 0; mi < 4; ++mi) {
            const int m = mt * 128 + wm * 64 + mi * 16 + (lane & 15);
            const bool lat = m < NTOK;
            const int bb = lat ? (m >> 13) : 4;
            const float* src = lat ? xsrc + (size_t)m * DM : ysrc + (size_t)(m - NTOK) * DM;
            float* dst = lat ? p.out + (size_t)m * DM : p.y + (size_t)(m - NTOK) * DM;
            const float* gate = p.mod + (size_t)(l * 5 + bb) * 3072 + 2048;
#pragma unroll
            for (int ni = 0; ni < 4; ++ni) {
                const int n = nt * 128 + wn * 64 + ni * 16 + (lane >> 4) * 4;
                const f32x4 xo = *(const f32x4*)(src + n), gv = *(const f32x4*)(gate + n);
                if (dostore) *(f32x4*)(dst + n) = xo + gv * acc[ni][mi];
            }
        }
    }
}

__device__ void phase_e3(const Params& p, int l, unsigned char* lds) {
    norm_rows(p, l + 1, p.out, p.y);
    if (l < 3)
        for (int item = blockIdx.x; item < NCONV_ITEMS; item += gridDim.x) convert_item(p, l + 1, item, lds);
}


__device__ __forceinline__ void run_phase(const Params& p, int ph, int l, unsigned char* lds) {
    switch (ph) {
        case 0: phase_p0(p, lds);
            break;
        case 1: norm_rows(p, 0, p.x, p.ctx); break;
        case 2: phase_a(p, l, lds);
            break;
        case 3: phase_b(p, l, lds); break;
        case 4:
            phase_c(p, l); break;
        case 5: phase_d(p, l, lds); break;
        case 6: phase_e1(p, l, lds);
            break;
        case 7:
            phase_e2(p, l, lds); break;
        default: phase_e3(p, l, lds);
            break;
    }
}

__device__ __forceinline__ void fast_grid_barrier(unsigned* bar, unsigned k) {
    asm volatile("s_waitcnt vmcnt(0) lgkmcnt(0)" ::: "memory");
    __syncthreads();
    if (threadIdx.x == 0) {
        const unsigned grp = blockIdx.x & 7u, members = (gridDim.x - grp + 7u) >> 3;
        __builtin_amdgcn_fence(__ATOMIC_RELEASE, "agent");
        const unsigned old = __hip_atomic_fetch_add(bar + grp * 32, 1u, __ATOMIC_RELAXED, __HIP_MEMORY_SCOPE_AGENT);
        if (old + 1u == k * members) {
            __hip_atomic_fetch_add(bar + 256, 1u, __ATOMIC_RELAXED, __HIP_MEMORY_SCOPE_AGENT);
            while (__hip_atomic_load(bar + 256, __ATOMIC_RELAXED, __HIP_MEMORY_SCOPE_AGENT) < k * 8u) __builtin_amdgcn_s_sleep(1);
            __hip_atomic_store(bar + 288 + grp * 32, k, __ATOMIC_RELAXED, __HIP_MEMORY_SCOPE_AGENT);
        } else {
            while (__hip_atomic_load(bar + 288 + grp * 32, __ATOMIC_RELAXED, __HIP_MEMORY_SCOPE_AGENT) < k) __builtin_amdgcn_s_sleep(1);
        }
        __builtin_amdgcn_fence(__ATOMIC_ACQUIRE, "agent");
    }
    __syncthreads();
}
#define GSYNC() do { asm volatile("s_waitcnt vmcnt(0) lgkmcnt(0)" ::: "memory"); grid.sync(); } while (0)
__global__ void __launch_bounds__(256, 2) mega_kernel(Params p) {
    __shared__ __attribute__((aligned(16))) unsigned char lds[LDS_BYTES];
    cg::grid_group grid = cg::this_grid();
    unsigned bk = 0;
    run_phase(p, 0, 0, lds);
    if (p.out == nullptr) GSYNC();
    fast_grid_barrier(p.bar, ++bk);
    run_phase(p, 1, 0, lds); fast_grid_barrier(p.bar, ++bk);
    for (int l = 0; l < 4; ++l) {
#pragma unroll 1
        for (int ph = 2; ph <= 8; ++ph) {
            if (ph == 4) continue;
            run_phase(p, ph, l, lds);
            if (!(l == 3 && ph == 8)) fast_grid_barrier(p.bar, ++bk);
        }
    }
}

extern "C" void kernel_launch(void* const* d_in, const int* in_sizes, int n_in, void* d_out, int out_size, void* d_ws, size_t ws_size, hipStream_t stream) {
    Params p{};
    p.x = (const float*)d_in[0]; p.c = (const float*)d_in[1]; p.ctx = (const float*)d_in[2]; p.c_ctx = (const float*)d_in[3];
    p.ada_w = (const float*)d_in[4]; p.ada_b = (const float*)d_in[5]; p.norm_w = (const float*)d_in[6]; p.w_in = (const float*)d_in[7];
    p.ret_log_decay = (const float*)d_in[8]; p.ret_gn_w = (const float*)d_in[9]; p.na_rpb = (const float*)d_in[10];
    p.q_norm_w = (const float*)d_in[11]; p.k_norm_w = (const float*)d_in[12]; p.w_ret_o = (const float*)d_in[13];
    p.w_na_o = (const float*)d_in[14]; p.w_gqa_o = (const float*)d_in[15]; p.w_out = (const float*)d_in[16]; p.final_norm_w = (const float*)d_in[17];
    p.out = (float*)d_out;
    unsigned char* ws = (unsigned char*)d_ws;
    size_t off = 0;
    p.P = (bf16_t*)(ws + off); off += (size_t)NROWS * PC * 2;
    p.HX = (bf16_t*)(ws + off); off += (size_t)NROWS * DM * 2;
    p.Wt = (bf16_t*)(ws + off); off += (size_t)WT_TOTAL * 2;
    p.SU = (bf16_t*)(ws + off); off += (size_t)2 * 4 * 4 * 66 * 16384 * 2;
    p.y = (float*)(ws + off); off += (size_t)1024 * 1024 * 4;
    p.mod = (float*)(ws + off); off += (size_t)4 * 5 * 3072 * 4;
    p.rope = (float*)(ws + off); off += (size_t)128 * 16 * 2 * 4 + 256;
    p.bar = (unsigned*)(ws + off); off += 4096;
    off += (size_t)4 * 2 * 64 * 8448 * 2;
    if (off > ws_size) { fprintf(stderr, "workspace too small: need %zu have %zu\n", off, ws_size); return; }
    static int grid_blocks = 0;
    if (!grid_blocks) {
        int dev = 0, cus = 0, per_cu = 0;
        hipGetDevice(&dev);
        hipDeviceGetAttribute(&cus, hipDeviceAttributeMultiprocessorCount, dev);
        hipOccupancyMaxActiveBlocksPerMultiprocessor(&per_cu, mega_kernel, 256, 0);
        if (per_cu > 2) per_cu = 2;
        grid_blocks = cus * per_cu;
    }
    hipMemsetAsync(p.bar, 0, 4096, stream);
    void* args[] = {&p};
    hipError_t e = hipLaunchCooperativeKernel((void*)mega_kernel, dim3(grid_blocks), dim3(256), args, 0, stream);
    if (e != hipSuccess) fprintf(stderr, "cooperative launch failed: %s (grid %d)\n", hipGetErrorString(e), grid_blocks);
}
```
